# Optimizing an MI355X kernel written in HIP

```python
import math, functools
import jax, jax.numpy as jnp
from jax import lax
import numpy as np

D_MODEL = 1024
BATCH = 16
SEQ = 2048
DEPTH = 2
DEC_BATCH = 16
DEC_SEQ = 16
PAST_LEN = 2048

CHUNK = 64
HEAD_DIM = 64
N_MIXERS = 2
A_HEADS = 16
A_LEFT_CHUNKS = 8
A_REL_CLIP = 128
B_Q_HEADS = 16
B_KV_HEADS = 4
B_WINDOW = 128
B_LEFT_CHUNKS = B_WINDOW // CHUNK
D_FF = 2816
ROPE_THETA = 10000.0
LN_EPS = 1e-5
DEEPNORM_ALPHA = (2.0 * DEPTH) ** 0.25
DEEPNORM_BETA = (8.0 * DEPTH) ** -0.25
N_A_LAYERS = (DEPTH + 1) // 2
N_B_LAYERS = DEPTH // 2

kernel_name = "streaming_chunkband_sinkswa_macaron_step"


def _layer_norm(x, g, b):
    xf = x.astype(jnp.float32)
    mu = jnp.mean(xf, axis=-1, keepdims=True)
    var = jnp.mean(jnp.square(xf - mu), axis=-1, keepdims=True)
    y = (xf - mu) * lax.rsqrt(var + LN_EPS) * g.astype(jnp.float32) + b.astype(jnp.float32)
    return y.astype(x.dtype)


def _post_norm(x, sub, g, b):
    return _layer_norm(DEEPNORM_ALPHA * x + sub, g, b)


def _swiglu(x, w_in, w_down):
    gate, up = jnp.split(x @ w_in, 2, axis=-1)
    return (jax.nn.silu(gate) * up) @ w_down


def _rope(x, pos):
    half = HEAD_DIM // 2
    inv = ROPE_THETA ** (-jnp.arange(half, dtype=jnp.float32) / half)
    ang = pos.astype(jnp.float32)[:, None] * inv[None, :]
    cos = jnp.cos(ang)[None, :, None, :]
    sin = jnp.sin(ang)[None, :, None, :]
    xf = x.astype(jnp.float32)
    x1, x2 = xf[..., :half], xf[..., half:]
    return jnp.concatenate([x1 * cos - x2 * sin, x2 * cos + x1 * sin], axis=-1).astype(x.dtype)


def _split_qkv(h, hq, hkv):
    bsz, t, _ = h.shape
    q, k, v = jnp.split(h, [hq * HEAD_DIM, (hq + hkv) * HEAD_DIM], axis=-1)
    return (q.reshape(bsz, t, hq, HEAD_DIM), k.reshape(bsz, t, hkv, HEAD_DIM),
            v.reshape(bsz, t, hkv, HEAD_DIM))


def _rel_bias(table, q_off, k_off):
    rel = jnp.clip(q_off[:, None] - k_off[None, :], -A_REL_CLIP, A_REL_CLIP) + A_REL_CLIP
    return table.astype(jnp.float32)[:, rel][:, None]


def _attend(q, k, v, valid, bias, sinks):
    s = jnp.einsum("bqhgd,bkhd->bhgqk", q, k, preferred_element_type=jnp.float32) * (HEAD_DIM ** -0.5)
    if bias is not None:
        s = s + bias
    if valid is not None:
        s = jnp.where(valid, s, -jnp.inf)
    if sinks is None:
        p = jax.nn.softmax(s, axis=-1)
    else:
        sk = sinks.astype(jnp.float32)[None, :, :, None, None]
        m = jnp.maximum(jnp.max(s, axis=-1, keepdims=True), sk)
        e = jnp.exp(s - m)
        p = e / (jnp.sum(e, axis=-1, keepdims=True) + jnp.exp(sk - m))
    return jnp.einsum("bhgqk,bkhd->bqhgd", p.astype(v.dtype), v)


def _band_attention(q, k, v, n_left, bias, sinks):
    bsz, s_len, hkv, g, hd = q.shape
    n_chunks = s_len // CHUNK
    pad = n_left * CHUNK
    band = pad + CHUNK
    kp = jnp.pad(k, ((0, 0), (pad, 0), (0, 0), (0, 0)))
    vp = jnp.pad(v, ((0, 0), (pad, 0), (0, 0), (0, 0)))
    qc = jnp.moveaxis(q.reshape(bsz, n_chunks, CHUNK, hkv, g, hd), 1, 0)
    offs = jnp.arange(band) - pad

    def one_chunk(args):
        c, qb = args
        start = c * CHUNK
        kb = lax.dynamic_slice_in_dim(kp, start, band, axis=1)
        vb = lax.dynamic_slice_in_dim(vp, start, band, axis=1)
        valid = (start + offs >= 0)[None, :]
        return _attend(qb, kb, vb, valid, bias, sinks)

    out = lax.map(one_chunk, (jnp.arange(n_chunks), qc))
    return jnp.moveaxis(out, 0, 1).reshape(bsz, s_len, hkv * g * hd)


def _mixer_a_prompt(x, w_qkv, w_o, table):
    bsz, s_len, _ = x.shape
    q, k, v = _split_qkv(x @ w_qkv, A_HEADS, A_HEADS)
    pad = A_LEFT_CHUNKS * CHUNK
    bias = _rel_bias(table, jnp.arange(CHUNK), jnp.arange(pad + CHUNK) - pad)
    o = _band_attention(q.reshape(bsz, s_len, A_HEADS, 1, HEAD_DIM), k, v, A_LEFT_CHUNKS, bias, None)
    keep = min(pad, s_len)
    return o @ w_o, k[:, s_len - keep:], v[:, s_len - keep:]


def _mixer_a_step(x, w_qkv, w_o, table, k_cache, v_cache):
    bsz, t, _ = x.shape
    q, k, v = _split_qkv(x @ w_qkv, A_HEADS, A_HEADS)
    lc = k_cache.shape[1]
    kk = jnp.concatenate([k_cache, k], axis=1)
    vv = jnp.concatenate([v_cache, v], axis=1)
    bias = _rel_bias(table, jnp.arange(t), jnp.arange(lc + t) - lc)
    o = _attend(q.reshape(bsz, t, A_HEADS, 1, HEAD_DIM), kk, vv, None, bias, None)
    return o.reshape(bsz, t, A_HEADS * HEAD_DIM) @ w_o, k, v


def _mixer_b_prompt(x, w_qkv, w_o, sinks):
    bsz, s_len, _ = x.shape
    q, k, v = _split_qkv(x @ w_qkv, B_Q_HEADS, B_KV_HEADS)
    pos = jnp.arange(s_len)
    q, k = _rope(q, pos), _rope(k, pos)
    g = B_Q_HEADS // B_KV_HEADS
    o = _band_attention(q.reshape(bsz, s_len, B_KV_HEADS, g, HEAD_DIM), k, v, B_LEFT_CHUNKS,
                        None, sinks.reshape(B_KV_HEADS, g))
    keep = min(B_WINDOW, s_len)
    return o @ w_o, k[:, s_len - keep:], v[:, s_len - keep:]


def _mixer_b_step(x, w_qkv, w_o, sinks, k_cache, v_cache):
    bsz, t, _ = x.shape
    q, k, v = _split_qkv(x @ w_qkv, B_Q_HEADS, B_KV_HEADS)
    pos = PAST_LEN + jnp.arange(t)
    q, k = _rope(q, pos), _rope(k, pos)
    g = B_Q_HEADS // B_KV_HEADS
    kk = jnp.concatenate([k_cache, k], axis=1)
    vv = jnp.concatenate([v_cache, v], axis=1)
    o = _attend(q.reshape(bsz, t, B_KV_HEADS, g, HEAD_DIM), kk, vv, None, None,
                sinks.reshape(B_KV_HEADS, g))
    return o.reshape(bsz, t, B_Q_HEADS * HEAD_DIM) @ w_o, k, v


def _macaron_layer(x, i, mixer, ln_g, ln_b, w_ffn_in, w_ffn_down):
    x = _post_norm(x, 0.5 * _swiglu(x, w_ffn_in[i, 0], w_ffn_down[i, 0]), ln_g[i, 0], ln_b[i, 0])
    m, k_new, v_new = mixer(x)
    x = _post_norm(x, m, ln_g[i, 1], ln_b[i, 1])
    x = _post_norm(x, 0.5 * _swiglu(x, w_ffn_in[i, 1], w_ffn_down[i, 1]), ln_g[i, 2], ln_b[i, 2])
    return x, k_new, v_new


def setup_inputs(seed: int = 0) -> dict:
    key = jax.random.key(seed)
    ks = jax.random.split(key, 16)
    f32 = jnp.float32

    def nrm(k, shape, scale):
        return scale * jax.random.normal(k, shape, f32)

    la = min(A_LEFT_CHUNKS * CHUNK, PAST_LEN)
    lb = min(B_WINDOW, PAST_LEN)
    qkv_b_cols = (B_Q_HEADS + 2 * B_KV_HEADS) * HEAD_DIM
    return {
        "x_prompt": nrm(ks[0], (BATCH, SEQ, D_MODEL), 1.0),
        "x_sample": nrm(ks[1], (DEC_BATCH, DEC_SEQ, D_MODEL), 1.0),
        "cache_a_k": nrm(ks[2], (N_A_LAYERS, DEC_BATCH, la, A_HEADS, HEAD_DIM), 1.0),
        "cache_a_v": nrm(ks[3], (N_A_LAYERS, DEC_BATCH, la, A_HEADS, HEAD_DIM), 1.0),
        "cache_b_k": nrm(ks[4], (N_B_LAYERS, DEC_BATCH, lb, B_KV_HEADS, HEAD_DIM), 1.0),
        "cache_b_v": nrm(ks[5], (N_B_LAYERS, DEC_BATCH, lb, B_KV_HEADS, HEAD_DIM), 1.0),
        "ln_g": 1.0 + nrm(ks[6], (DEPTH, 3, D_MODEL), 0.02),
        "ln_b": nrm(ks[7], (DEPTH, 3, D_MODEL), 0.02),
        "w_ffn_in": nrm(ks[8], (DEPTH, 2, D_MODEL, 2 * D_FF), D_MODEL ** -0.5),
        "w_ffn_down": nrm(ks[9], (DEPTH, 2, D_FF, D_MODEL), DEEPNORM_BETA * D_FF ** -0.5),
        "w_qkv_a": nrm(ks[10], (N_A_LAYERS, D_MODEL, 3 * A_HEADS * HEAD_DIM), D_MODEL ** -0.5),
        "w_o_a": nrm(ks[11], (N_A_LAYERS, A_HEADS * HEAD_DIM, D_MODEL),
                     DEEPNORM_BETA * (A_HEADS * HEAD_DIM) ** -0.5),
        "rel_bias_a": nrm(ks[12], (N_A_LAYERS, A_HEADS, 2 * A_REL_CLIP + 1), 0.5),
        "w_qkv_b": nrm(ks[13], (N_B_LAYERS, D_MODEL, qkv_b_cols), D_MODEL ** -0.5),
        "w_o_b": nrm(ks[14], (N_B_LAYERS, B_Q_HEADS * HEAD_DIM, D_MODEL),
                     DEEPNORM_BETA * (B_Q_HEADS * HEAD_DIM) ** -0.5),
        "sinks_b": nrm(ks[15], (N_B_LAYERS, B_Q_HEADS), 1.0),
    }


def reference(x_prompt, x_sample, cache_a_k, cache_a_v, cache_b_k, cache_b_v,
              ln_g, ln_b, w_ffn_in, w_ffn_down, w_qkv_a, w_o_a, rel_bias_a,
              w_qkv_b, w_o_b, sinks_b):
    xp, xs = x_prompt, x_sample
    ak_p, av_p, bk_p, bv_p = [], [], [], []
    ak_s, av_s, bk_s, bv_s = [], [], [], []
    for i in range(DEPTH):
        j = i // N_MIXERS
        if i % N_MIXERS == 0:
            mix_p = functools.partial(_mixer_a_prompt, w_qkv=w_qkv_a[j], w_o=w_o_a[j], table=rel_bias_a[j])
            mix_s = functools.partial(_mixer_a_step, w_qkv=w_qkv_a[j], w_o=w_o_a[j], table=rel_bias_a[j],
                                      k_cache=cache_a_k[j], v_cache=cache_a_v[j])
        else:
            mix_p = functools.partial(_mixer_b_prompt, w_qkv=w_qkv_b[j], w_o=w_o_b[j], sinks=sinks_b[j])
            mix_s = functools.partial(_mixer_b_step, w_qkv=w_qkv_b[j], w_o=w_o_b[j], sinks=sinks_b[j],
                                      k_cache=cache_b_k[j], v_cache=cache_b_v[j])
        xp, kp_new, vp_new = _macaron_layer(xp, i, mix_p, ln_g, ln_b, w_ffn_in, w_ffn_down)
        xs, ks_new, vs_new = _macaron_layer(xs, i, mix_s, ln_g, ln_b, w_ffn_in, w_ffn_down)
        if i % N_MIXERS == 0:
            ak_p.append(kp_new); av_p.append(vp_new); ak_s.append(ks_new); av_s.append(vs_new)
        else:
            bk_p.append(kp_new); bv_p.append(vp_new); bk_s.append(ks_new); bv_s.append(vs_new)
    return (xp, xs,
            jnp.stack(ak_p), jnp.stack(av_p), jnp.stack(bk_p), jnp.stack(bv_p),
            jnp.stack(ak_s), jnp.stack(av_s), jnp.stack(bk_s), jnp.stack(bv_s))
```

```cpp
#include <hip/hip_runtime.h>
#include <hip/hip_cooperative_groups.h>
#include <cstdio>
#include <cstdint>
namespace cg = cooperative_groups;
namespace pg8 {
#define PG8_LAS __attribute__((address_space(3)))
typedef unsigned short bf16_t;
typedef short bf16x8 __attribute__((ext_vector_type(8)));
typedef float f32x4 __attribute__((ext_vector_type(4)));
typedef unsigned u32x4 __attribute__((ext_vector_type(4)));
constexpr int BM = 256, BK = 64, HALF = 128, HTB = HALF * BK * 2  , STAGE_BYTES = 8 * HTB, NXCD = 8, WGM = 8;

__host__ __device__ __forceinline__ int lds_byte(int r, int c) { const int st = (r >> 4) * 2 + (c >> 5), rr = r & 15, cc = c & 31, ob = rr * 64 + cc * 2; return st * 1024 + (ob ^ (((ob >> 9) & 1) << 5)); }
__host__ __device__ __forceinline__ void stage_rc(int b, int& R, int& C) { const int st = b / 1024, sb = b % 1024, swz = sb ^ (((sb >> 9) & 1) << 5); R = (st >> 1) * 16 + swz / 64; C = (st & 1) * 32 + (swz % 64) / 2; }
__host__ __device__ __forceinline__ int perm32(int rho) { const int n = rho >> 4, i = rho & 15; return 8 * (i >> 2) + 4 * n + (i & 3); }

struct Unit { int pm, pn; };
struct Gemm { const bf16_t* A; const bf16_t* Bt; int M, N, K; };

struct StaticOrder {
    int nM, nN, nwg, G, c;
    __host__ __device__ void init(int M, int N, int G_, int c_) { nM = M / BM; nN = N / BM; nwg = nM * nN; G = G_; c = c_; }
    __host__ __device__ bool next(int i, Unit& u) const {
        const long L = (long)i * G + c; if (L >= nwg) return false;
        int wgid = (int)L; { const int q = nwg / NXCD, r = nwg % NXCD, xcd = wgid % NXCD, off = wgid / NXCD; wgid = (xcd < r ? xcd * (q + 1) : r * (q + 1) + (xcd - r) * q) + off; }
        const int nig = WGM * nN, gid = wgid / nig, fm = gid * WGM, gsz = (nM - fm) < WGM ? (nM - fm) : WGM;
        u.pm = fm + ((wgid % nig) % gsz); u.pn = (wgid % nig) / gsz; return true;
    }
    __device__ __forceinline__ void a_ready(const Unit&) const {}
    __device__ __forceinline__ void done(const Unit&) const {}
};

__device__ __forceinline__ unsigned cvt_pk_bf16(float lo, float hi) { unsigned r; asm volatile("v_cvt_pk_bf16_f32 %0, %1, %2" : "=v"(r) : "v"(lo), "v"(hi)); return r; }
template <class Epi, class Sched, bool ALIGN_EPI = false, bool SP2 = false>
__device__ __forceinline__ void gemm_phase(PG8_LAS unsigned char* lds, const Gemm g, const Sched& S, const Epi& E) {
    int tid_o = threadIdx.x; asm volatile("" : "+v"(tid_o));
    const int tid = tid_o, wid = __builtin_amdgcn_readfirstlane(tid >> 6), lane = tid & 63, wr = wid >> 2, wc = wid & 3, fr = lane & 15, fq = lane >> 4;
    const int K = g.K, nt = K / BK;
    unsigned voffA[2], voffB[2];
#pragma unroll
    for (int i = 0; i < 2; ++i) { int R, C; stage_rc(tid * 16 + i * 8192, R, C); const int Rb = Epi::PERM ? ((R & ~31) + perm32(R & 31)) : R;
        voffA[i] = (unsigned)(R * K + C) * 2u; voffB[i] = (unsigned)(Rb * K + C) * 2u; }
    const size_t kstep = (size_t)(BK * 2);
    const size_t hstep = (size_t)HALF * K * 2;
    const size_t tstep = 2 * hstep;
    const unsigned ldsw = (unsigned)wid * 1024u;
    const int aoff = lds_byte(wr * 64 + fr, fq * 8), boff = lds_byte(wc * 32 + fr, fq * 8);
#define PG8_SA(b, h) (((b) * 2 + (h)) * HTB)
#define PG8_SB(b, h) ((4 + (b) * 2 + (h)) * HTB)
#define PG8_STAGE(bufoff, gbase, voff) do { _Pragma("unroll") for (int _i = 0; _i < 2; ++_i) \
        __builtin_amdgcn_global_load_lds((const unsigned*)((const char*)(gbase) + (voff)[_i]), (PG8_LAS unsigned*)(lds + (bufoff) + ldsw + _i * 8192), 16, 0, 0); } while (0)
#define PG8_LDA(dst, b, h) do { _Pragma("unroll") for (int m = 0; m < 4; ++m) _Pragma("unroll") for (int k = 0; k < 2; ++k) dst[m][k] = *(const PG8_LAS bf16x8*)(lds + PG8_SA(b, h) + aoff + m * 2048 + k * 1024); } while (0)
#define PG8_LDB(dst, b, h) do { _Pragma("unroll") for (int n = 0; n < 2; ++n) _Pragma("unroll") for (int k = 0; k < 2; ++k) dst[n][k] = *(const PG8_LAS bf16x8*)(lds + PG8_SB(b, h) + boff + n * 2048 + k * 1024); } while (0)
#define PG8_MMA(ai, bj, At, Bt) do { __builtin_amdgcn_s_setprio(1); _Pragma("unroll") for (int m = 0; m < 4; ++m) _Pragma("unroll") for (int n = 0; n < 2; ++n) _Pragma("unroll") for (int k = 0; k < 2; ++k) \
        acc[ai][bj][m][n] = __builtin_amdgcn_mfma_f32_16x16x32_bf16(Bt[n][k], At[m][k], acc[ai][bj][m][n], 0, 0, 0); __builtin_amdgcn_s_setprio(0); } while (0)
#define PG8_WAIT_V(n) asm volatile("s_waitcnt vmcnt(" #n ")" ::: "memory")
#define PG8_WAIT_L(n) asm volatile("s_waitcnt lgkmcnt(" #n ")" ::: "memory")
#define PG8_BAR __builtin_amdgcn_s_barrier()
#define PG8_SCHED __builtin_amdgcn_sched_barrier(0)
    Unit cur, nxt; int ui = 0;
    if (!S.next(0, cur)) return;
    f32x4 acc[2][2][4][2];
#pragma unroll
    for (int a = 0; a < 2; ++a)
#pragma unroll
        for (int b = 0; b < 2; ++b)
#pragma unroll
            for (int m = 0; m < 4; ++m)
#pragma unroll
                for (int n = 0; n < 2; ++n) acc[a][b][m][n] = (f32x4){0.f, 0.f, 0.f, 0.f};
    bf16x8 At[4][2], B0[2][2], B1[2][2];
    const char* cA = (const char*)g.A + (size_t)cur.pm * tstep; const char* cB = (const char*)g.Bt + (size_t)cur.pn * tstep;
    S.a_ready(cur);
    if constexpr (SP2) {
        PG8_STAGE(PG8_SB(0, 0), cB, voffB); PG8_STAGE(PG8_SB(0, 1), cB + hstep, voffB); PG8_STAGE(PG8_SA(0, 0), cA, voffA); PG8_STAGE(PG8_SA(0, 1), cA + hstep, voffA);
        if (wr == 1) PG8_BAR;
        PG8_WAIT_V(2); PG8_BAR;
        PG8_STAGE(PG8_SB(1, 0), cB + kstep, voffB); PG8_STAGE(PG8_SA(1, 0), cA + kstep, voffA); PG8_STAGE(PG8_SB(1, 1), cB + hstep + kstep, voffB);
        PG8_WAIT_V(6); PG8_BAR;
    } else {
        PG8_STAGE(PG8_SB(0, 0), cB, voffB); PG8_STAGE(PG8_SA(0, 0), cA, voffA); PG8_STAGE(PG8_SB(0, 1), cB + hstep, voffB); PG8_STAGE(PG8_SA(0, 1), cA + hstep, voffA);
        if (wr == 1) PG8_BAR;
        PG8_WAIT_V(4); PG8_BAR;
        PG8_STAGE(PG8_SB(1, 0), cB + kstep, voffB); PG8_STAGE(PG8_SA(1, 0), cA + kstep, voffA); PG8_STAGE(PG8_SB(1, 1), cB + hstep + kstep, voffB);
        PG8_WAIT_V(6); PG8_BAR;
    }
    for (;;) {
        const bool has_next = S.next(ui + 1, nxt);
        const char* nA = has_next ? (const char*)g.A + (size_t)nxt.pm * tstep : cA; const char* nB = has_next ? (const char*)g.Bt + (size_t)nxt.pn * tstep : cB;
        for (int t = 0; t < nt; t += 2) {
            const bool last = (t == nt - 2);
            const char* a1 = cA + (size_t)(t + 1) * kstep;
            const char* a2 = last ? nA : cA + (size_t)(t + 2) * kstep; const char* b2 = last ? nB : cB + (size_t)(t + 2) * kstep;
            const char* a3 = a2 + kstep; const char* b3 = b2 + kstep;
            if (last && has_next) S.a_ready(nxt);
            if constexpr (SP2) {
            PG8_LDB(B0, 0, 0); PG8_LDB(B1, 0, 1); PG8_SCHED; PG8_LDA(At, 0, 0); PG8_STAGE(PG8_SA(1, 1), a1 + hstep, voffA);
            PG8_WAIT_V(8); PG8_WAIT_L(0); PG8_BAR; PG8_MMA(0, 0, At, B0); PG8_MMA(0, 1, At, B1); PG8_BAR; PG8_SCHED;
            PG8_LDA(At, 0, 1); PG8_STAGE(PG8_SB(0, 0), b2, voffB); PG8_STAGE(PG8_SB(0, 1), b2 + hstep, voffB); PG8_STAGE(PG8_SA(0, 0), a2, voffA);
            PG8_WAIT_V(8); PG8_WAIT_L(0); PG8_BAR; PG8_MMA(1, 0, At, B0); PG8_MMA(1, 1, At, B1); PG8_BAR; PG8_SCHED;
            PG8_LDB(B0, 1, 0); PG8_LDB(B1, 1, 1); PG8_SCHED; PG8_LDA(At, 1, 0); PG8_STAGE(PG8_SA(0, 1), a2 + hstep, voffA);
            PG8_WAIT_V(8); PG8_WAIT_L(0); PG8_BAR; PG8_MMA(0, 0, At, B0); PG8_MMA(0, 1, At, B1); PG8_BAR; PG8_SCHED;
            PG8_LDA(At, 1, 1); PG8_STAGE(PG8_SB(1, 0), b3, voffB); PG8_STAGE(PG8_SB(1, 1), b3 + hstep, voffB); PG8_STAGE(PG8_SA(1, 0), a3, voffA);
            PG8_WAIT_V(8); PG8_WAIT_L(0); PG8_BAR; PG8_MMA(1, 0, At, B0); PG8_MMA(1, 1, At, B1); PG8_BAR; PG8_SCHED;
            } else {
            PG8_LDB(B0, 0, 0); PG8_SCHED; PG8_LDA(At, 0, 0); PG8_STAGE(PG8_SA(1, 1), a1 + hstep, voffA);
            PG8_WAIT_L(8); PG8_BAR; PG8_WAIT_L(0); PG8_MMA(0, 0, At, B0); PG8_BAR; PG8_SCHED;
            PG8_LDB(B1, 0, 1); PG8_STAGE(PG8_SB(0, 0), b2, voffB);
            PG8_BAR; PG8_WAIT_L(0); PG8_MMA(0, 1, At, B1); PG8_BAR;
            PG8_LDA(At, 0, 1); PG8_STAGE(PG8_SA(0, 0), a2, voffA);
            PG8_BAR; PG8_WAIT_L(0); PG8_MMA(1, 0, At, B0); PG8_BAR; PG8_SCHED;
            PG8_STAGE(PG8_SB(0, 1), b2 + hstep, voffB);
            PG8_WAIT_V(6); PG8_BAR; PG8_MMA(1, 1, At, B1); PG8_BAR;
            PG8_LDB(B0, 1, 0); PG8_SCHED; PG8_LDA(At, 1, 0); PG8_STAGE(PG8_SA(0, 1), a2 + hstep, voffA);
            PG8_WAIT_L(8); PG8_BAR; PG8_WAIT_L(0); PG8_MMA(0, 0, At, B0); PG8_BAR; PG8_SCHED;
            PG8_LDB(B1, 1, 1); PG8_STAGE(PG8_SB(1, 0), b3, voffB);
            PG8_BAR; PG8_WAIT_L(0); PG8_MMA(0, 1, At, B1); PG8_BAR;
            PG8_LDA(At, 1, 1); PG8_STAGE(PG8_SA(1, 0), a3, voffA);
            PG8_BAR; PG8_WAIT_L(0); PG8_MMA(1, 0, At, B0); PG8_BAR; PG8_SCHED;
            PG8_STAGE(PG8_SB(1, 1), b3 + hstep, voffB);
            PG8_WAIT_V(6); PG8_BAR; PG8_MMA(1, 1, At, B1); PG8_BAR;
            }
        }
        if constexpr (ALIGN_EPI) { if (wr == 0) PG8_BAR; }
        if constexpr (!Epi::AFTER_DRAIN) { E(acc, cur, wr, wc, fr, fq); S.done(cur); }
        if (!has_next) break;
#pragma unroll
        for (int a = 0; a < 2; ++a)
#pragma unroll
            for (int b = 0; b < 2; ++b)
#pragma unroll
                for (int m = 0; m < 4; ++m)
#pragma unroll
                    for (int n = 0; n < 2; ++n) acc[a][b][m][n] = (f32x4){0.f, 0.f, 0.f, 0.f};
        cur = nxt; cA = nA; cB = nB; ++ui;
        if constexpr (ALIGN_EPI) { if (wr == 1) PG8_BAR; }
    }
    PG8_WAIT_V(0);
    if constexpr (!ALIGN_EPI) { if (wr == 0) PG8_BAR; }
    PG8_BAR;
    if constexpr (Epi::AFTER_DRAIN) { E.fused(acc, cur, wr, wc, fr, fq, lds, wid, lane); S.done(cur); }
#undef PG8_SA
#undef PG8_SB
#undef PG8_STAGE
#undef PG8_LDA
#undef PG8_LDB
#undef PG8_MMA
#undef PG8_WAIT_V
#undef PG8_WAIT_L
#undef PG8_BAR
#undef PG8_SCHED
}
}
constexpr int DM = 1024, FF = 2816, MP = 32768, MS = 256, MT = MP + MS, SEQ = 2048;
constexpr float ALPHA = 1.4142135623730951f;
constexpr float LOG2E = 1.4426950408889634f;
typedef pg8::bf16_t bf16_t;
typedef pg8::bf16x8 bf16x8;
typedef pg8::f32x4 f32x4;
typedef pg8::u32x4 u32x4;
typedef float f32x2v __attribute__((ext_vector_type(2)));
typedef float f32x16 __attribute__((ext_vector_type(16)));
typedef unsigned u32x2 __attribute__((ext_vector_type(2)));
#define LAS __attribute__((address_space(3)))

constexpr size_t MiB = 1u << 20;
constexpr size_t WS_WIN = 1 * MiB;
constexpr size_t WS_WDN = 45 * MiB;
constexpr size_t WS_WQKVA = 67 * MiB;
constexpr size_t WS_WOA = 73 * MiB;
constexpr size_t WS_WQKVB = 75 * MiB;
constexpr size_t WS_WOB = 78 * MiB;
constexpr size_t WS_MISC = 80 * MiB;
constexpr size_t WS_STA = 82 * MiB;
constexpr size_t WS_STB = 87 * MiB;
constexpr size_t WS_ZB = 92 * MiB;
constexpr size_t WS_KSA = 157 * MiB;
constexpr size_t WS_VTSA = 174 * MiB;
constexpr size_t WS_KSB = 191 * MiB;
constexpr size_t WS_VTSB = 193 * MiB;
constexpr size_t WS_BIG = 195 * MiB;
constexpr size_t BIG_K = (size_t)MT * DM * 2, BIG_VT = BIG_K + (size_t)MP * DM * 2;
constexpr size_t WS_END = 388 * MiB;
constexpr int MC_WIN = 0;
constexpr int MC_QKVA = 4 * 2 * 5632;
constexpr int MC_QKVB = MC_QKVA + 2 * 3072;
constexpr int MC_ROPE = MC_QKVB + 2 * 1536;
constexpr int LDS_BYTES = 131072;
struct Args { const float* in[16]; float* out; unsigned char* ws; int ph_lo, ph_hi; };
typedef const __attribute__((address_space(4))) Args* ArgsP;
__device__ __forceinline__ ArgsP get_args() { ArgsP p = (ArgsP)__builtin_amdgcn_kernarg_segment_ptr(); asm volatile("" : "+s"(p)); return p; }
constexpr size_t OUT_YP = 0, OUT_YS = (size_t)MP * DM, OUT_AKP = OUT_YS + (size_t)MS * DM, OUT_AVP = OUT_AKP + (size_t)16 * 512 * 1024, OUT_BKP = OUT_AVP + (size_t)16 * 512 * 1024,
                 OUT_BVP = OUT_BKP + (size_t)16 * 128 * 256, OUT_AKS = OUT_BVP + (size_t)16 * 128 * 256, OUT_AVS = OUT_AKS + (size_t)16 * 16 * 1024, OUT_BKS = OUT_AVS + (size_t)16 * 16 * 1024,
                 OUT_BVS = OUT_BKS + (size_t)16 * 16 * 256, OUT_END = OUT_BVS + (size_t)16 * 16 * 256;


__device__ __forceinline__ unsigned f2bf(float f) { unsigned u = __builtin_bit_cast(unsigned, f); return (u + 0x7fffu + ((u >> 16) & 1u)) >> 16; }
__device__ __forceinline__ unsigned pk2(float lo, float hi) { return f2bf(lo) | (f2bf(hi) << 16); }
__device__ __forceinline__ float bfround(float f) { return __builtin_bit_cast(float, f2bf(f) << 16); }
__device__ __forceinline__ u32x2 pk4(f32x4 v) { u32x2 r; r.x = pg8::cvt_pk_bf16(v[0], v[1]); r.y = pg8::cvt_pk_bf16(v[2], v[3]); return r; }
__device__ __forceinline__ float wave_sum(float v) {
#pragma unroll
    for (int o = 1; o < 64; o <<= 1) v += __shfl_xor(v, o);
    return v;
}

namespace pg8 {
__device__ __forceinline__ void row_mean_rstd(const float* st, int row, int fq, float& mean, float& rstd) {
    const f32x4* p = (const f32x4*)(st + (unsigned)row * 32 + 8 * fq);
    const f32x4 a = p[0], b = p[1];
    float s = (a[0] + a[2]) + (b[0] + b[2]), q = (a[1] + a[3]) + (b[1] + b[3]);
    s += __shfl_xor(s, 16); s += __shfl_xor(s, 32); q += __shfl_xor(q, 16); q += __shfl_xor(q, 32);
    mean = s * (1.0f / 1024.0f);
    const float var = fmaxf(q * (1.0f / 1024.0f) - mean * mean, 0.f);
    rstd = 1.0f / sqrtf(var + 1e-5f);
}

struct EpiSwiglu {
    static constexpr bool PERM = false, AFTER_DRAIN = false;
    int w, cnt;
    __device__ __forceinline__ void operator()(const f32x4 (&acc)[2][2][4][2], const Unit& u, int wr, int wc, int fr, int fq) const {
        unsigned char* wsp = get_args()->ws;
        bf16_t* H = (bf16_t*)(wsp + WS_BIG); const float* st = cnt == 0 ? nullptr : (const float*)(wsp + ((cnt & 1) ? WS_STA : WS_STB));
        const float* c1 = (const float*)(wsp + WS_MISC) + MC_WIN + w * 2 * 5632; const float* c2 = c1 + 5632;
        const int sb0 = u.pn * 256 + wc * 32 + 4 * fq;
        const int ff0 = u.pn * 128 + wc * 16 + 4 * fq;
        const bool fold = (st != nullptr);
#pragma unroll
        for (int ai = 0; ai < 2; ++ai)
#pragma unroll
            for (int m = 0; m < 4; ++m) {
                const int row = u.pm * 256 + ai * 128 + wr * 64 + m * 16 + fr;
                float mean = 0.f, rstd = 1.f;
                if (fold) row_mean_rstd(st, row, fq, mean, rstd);
#pragma unroll
                for (int bj = 0; bj < 2; ++bj) {
                    f32x4 g = acc[ai][bj][m][0], up = acc[ai][bj][m][1];
                    if (fold) {
                        const f32x4 c1g = *(const f32x4*)(c1 + sb0 + bj * 128), c1u = *(const f32x4*)(c1 + sb0 + bj * 128 + 16);
                        const f32x4 c2g = *(const f32x4*)(c2 + sb0 + bj * 128), c2u = *(const f32x4*)(c2 + sb0 + bj * 128 + 16);
                        g = (g - mean * c1g) * rstd + c2g; up = (up - mean * c1u) * rstd + c2u;
                    }
                    f32x4 hv;
#pragma unroll
                    for (int j = 0; j < 4; ++j) hv[j] = g[j] * __builtin_amdgcn_rcpf(1.0f + __expf(-g[j])) * up[j];
                    *(u32x2*)(H + (unsigned)row * FF + ff0 + bj * 64) = pk4(hv);
                }
            }
    }
};

struct EpiResid {
    static constexpr bool PERM = false, AFTER_DRAIN = false;
    int cnt; float cs;
    __device__ __forceinline__ void operator()(const f32x4 (&acc)[2][2][4][2], const Unit& u, int wr, int wc, int fr, int fq) const {
        unsigned char* wsp = get_args()->ws;
        float* Z = get_args()->out; const float* xp = get_args()->in[0]; const float* xs = get_args()->in[1];
        const float* stp = cnt == 0 ? nullptr : (const float*)(wsp + ((cnt & 1) ? WS_STA : WS_STB)); float* stn = (float*)(wsp + ((cnt & 1) ? WS_STB : WS_STA));
        const int lni = cnt > 0 ? cnt - 1 : 0;
        const float* g = get_args()->in[6] + lni * DM; const float* b = get_args()->in[7] + lni * DM; bf16_t* Zb = (bf16_t*)(wsp + WS_ZB);
        const int col0 = u.pn * 256 + wc * 32 + 4 * fq;
        const bool first = (stp == nullptr);
#pragma unroll
        for (int ai = 0; ai < 2; ++ai)
#pragma unroll
            for (int m = 0; m < 4; ++m) {
                const int row = u.pm * 256 + ai * 128 + wr * 64 + m * 16 + fr;
                float mean = 0.f, rstd = 1.f;
                if (!first) row_mean_rstd(stp, row, fq, mean, rstd);
                const float* src = first ? (u.pm < 128 ? xp + (unsigned)row * DM : xs + (unsigned)(row - MP) * DM) : Z + (unsigned)row * DM;
                float s = 0.f, q = 0.f;
#pragma unroll
                for (int bj = 0; bj < 2; ++bj)
#pragma unroll
                    for (int n = 0; n < 2; ++n) {
                        const int col = col0 + bj * 128 + n * 16;
                        f32x4 x = *(const f32x4*)(src + col);
                        if (!first) { const f32x4 gv = *(const f32x4*)(g + col), bv = *(const f32x4*)(b + col); x = (x - mean) * rstd * gv + bv; }
                        const f32x4 zn = ALPHA * x + cs * acc[ai][bj][m][n];
                        *(f32x4*)(Z + (unsigned)row * DM + col) = zn;
                        *(u32x2*)(Zb + (unsigned)row * DM + col) = pk4(zn);
                        s += (zn[0] + zn[1]) + (zn[2] + zn[3]);
                        q += (zn[0] * zn[0] + zn[1] * zn[1]) + (zn[2] * zn[2] + zn[3] * zn[3]);
                    }
                s += __shfl_xor(s, 16); s += __shfl_xor(s, 32); q += __shfl_xor(q, 16); q += __shfl_xor(q, 32);
                if (fq == 0) *(f32x2v*)(stn + (unsigned)row * 32 + (u.pn * 4 + wc) * 2) = (f32x2v){s, q};
            }
    }
};

struct EpiQkvA {
    static constexpr bool PERM = false, AFTER_DRAIN = false;
    int cnt;
    __device__ __forceinline__ void operator()(const f32x4 (&acc)[2][2][4][2], const Unit& u, int wr, int wc, int fr, int fq) const {
        unsigned char* wsp = get_args()->ws; float* outp = get_args()->out;
        const float* st = (const float*)(wsp + ((cnt & 1) ? WS_STA : WS_STB)); const float* c1 = (const float*)(wsp + WS_MISC) + MC_QKVA; const float* c2 = c1 + 3072;
        bf16_t* Q = (bf16_t*)(wsp + WS_BIG); bf16_t* Kp = (bf16_t*)(wsp + WS_BIG + BIG_K); bf16_t* Vtp = (bf16_t*)(wsp + WS_BIG + BIG_VT); bf16_t* Ks = (bf16_t*)(wsp + WS_KSA); bf16_t* Vts = (bf16_t*)(wsp + WS_VTSA);
        float* okp = outp + OUT_AKP; float* ovp = outp + OUT_AVP; float* oks = outp + OUT_AKS; float* ovs = outp + OUT_AVS;
        const int typ = u.pn >> 2, hc0 = (u.pn & 3) * 256 + wc * 32 + 4 * fq, ns0 = u.pn * 256 + wc * 32 + 4 * fq;
        const bool sample = (u.pm == 128);
#pragma unroll
        for (int ai = 0; ai < 2; ++ai)
#pragma unroll
            for (int m = 0; m < 4; ++m) {
                const int row = u.pm * 256 + ai * 128 + wr * 64 + m * 16 + fr;
                float mean, rstd; row_mean_rstd(st, row, fq, mean, rstd);
                int b, pos; if (!sample) { b = row >> 11; pos = row & 2047; } else { const int r = row - MP; b = r >> 4; pos = r & 15; }
#pragma unroll
                for (int bj = 0; bj < 2; ++bj)
#pragma unroll
                    for (int n = 0; n < 2; ++n) {
                        const int hc = hc0 + bj * 128 + n * 16;
                        const f32x4 v = (acc[ai][bj][m][n] - mean * *(const f32x4*)(c1 + ns0 + bj * 128 + n * 16)) * rstd + *(const f32x4*)(c2 + ns0 + bj * 128 + n * 16);
                        if (typ == 0) { *(u32x2*)(Q + (unsigned)row * DM + hc) = pk4(v); }
                        else if (typ == 1) {
                            if (!sample) { *(u32x2*)(Kp + (unsigned)row * DM + hc) = pk4(v); if (pos >= 1536) *(f32x4*)(okp + ((unsigned)(b * 512 + pos - 1536) * DM + hc)) = v; }
                            else { *(u32x2*)(Ks + ((unsigned)(b * 544 + 512 + pos) * DM + hc)) = pk4(v); *(f32x4*)(oks + ((unsigned)(b * 16 + pos) * DM + hc)) = v; }
                        } else {
                            const int h = hc >> 6, d = hc & 63;
                            if (!sample) {
                                bf16_t* vt = Vtp + ((unsigned)((b * 16 + h) * 64 + d) * 2048 + pos);
#pragma unroll
                                for (int j = 0; j < 4; ++j) vt[(unsigned)j * 2048] = (bf16_t)f2bf(v[j]);
                                if (pos >= 1536) *(f32x4*)(ovp + ((unsigned)(b * 512 + pos - 1536) * DM + hc)) = v;
                            } else {
                                bf16_t* vt = Vts + ((unsigned)((b * 16 + h) * 64 + d) * 544 + 512 + pos);
#pragma unroll
                                for (int j = 0; j < 4; ++j) vt[(unsigned)j * 544] = (bf16_t)f2bf(v[j]);
                                *(f32x4*)(ovs + ((unsigned)(b * 16 + pos) * DM + hc)) = v;
                            }
                        }
                    }
            }
    }
};

struct EpiQkvB {
    static constexpr bool PERM = false, AFTER_DRAIN = false;
    int cnt;
    __device__ __forceinline__ void operator()(const f32x4 (&acc)[2][2][4][2], const Unit& u, int wr, int wc, int fr, int fq) const {
        unsigned char* wsp = get_args()->ws; float* outp = get_args()->out;
        const float* st = (const float*)(wsp + ((cnt & 1) ? WS_STA : WS_STB)); const float* c1 = (const float*)(wsp + WS_MISC) + MC_QKVB; const float* c2 = c1 + 1536; const float* rope = (const float*)(wsp + WS_MISC) + MC_ROPE;
        bf16_t* Q = (bf16_t*)(wsp + WS_BIG); bf16_t* Kp = (bf16_t*)(wsp + WS_BIG + BIG_K); bf16_t* Vtp = (bf16_t*)(wsp + WS_BIG + BIG_VT); bf16_t* Ks = (bf16_t*)(wsp + WS_KSB); bf16_t* Vts = (bf16_t*)(wsp + WS_VTSB);
        float* okp = outp + OUT_BKP; float* ovp = outp + OUT_BVP; float* oks = outp + OUT_BKS; float* ovs = outp + OUT_BVS;
        const int ns0 = u.pn * 256 + wc * 32 + 4 * fq;
        const bool sample = (u.pm == 128);
        const int dlo = 16 * (wc & 1) + 4 * fq;
#pragma unroll
        for (int ai = 0; ai < 2; ++ai)
#pragma unroll
            for (int m = 0; m < 4; ++m) {
                const int row = u.pm * 256 + ai * 128 + wr * 64 + m * 16 + fr;
                float mean, rstd; row_mean_rstd(st, row, fq, mean, rstd);
                int b, pos; if (!sample) { b = row >> 11; pos = row & 2047; } else { const int r = row - MP; b = r >> 4; pos = r & 15; }
                if (u.pn < 5) {
                    const int rp = sample ? 2048 + pos : pos;
                    const f32x4 cs0 = *(const f32x4*)(rope + ((unsigned)rp * 32 + dlo) * 2), cs1 = *(const f32x4*)(rope + ((unsigned)rp * 32 + dlo) * 2 + 4);
                    const f32x4 cc = (f32x4){cs0[0], cs0[2], cs1[0], cs1[2]}, ss = (f32x4){cs0[1], cs0[3], cs1[1], cs1[3]};
#pragma unroll
                    for (int bj = 0; bj < 2; ++bj) {
                        const f32x4 x1 = (acc[ai][bj][m][0] - mean * *(const f32x4*)(c1 + ns0 + bj * 128)) * rstd + *(const f32x4*)(c2 + ns0 + bj * 128);
                        const f32x4 x2 = (acc[ai][bj][m][1] - mean * *(const f32x4*)(c1 + ns0 + bj * 128 + 16)) * rstd + *(const f32x4*)(c2 + ns0 + bj * 128 + 16);
                        const f32x4 lo = x1 * cc - x2 * ss, hi = x2 * cc + x1 * ss;
                        const int hit = bj * 2 + (wc >> 1);
                        if (u.pn < 4) {
                            const int hc = (u.pn * 4 + hit) * 64 + dlo;
                            *(u32x2*)(Q + (unsigned)row * DM + hc) = pk4(lo); *(u32x2*)(Q + (unsigned)row * DM + hc + 32) = pk4(hi);
                        } else {
                            const int kc = hit * 64 + dlo;
                            if (!sample) {
                                *(u32x2*)(Kp + (unsigned)row * 256 + kc) = pk4(lo); *(u32x2*)(Kp + (unsigned)row * 256 + kc + 32) = pk4(hi);
                                if (pos >= 1920) { float* o = okp + ((unsigned)(b * 128 + pos - 1920) * 256 + kc); *(f32x4*)o = lo; *(f32x4*)(o + 32) = hi; }
                            } else {
                                bf16_t* kd = Ks + ((unsigned)(b * 160 + 128 + pos) * 256 + kc); *(u32x2*)kd = pk4(lo); *(u32x2*)(kd + 32) = pk4(hi);
                                float* o = oks + ((unsigned)(b * 16 + pos) * 256 + kc); *(f32x4*)o = lo; *(f32x4*)(o + 32) = hi;
                            }
                        }
                    }
                } else {
#pragma unroll
                    for (int bj = 0; bj < 2; ++bj)
#pragma unroll
                        for (int n = 0; n < 2; ++n) {
                            const int hc = bj * 128 + wc * 32 + n * 16 + 4 * fq, kvh = hc >> 6, d = hc & 63;
                            const f32x4 v = (acc[ai][bj][m][n] - mean * *(const f32x4*)(c1 + ns0 + bj * 128 + n * 16)) * rstd + *(const f32x4*)(c2 + ns0 + bj * 128 + n * 16);
                            if (!sample) {
                                bf16_t* vt = Vtp + ((unsigned)((b * 4 + kvh) * 64 + d) * 2048 + pos);
#pragma unroll
                                for (int j = 0; j < 4; ++j) vt[(unsigned)j * 2048] = (bf16_t)f2bf(v[j]);
                                if (pos >= 1920) *(f32x4*)(ovp + ((unsigned)(b * 128 + pos - 1920) * 256 + hc)) = v;
                            } else {
                                bf16_t* vt = Vts + ((unsigned)((b * 4 + kvh) * 64 + d) * 160 + 128 + pos);
#pragma unroll
                                for (int j = 0; j < 4; ++j) vt[(unsigned)j * 160] = (bf16_t)f2bf(v[j]);
                                *(f32x4*)(ovs + ((unsigned)(b * 16 + pos) * 256 + hc)) = v;
                            }
                        }
                }
            }
    }
};
}
template <bool MODE_A>
__device__ __forceinline__ void attn_wave(const bf16_t* Qrow0, int ldq, int nq, const bf16_t* Kb, int ldk, const bf16_t* Vt, int ldv,
                                          int kt0, int kt1, int nvalid, int qpos0, const float* tab, float sink, bf16_t* Orow0, int ldo, int lane) {
    const int r = lane & 31, h = lane >> 5;
    const int qr = r < nq ? r : nq - 1;
    bf16x8 qf[4];
#pragma unroll
    for (int s = 0; s < 4; ++s) qf[s] = *(const bf16x8*)(Qrow0 + (size_t)qr * ldq + 16 * s + 8 * h);
    const int pr = (r & ~12) | ((r & 4) << 1) | ((r & 8) >> 1);
    f32x16 O0, O1;
#pragma unroll
    for (int i = 0; i < 16; ++i) { O0[i] = 0.f; O1[i] = 0.f; }
    float mrun = MODE_A ? -1e30f : sink * LOG2E;
    float l = MODE_A ? 0.f : (h == 0 ? 1.f : 0.f);
    const float SC = 0.125f * LOG2E;
    const float tconst = MODE_A ? tab[256] * LOG2E : 0.f;
    for (int kt = kt0; kt < kt1; ++kt) {
        const int k0 = kt * 32;
        const bf16_t* kp = Kb + (size_t)(k0 + pr) * ldk + 8 * h;
        bf16x8 kf[4], vf[2][2];
#pragma unroll
        for (int s = 0; s < 4; ++s) kf[s] = *(const bf16x8*)(kp + 16 * s);
#pragma unroll
        for (int dt = 0; dt < 2; ++dt)
#pragma unroll
            for (int s = 0; s < 2; ++s) vf[dt][s] = *(const bf16x8*)(Vt + (size_t)(dt * 32 + r) * ldv + k0 + 16 * s + 8 * h);
        f32x16 S;
#pragma unroll
        for (int i = 0; i < 16; ++i) S[i] = 0.f;
#pragma unroll
        for (int s = 0; s < 4; ++s) S = __builtin_amdgcn_mfma_f32_32x32x16_bf16(kf[s], qf[s], S, 0, 0, 0);
        float t[16];
        const int qp = qpos0 + r;
        const bool farblk = MODE_A && (qpos0 - (k0 + 31) >= 128);
        float mx = -1e30f;
#pragma unroll
        for (int i = 0; i < 16; ++i) {
            const int key = k0 + 16 * (i >> 3) + 8 * h + (i & 7);
            float bias = 0.f;
            if (MODE_A) {
                if (farblk) bias = tconst;
                else { int rel = qp - key; rel = rel < -128 ? -128 : (rel > 128 ? 128 : rel); bias = tab[rel + 128] * LOG2E; }
            }
            float v = S[i] * SC + bias;
            if (key >= nvalid) v = -1e30f;
            t[i] = v; mx = fmaxf(mx, v);
        }
        mx = fmaxf(mx, __shfl_xor(mx, 32));
        const float mnew = fmaxf(mrun, mx);
        const float alpha = __builtin_amdgcn_exp2f(mrun - mnew);
        mrun = mnew;
        float ps = 0.f;
#pragma unroll
        for (int i = 0; i < 16; ++i) { t[i] = __builtin_amdgcn_exp2f(t[i] - mnew); ps += t[i]; }
        l = l * alpha + ps;
#pragma unroll
        for (int i = 0; i < 16; ++i) { O0[i] *= alpha; O1[i] *= alpha; }
        bf16x8 pf[2];
#pragma unroll
        for (int s = 0; s < 2; ++s) {
            u32x4 w; w.x = pg8::cvt_pk_bf16(t[8 * s + 0], t[8 * s + 1]); w.y = pg8::cvt_pk_bf16(t[8 * s + 2], t[8 * s + 3]);
            w.z = pg8::cvt_pk_bf16(t[8 * s + 4], t[8 * s + 5]); w.w = pg8::cvt_pk_bf16(t[8 * s + 6], t[8 * s + 7]);
            pf[s] = __builtin_bit_cast(bf16x8, w);
        }
        O0 = __builtin_amdgcn_mfma_f32_32x32x16_bf16(vf[0][0], pf[0], O0, 0, 0, 0);
        O0 = __builtin_amdgcn_mfma_f32_32x32x16_bf16(vf[0][1], pf[1], O0, 0, 0, 0);
        O1 = __builtin_amdgcn_mfma_f32_32x32x16_bf16(vf[1][0], pf[0], O1, 0, 0, 0);
        O1 = __builtin_amdgcn_mfma_f32_32x32x16_bf16(vf[1][1], pf[1], O1, 0, 0, 0);
    }
    l += __shfl_xor(l, 32);
    const float inv = 1.0f / l;
    if (r < nq) {
        bf16_t* op = Orow0 + (size_t)r * ldo + 4 * h;
#pragma unroll
        for (int g = 0; g < 4; ++g) {
            f32x4 a = (f32x4){O0[4 * g], O0[4 * g + 1], O0[4 * g + 2], O0[4 * g + 3]} * inv;
            f32x4 b = (f32x4){O1[4 * g], O1[4 * g + 1], O1[4 * g + 2], O1[4 * g + 3]} * inv;
            *(u32x2*)(op + 8 * g) = pk4(a);
            *(u32x2*)(op + 32 + 8 * g) = pk4(b);
        }
    }
}

__device__ __forceinline__ void prep_weight_item(const float* W, int K, int N, int cb0, int cb1, const float* g, const float* b, bf16_t* Bt, int row0, float* c1, float* c2,
                                                 LAS float* scr, int lane) {
    const int c = lane & 31, col = c < 16 ? cb0 + c : cb1 + c - 16;
    float a1 = 0.f, a2 = 0.f;
    for (int k0 = 0; k0 < K; k0 += 64) {
#pragma unroll 8
        for (int i = 0; i < 32; ++i) {
            const int kk = 2 * i + (lane >> 5);
            const float w = W[(size_t)(k0 + kk) * N + col];
            float v = w;
            if (g) { v = w * g[k0 + kk]; a2 += w * b[k0 + kk]; }
            v = bfround(v); a1 += v;
            scr[kk * 33 + c] = v;
        }
        asm volatile("s_waitcnt lgkmcnt(0)" ::: "memory");
        const int c8 = lane & 7;
#pragma unroll
        for (int j = 0; j < 4; ++j) {
            const int n = (lane >> 3) + 8 * j; const LAS float* s = scr + (8 * c8) * 33 + n;
            u32x4 o;
            o.x = (__builtin_bit_cast(unsigned, s[0 * 33]) >> 16) | (__builtin_bit_cast(unsigned, s[1 * 33]) & 0xffff0000u);
            o.y = (__builtin_bit_cast(unsigned, s[2 * 33]) >> 16) | (__builtin_bit_cast(unsigned, s[3 * 33]) & 0xffff0000u);
            o.z = (__builtin_bit_cast(unsigned, s[4 * 33]) >> 16) | (__builtin_bit_cast(unsigned, s[5 * 33]) & 0xffff0000u);
            o.w = (__builtin_bit_cast(unsigned, s[6 * 33]) >> 16) | (__builtin_bit_cast(unsigned, s[7 * 33]) & 0xffff0000u);
            *(u32x4*)(Bt + (size_t)(row0 + n) * K + k0 + 8 * c8) = o;
        }
        asm volatile("s_waitcnt lgkmcnt(0)" ::: "memory");
    }
    a1 += __shfl_xor(a1, 32); a2 += __shfl_xor(a2, 32);
    if (c1 && lane < 32) { c1[row0 + c] = a1; c2[row0 + c] = a2; }
}
constexpr int N_PHASES = 16;
__device__ const double ROPE_INV[32] = {1.0, 0.7498942093324559, 0.5623413251903491, 0.4216965034285822, 0.31622776601683794, 0.23713737056616552, 0.1778279410038923, 0.1333521432163324, 0.1,
    0.07498942093324558, 0.05623413251903491, 0.042169650342858224, 0.03162277660168379, 0.023713737056616554, 0.01778279410038923, 0.01333521432163324, 0.01, 0.007498942093324558,
    0.005623413251903491, 0.004216965034285823, 0.0031622776601683794, 0.0023713737056616554, 0.0017782794100389228, 0.001333521432163324, 0.001, 0.0007498942093324559, 0.0005623413251903491,
    0.00042169650342858224, 0.00031622776601683794, 0.00023713737056616554, 0.00017782794100389227, 0.0001333521432163324};


#define AIN(i) ((const float*)get_args()->in[i])
#define x_p AIN(0)
#define x_s AIN(1)
#define cak AIN(2)
#define cav AIN(3)
#define cbk AIN(4)
#define cbv AIN(5)
#define ln_g AIN(6)
#define ln_b AIN(7)
#define w_in AIN(8)
#define w_dn AIN(9)
#define w_qkva AIN(10)
#define w_oa AIN(11)
#define relb AIN(12)
#define w_qkvb AIN(13)
#define w_ob AIN(14)
#define sinks AIN(15)
#define out ((float*)get_args()->out)
#define WSP ((unsigned char*)get_args()->ws)
#define Win ((bf16_t*)(WSP + WS_WIN))
#define Wdn ((bf16_t*)(WSP + WS_WDN))
#define Wqkva ((bf16_t*)(WSP + WS_WQKVA))
#define Woa ((bf16_t*)(WSP + WS_WOA))
#define Wqkvb ((bf16_t*)(WSP + WS_WQKVB))
#define Wob ((bf16_t*)(WSP + WS_WOB))
#define misc ((float*)(WSP + WS_MISC))
#define stA ((float*)(WSP + WS_STA))
#define stB ((float*)(WSP + WS_STB))
#define Zb ((bf16_t*)(WSP + WS_ZB))
#define Ksa ((bf16_t*)(WSP + WS_KSA))
#define Vtsa ((bf16_t*)(WSP + WS_VTSA))
#define Ksb ((bf16_t*)(WSP + WS_KSB))
#define Vtsb ((bf16_t*)(WSP + WS_VTSB))
#define Hb ((bf16_t*)(WSP + WS_BIG))
#define Qb ((bf16_t*)(WSP + WS_BIG))
#define Kpb ((bf16_t*)(WSP + WS_BIG + BIG_K))
#define Vtpb ((bf16_t*)(WSP + WS_BIG + BIG_VT))
#define rope (misc + MC_ROPE)
__global__ void __launch_bounds__(512, 2) fwd_kernel(Args args) {
    extern __shared__ __attribute__((aligned(16))) unsigned char lds_raw[];
    LAS unsigned char* lds = (LAS unsigned char*)lds_raw;
    cg::grid_group grid = cg::this_grid();
    const int tid = threadIdx.x, lane = tid & 63, wave = __builtin_amdgcn_readfirstlane(tid >> 6);
    const int G = gridDim.x, bid = blockIdx.x;
    const int lo = args.ph_lo, hi = args.ph_hi;
#define IN(k) (lo <= (k) && (k) < hi)
#define SEAM(k) do { if (IN(k) && IN((k) + 1)) grid.sync(); } while (0)

    if (IN(0)) {
        const int gw = bid * 8 + wave, NGW = G * 8;
        const long gt = (long)bid * 512 + tid, NGT = (long)G * 512;
        LAS float* scr = (LAS float*)(lds + wave * 16384);
        for (int it = gw; it < 1040; it += NGW) {
            int r = it;
            if (r < 704) { const int w = r / 176, grp = r % 176;
                const int lnidx = (w == 1) ? 1 : (w == 2) ? 2 : 4;
                const float* g = (w == 0) ? nullptr : ln_g + lnidx * DM; const float* b = (w == 0) ? nullptr : ln_b + lnidx * DM;
                prep_weight_item(w_in + (size_t)w * DM * 2 * FF, DM, 2 * FF, grp * 16, FF + grp * 16, g, b, Win + (size_t)w * 2 * FF * DM, grp * 32,
                                 misc + MC_WIN + w * 2 * 5632, misc + MC_WIN + w * 2 * 5632 + 5632, scr, lane);
                continue; }
            r -= 704;
            if (r < 128) { const int w = r / 32, grp = r % 32;
                prep_weight_item(w_dn + (size_t)w * FF * DM, FF, DM, grp * 32, grp * 32 + 16, nullptr, nullptr, Wdn + (size_t)w * DM * FF, grp * 32, nullptr, nullptr, scr, lane);
                continue; }
            r -= 128;
            if (r < 96) { prep_weight_item(w_qkva, DM, 3072, r * 32, r * 32 + 16, ln_g + 0 * DM, ln_b + 0 * DM, Wqkva, r * 32, misc + MC_QKVA, misc + MC_QKVA + 3072, scr, lane); continue; }
            r -= 96;
            if (r < 32) { prep_weight_item(w_oa, DM, DM, r * 32, r * 32 + 16, nullptr, nullptr, Woa, r * 32, nullptr, nullptr, scr, lane); continue; }
            r -= 32;
            if (r < 48) { int cb0, cb1; if (r < 40) { cb0 = (r >> 1) * 64 + 16 * (r & 1); cb1 = cb0 + 32; } else { cb0 = r * 32; cb1 = cb0 + 16; }
                prep_weight_item(w_qkvb, DM, 1536, cb0, cb1, ln_g + 3 * DM, ln_b + 3 * DM, Wqkvb, r * 32, misc + MC_QKVB, misc + MC_QKVB + 1536, scr, lane); continue; }
            r -= 48;
            prep_weight_item(w_ob, DM, DM, r * 32, r * 32 + 16, nullptr, nullptr, Wob, r * 32, nullptr, nullptr, scr, lane);
        }
        for (long i = gt; i < (long)MT * 128; i += NGT) {
            const int row = (int)(i >> 7), c8 = (int)(i & 127);
            const float* src = (row < MP ? x_p + (size_t)row * DM : x_s + (size_t)(row - MP) * DM) + c8 * 8;
            const f32x4 a = *(const f32x4*)src, b = *(const f32x4*)(src + 4);
            u32x4 o; o.x = pk2(a[0], a[1]); o.y = pk2(a[2], a[3]); o.z = pk2(b[0], b[1]); o.w = pk2(b[2], b[3]);
            *(u32x4*)(Zb + (size_t)row * DM + c8 * 8) = o;
        }
        for (long i = gt; i < 2064 * 32; i += NGT) {
            const int pos = (int)(i >> 5), fi = (int)(i & 31);
            const double a = (double)pos * ROPE_INV[fi];
            const double n = __builtin_floor(a * 0.15915494309189535);
            const float rr = (float)__builtin_fma(-n, 6.283185307179586, a);
            rope[2 * i] = cosf(rr); rope[2 * i + 1] = sinf(rr);
        }
        for (long i = gt; i < 16L * 544 * 128; i += NGT) {
            const int c8 = (int)(i & 127); const int bp = (int)(i >> 7); const int b = bp / 544, pos = bp % 544;
            u32x4 o = (u32x4){0u, 0u, 0u, 0u};
            if (pos < 512) { const float* src = cak + ((size_t)(b * 512 + pos) * DM + c8 * 8); const f32x4 a = *(const f32x4*)src, c = *(const f32x4*)(src + 4);
                o.x = pk2(a[0], a[1]); o.y = pk2(a[2], a[3]); o.z = pk2(c[0], c[1]); o.w = pk2(c[2], c[3]); }
            if (pos < 512 || pos >= 528) *(u32x4*)(Ksa + (size_t)bp * DM + c8 * 8) = o;
        }
        for (long i = gt; i < 16L * 16 * 68 * 64; i += NGT) {
            const int d = (int)(i & 63); long t = i >> 6; const int p8 = (int)(t % 68); t /= 68; const int h = (int)(t & 15), b = (int)(t >> 4);
            u32x4 o = (u32x4){0u, 0u, 0u, 0u};
            if (p8 < 64) { float v[8];
#pragma unroll
                for (int e = 0; e < 8; ++e) v[e] = cav[((size_t)(b * 512 + p8 * 8 + e) * 16 + h) * 64 + d];
                o.x = pk2(v[0], v[1]); o.y = pk2(v[2], v[3]); o.z = pk2(v[4], v[5]); o.w = pk2(v[6], v[7]); }
            if (p8 < 64 || p8 >= 66) *(u32x4*)(Vtsa + ((size_t)((b * 16 + h) * 64 + d) * 544 + p8 * 8)) = o;
        }
        for (long i = gt; i < 16L * 160 * 32; i += NGT) {
            const int c8 = (int)(i & 31); const int bp = (int)(i >> 5); const int b = bp / 160, pos = bp % 160;
            u32x4 o = (u32x4){0u, 0u, 0u, 0u};
            if (pos < 128) { const float* src = cbk + ((size_t)(b * 128 + pos) * 256 + c8 * 8); const f32x4 a = *(const f32x4*)src, c = *(const f32x4*)(src + 4);
                o.x = pk2(a[0], a[1]); o.y = pk2(a[2], a[3]); o.z = pk2(c[0], c[1]); o.w = pk2(c[2], c[3]); }
            if (pos < 128 || pos >= 144) *(u32x4*)(Ksb + (size_t)bp * 256 + c8 * 8) = o;
        }
        for (long i = gt; i < 16L * 4 * 20 * 64; i += NGT) {
            const int d = (int)(i & 63); long t = i >> 6; const int p8 = (int)(t % 20); t /= 20; const int h = (int)(t & 3), b = (int)(t >> 2);
            u32x4 o = (u32x4){0u, 0u, 0u, 0u};
            if (p8 < 16) { float v[8];
#pragma unroll
                for (int e = 0; e < 8; ++e) v[e] = cbv[((size_t)(b * 128 + p8 * 8 + e) * 4 + h) * 64 + d];
                o.x = pk2(v[0], v[1]); o.y = pk2(v[2], v[3]); o.z = pk2(v[4], v[5]); o.w = pk2(v[6], v[7]); }
            if (p8 < 16 || p8 >= 18) *(u32x4*)(Vtsb + ((size_t)((b * 4 + h) * 64 + d) * 160 + p8 * 8)) = o;
        }
    }
    SEAM(0);

#pragma unroll 1
    for (int s = 0; s < 14; ++s) {
        if (IN(s + 1)) {
            const int L = s / 7, k = s % 7;
            const int c = 3 * L + (k > 1) + (k > 4);
            if (false) {}
#ifndef NO_SW
            else if (k == 0 || k == 5) {
                const int w = 2 * L + (k == 5);
                pg8::Gemm g{Zb, Win + (size_t)w * 2 * FF * DM, MT, 2 * FF, DM}; pg8::StaticOrder S; S.init(MT, 2 * FF, G, bid);
                pg8::EpiSwiglu E{w, c};
                pg8::gemm_phase<pg8::EpiSwiglu, pg8::StaticOrder, true, true>(lds, g, S, E);
            }
#endif
#ifndef NO_RES
            else if (k == 1 || k == 6 || k == 4) {
                const bool wo = (k == 4);
                const bf16_t* Bt = wo ? (L == 0 ? Woa : Wob) : Wdn + (size_t)(2 * L + (k == 6)) * DM * FF;
                pg8::Gemm g{wo ? Qb : Hb, Bt, MT, DM, wo ? DM : FF}; pg8::StaticOrder S; S.init(MT, DM, G, bid);
                pg8::EpiResid E{c, wo ? 1.0f : 0.5f};
                pg8::gemm_phase<pg8::EpiResid, pg8::StaticOrder, true, true>(lds, g, S, E);
            }
#endif
#ifndef NO_QKV
            else if (k == 2) {
                if (L == 0) {
                    pg8::Gemm g{Zb, Wqkva, MT, 3072, DM}; pg8::StaticOrder S; S.init(MT, 3072, G, bid);
                    pg8::EpiQkvA E{c};
                    pg8::gemm_phase<pg8::EpiQkvA, pg8::StaticOrder, true, true>(lds, g, S, E);
                } else {
                    pg8::Gemm g{Zb, Wqkvb, MT, 1536, DM}; pg8::StaticOrder S; S.init(MT, 1536, G, bid);
                    pg8::EpiQkvB E{c};
                    pg8::gemm_phase<pg8::EpiQkvB, pg8::StaticOrder, true, true>(lds, g, S, E);
                }
            }
#endif
#ifndef NO_ATT
            else {
                int lane_o = threadIdx.x & 63; asm volatile("" : "+v"(lane_o)); const int lane = lane_o;
                for (int bu = bid; bu < 2048 + 32; bu += G) {
                    if (L == 0) {
                        if (bu < 2048) { const int b = bu >> 7, h = (bu >> 3) & 15, chunk = (bu & 7) * 4 + (wave >> 1), half = wave & 1;
                            const size_t row0 = (size_t)b * 2048 + chunk * 64 + half * 32;
                            attn_wave<true>(Qb + row0 * DM + h * 64, DM, 32, Kpb + (size_t)b * 2048 * DM + h * 64, DM, Vtpb + (size_t)((b * 16 + h) * 64) * 2048, 2048,
                                            (chunk > 8 ? chunk - 8 : 0) * 2, (chunk + 1) * 2, 1 << 30, chunk * 64 + half * 32, relb + h * 257, 0.f, Qb + row0 * DM + h * 64, DM, lane);
                        } else { const int wu = (bu - 2048) * 8 + wave, b = wu >> 4, h = wu & 15; const size_t row0 = (size_t)MP + b * 16;
                            attn_wave<true>(Qb + row0 * DM + h * 64, DM, 16, Ksa + (size_t)b * 544 * DM + h * 64, DM, Vtsa + (size_t)((b * 16 + h) * 64) * 544, 544,
                                            0, 17, 528, 512, relb + h * 257, 0.f, Qb + row0 * DM + h * 64, DM, lane);
                        }
                    } else {
                        if (bu < 2048) { const int b = bu >> 7, kvh = (bu >> 5) & 3, chunk = bu & 31, qh = kvh * 4 + (wave >> 1), half = wave & 1;
                            const size_t row0 = (size_t)b * 2048 + chunk * 64 + half * 32;
                            attn_wave<false>(Qb + row0 * DM + qh * 64, DM, 32, Kpb + (size_t)b * 2048 * 256 + kvh * 64, 256, Vtpb + (size_t)((b * 4 + kvh) * 64) * 2048, 2048,
                                             (chunk > 2 ? chunk - 2 : 0) * 2, (chunk + 1) * 2, 1 << 30, 0, nullptr, sinks[qh], Qb + row0 * DM + qh * 64, DM, lane);
                        } else { const int wu = (bu - 2048) * 8 + wave, b = wu >> 4, qh = wu & 15, kvh = qh >> 2; const size_t row0 = (size_t)MP + b * 16;
                            attn_wave<false>(Qb + row0 * DM + qh * 64, DM, 16, Ksb + (size_t)b * 160 * 256 + kvh * 64, 256, Vtsb + (size_t)((b * 4 + kvh) * 64) * 160, 160,
                                             0, 5, 144, 0, nullptr, sinks[qh], Qb + row0 * DM + qh * 64, DM, lane);
                        }
                    }
                }
            }
#endif
        }
        SEAM(s + 1);
    }
    if (IN(15)) {
        const int gw = bid * 8 + wave, NGW = G * 8;
        const float* g = ln_g + 5 * DM; const float* b = ln_b + 5 * DM;
        f32x4 gv[4], bv[4];
#pragma unroll
        for (int j = 0; j < 4; ++j) { gv[j] = *(const f32x4*)(g + 4 * lane + 256 * j); bv[j] = *(const f32x4*)(b + 4 * lane + 256 * j); }
        for (int row = gw; row < MT; row += NGW) {
            float* zr = out + (size_t)row * DM + 4 * lane;
            f32x4 v[4]; float s = 0.f;
#pragma unroll
            for (int j = 0; j < 4; ++j) { v[j] = *(const f32x4*)(zr + 256 * j); s += (v[j][0] + v[j][1]) + (v[j][2] + v[j][3]); }
            const float mean = wave_sum(s) * (1.0f / DM); float s2 = 0.f;
#pragma unroll
            for (int j = 0; j < 4; ++j) { v[j] = v[j] - mean; s2 += (v[j][0] * v[j][0] + v[j][1] * v[j][1]) + (v[j][2] * v[j][2] + v[j][3] * v[j][3]); }
            const float rstd = 1.0f / sqrtf(wave_sum(s2) * (1.0f / DM) + 1e-5f);
#pragma unroll
            for (int j = 0; j < 4; ++j) *(f32x4*)(zr + 256 * j) = v[j] * rstd * gv[j] + bv[j];
        }
    }
#undef IN
#undef SEAM
}

#undef AIN
#undef x_p
#undef x_s
#undef cak
#undef cav
#undef cbk
#undef cbv
#undef ln_g
#undef ln_b
#undef w_in
#undef w_dn
#undef w_qkva
#undef w_oa
#undef relb
#undef w_qkvb
#undef w_ob
#undef sinks
#undef out
#undef WSP
#undef Win
#undef Wdn
#undef Wqkva
#undef Woa
#undef Wqkvb
#undef Wob
#undef misc
#undef stA
#undef stB
#undef Zb
#undef Ksa
#undef Vtsa
#undef Ksb
#undef Vtsb
#undef Hb
#undef Qb
#undef Kpb
#undef Vtpb
#undef rope
#ifndef N_LAUNCH_MODE
#define N_LAUNCH_MODE 16
#endif
extern "C" void kernel_launch(void* const* d_in, const int* in_sizes, int n_in, void* d_out, int out_size, void* d_ws, size_t ws_size, hipStream_t stream) {
    static int grid = 0;
    if (grid == 0) {
        if (n_in != 16 || ws_size < WS_END || (size_t)out_size != OUT_END) { fprintf(stderr, "kernel_launch: unexpected problem (n_in %d, out %d, ws %zu)\n", n_in, out_size, ws_size); grid = -1; return; }
        int dev = 0, cus = 0, per_cu = 0;
        (void)hipGetDevice(&dev); (void)hipDeviceGetAttribute(&cus, hipDeviceAttributeMultiprocessorCount, dev);
        if (hipFuncSetAttribute((const void*)fwd_kernel, hipFuncAttributeMaxDynamicSharedMemorySize, LDS_BYTES) != hipSuccess) { fprintf(stderr, "kernel_launch: hipFuncSetAttribute failed\n"); grid = -1; return; }
        if (hipOccupancyMaxActiveBlocksPerMultiprocessor(&per_cu, (const void*)fwd_kernel, 512, LDS_BYTES) != hipSuccess || per_cu < 1) { fprintf(stderr, "kernel_launch: occupancy query gave %d\n", per_cu); per_cu = 1; }
        (void)hipGetLastError();
        grid = cus * per_cu;
        fprintf(stderr, "kernel_launch: grid %d (cus %d x %d)\n", grid, cus, per_cu);
    }
    if (grid < 0) return;
    Args a{};
    for (int i = 0; i < 16; ++i) a.in[i] = (const float*)d_in[i];
    a.out = (float*)d_out; a.ws = (unsigned char*)d_ws;
    if (N_LAUNCH_MODE == 1) {
        a.ph_lo = 0; a.ph_hi = N_PHASES;
        void* kargs[] = {&a};
        hipError_t e = hipLaunchCooperativeKernel((const void*)fwd_kernel, dim3(grid), dim3(512), kargs, LDS_BYTES, stream);
        if (e != hipSuccess) fprintf(stderr, "cooperative launch failed: %s (grid %d)\n", hipGetErrorString(e), grid);
    } else {
        for (int p = 0; p < N_PHASES; ++p) { a.ph_lo = p; a.ph_hi = p + 1; hipLaunchKernelGGL(fwd_kernel, dim3(grid), dim3(512), LDS_BYTES, stream, a); }
    }
}
```

```cpp
#include <hip/hip_runtime.h>
#include <hip/hip_cooperative_groups.h>
#include <cstdio>
#include <cstdint>
namespace cg = cooperative_groups;
namespace pg8 {
#define PG8_LAS __attribute__((address_space(3)))
typedef unsigned short bf16_t;
typedef short bf16x8 __attribute__((ext_vector_type(8)));
typedef float f32x4 __attribute__((ext_vector_type(4)));
typedef unsigned u32x4 __attribute__((ext_vector_type(4)));
constexpr int BM = 256, BK = 64, HALF = 128, HTB = HALF * BK * 2  , STAGE_BYTES = 8 * HTB, NXCD = 8, WGM = 8;

__host__ __device__ __forceinline__ int lds_byte(int r, int c) { const int st = (r >> 4) * 2 + (c >> 5), rr = r & 15, cc = c & 31, ob = rr * 64 + cc * 2; return st * 1024 + (ob ^ (((ob >> 9) & 1) << 5)); }
__host__ __device__ __forceinline__ void stage_rc(int b, int& R, int& C) { const int st = b / 1024, sb = b % 1024, swz = sb ^ (((sb >> 9) & 1) << 5); R = (st >> 1) * 16 + swz / 64; C = (st & 1) * 32 + (swz % 64) / 2; }
__host__ __device__ __forceinline__ int perm32(int rho) { const int n = rho >> 4, i = rho & 15; return 8 * (i >> 2) + 4 * n + (i & 3); }

struct Unit { int pm, pn; };
struct Gemm { const bf16_t* A; const bf16_t* Bt; int M, N, K; };

struct StaticOrder {
    int nM, nN, nwg, G, c;
    __host__ __device__ void init(int M, int N, int G_, int c_) { nM = M / BM; nN = N / BM; nwg = nM * nN; G = G_; c = c_; }
    __host__ __device__ bool next(int i, Unit& u) const {
        const long L = (long)i * G + c; if (L >= nwg) return false;
        int wgid = (int)L; { const int q = nwg / NXCD, r = nwg % NXCD, xcd = wgid % NXCD, off = wgid / NXCD; wgid = (xcd < r ? xcd * (q + 1) : r * (q + 1) + (xcd - r) * q) + off; }
        const int nig = WGM * nN, gid = wgid / nig, fm = gid * WGM, gsz = (nM - fm) < WGM ? (nM - fm) : WGM;
        u.pm = fm + ((wgid % nig) % gsz); u.pn = (wgid % nig) / gsz; return true;
    }
    __device__ __forceinline__ void a_ready(const Unit&) const {}
    __device__ __forceinline__ void done(const Unit&) const {}
};

__device__ __forceinline__ unsigned cvt_pk_bf16(float lo, float hi) { unsigned r; asm volatile("v_cvt_pk_bf16_f32 %0, %1, %2" : "=v"(r) : "v"(lo), "v"(hi)); return r; }
template <class Epi, class Sched, bool ALIGN_EPI = false, bool SP2 = false>
__device__ __forceinline__ void gemm_phase(PG8_LAS unsigned char* lds, const Gemm g, const Sched& S, const Epi& E) {
    int tid_o = threadIdx.x; asm volatile("" : "+v"(tid_o));
    const int tid = tid_o, wid = __builtin_amdgcn_readfirstlane(tid >> 6), lane = tid & 63, wr = wid >> 2, wc = wid & 3, fr = lane & 15, fq = lane >> 4;
    const int K = g.K, nt = K / BK;
    unsigned voffA[2], voffB[2];
#pragma unroll
    for (int i = 0; i < 2; ++i) { int R, C; stage_rc(tid * 16 + i * 8192, R, C); const int Rb = Epi::PERM ? ((R & ~31) + perm32(R & 31)) : R;
        voffA[i] = (unsigned)(R * K + C) * 2u; voffB[i] = (unsigned)(Rb * K + C) * 2u; }
    const size_t kstep = (size_t)(BK * 2);
    const size_t hstep = (size_t)HALF * K * 2;
    const size_t tstep = 2 * hstep;
    const unsigned ldsw = (unsigned)wid * 1024u;
    const int aoff = lds_byte(wr * 64 + fr, fq * 8), boff = lds_byte(wc * 32 + fr, fq * 8);
#define PG8_SA(b, h) (((b) * 2 + (h)) * HTB)
#define PG8_SB(b, h) ((4 + (b) * 2 + (h)) * HTB)
#define PG8_STAGE(bufoff, gbase, voff) do { _Pragma("unroll") for (int _i = 0; _i < 2; ++_i) \
        __builtin_amdgcn_global_load_lds((const unsigned*)((const char*)(gbase) + (voff)[_i]), (PG8_LAS unsigned*)(lds + (bufoff) + ldsw + _i * 8192), 16, 0, 0); } while (0)
#define PG8_LDA(dst, b, h) do { _Pragma("unroll") for (int m = 0; m < 4; ++m) _Pragma("unroll") for (int k = 0; k < 2; ++k) dst[m][k] = *(const PG8_LAS bf16x8*)(lds + PG8_SA(b, h) + aoff + m * 2048 + k * 1024); } while (0)
#define PG8_LDB(dst, b, h) do { _Pragma("unroll") for (int n = 0; n < 2; ++n) _Pragma("unroll") for (int k = 0; k < 2; ++k) dst[n][k] = *(const PG8_LAS bf16x8*)(lds + PG8_SB(b, h) + boff + n * 2048 + k * 1024); } while (0)
#define PG8_MMA(ai, bj, At, Bt) do { __builtin_amdgcn_s_setprio(1); _Pragma("unroll") for (int m = 0; m < 4; ++m) _Pragma("unroll") for (int n = 0; n < 2; ++n) _Pragma("unroll") for (int k = 0; k < 2; ++k) \
        acc[ai][bj][m][n] = __builtin_amdgcn_mfma_f32_16x16x32_bf16(Bt[n][k], At[m][k], acc[ai][bj][m][n], 0, 0, 0); __builtin_amdgcn_s_setprio(0); } while (0)
#define PG8_WAIT_V(n) asm volatile("s_waitcnt vmcnt(" #n ")" ::: "memory")
#define PG8_WAIT_L(n) asm volatile("s_waitcnt lgkmcnt(" #n ")" ::: "memory")
#define PG8_BAR __builtin_amdgcn_s_barrier()
#define PG8_SCHED __builtin_amdgcn_sched_barrier(0)
    Unit cur, nxt; int ui = 0;
    if (!S.next(0, cur)) return;
    f32x4 acc[2][2][4][2];
#pragma unroll
    for (int a = 0; a < 2; ++a)
#pragma unroll
        for (int b = 0; b < 2; ++b)
#pragma unroll
            for (int m = 0; m < 4; ++m)
#pragma unroll
                for (int n = 0; n < 2; ++n) acc[a][b][m][n] = (f32x4){0.f, 0.f, 0.f, 0.f};
    bf16x8 At[4][2], B0[2][2], B1[2][2];
    const char* cA = (const char*)g.A + (size_t)cur.pm * tstep; const char* cB = (const char*)g.Bt + (size_t)cur.pn * tstep;
    S.a_ready(cur);
    if constexpr (SP2) {
        PG8_STAGE(PG8_SB(0, 0), cB, voffB); PG8_STAGE(PG8_SB(0, 1), cB + hstep, voffB); PG8_STAGE(PG8_SA(0, 0), cA, voffA); PG8_STAGE(PG8_SA(0, 1), cA + hstep, voffA);
        if (wr == 1) PG8_BAR;
        PG8_WAIT_V(2); PG8_BAR;
        PG8_STAGE(PG8_SB(1, 0), cB + kstep, voffB); PG8_STAGE(PG8_SA(1, 0), cA + kstep, voffA); PG8_STAGE(PG8_SB(1, 1), cB + hstep + kstep, voffB);
        PG8_WAIT_V(6); PG8_BAR;
    } else {
        PG8_STAGE(PG8_SB(0, 0), cB, voffB); PG8_STAGE(PG8_SA(0, 0), cA, voffA); PG8_STAGE(PG8_SB(0, 1), cB + hstep, voffB); PG8_STAGE(PG8_SA(0, 1), cA + hstep, voffA);
        if (wr == 1) PG8_BAR;
        PG8_WAIT_V(4); PG8_BAR;
        PG8_STAGE(PG8_SB(1, 0), cB + kstep, voffB); PG8_STAGE(PG8_SA(1, 0), cA + kstep, voffA); PG8_STAGE(PG8_SB(1, 1), cB + hstep + kstep, voffB);
        PG8_WAIT_V(6); PG8_BAR;
    }
    for (;;) {
        const bool has_next = S.next(ui + 1, nxt);
        const char* nA = has_next ? (const char*)g.A + (size_t)nxt.pm * tstep : cA; const char* nB = has_next ? (const char*)g.Bt + (size_t)nxt.pn * tstep : cB;
        for (int t = 0; t < nt; t += 2) {
            const bool last = (t == nt - 2);
            const char* a1 = cA + (size_t)(t + 1) * kstep;
            const char* a2 = last ? nA : cA + (size_t)(t + 2) * kstep; const char* b2 = last ? nB : cB + (size_t)(t + 2) * kstep;
            const char* a3 = a2 + kstep; const char* b3 = b2 + kstep;
            if (last && has_next) S.a_ready(nxt);
            if constexpr (SP2) {
            PG8_LDB(B0, 0, 0); PG8_LDB(B1, 0, 1); PG8_SCHED; PG8_LDA(At, 0, 0); PG8_STAGE(PG8_SA(1, 1), a1 + hstep, voffA);
            PG8_WAIT_V(8); PG8_WAIT_L(0); PG8_BAR; PG8_MMA(0, 0, At, B0); PG8_MMA(0, 1, At, B1); PG8_BAR; PG8_SCHED;
            PG8_LDA(At, 0, 1); PG8_STAGE(PG8_SB(0, 0), b2, voffB); PG8_STAGE(PG8_SB(0, 1), b2 + hstep, voffB); PG8_STAGE(PG8_SA(0, 0), a2, voffA);
            PG8_WAIT_V(8); PG8_WAIT_L(0); PG8_BAR; PG8_MMA(1, 0, At, B0); PG8_MMA(1, 1, At, B1); PG8_BAR; PG8_SCHED;
            PG8_LDB(B0, 1, 0); PG8_LDB(B1, 1, 1); PG8_SCHED; PG8_LDA(At, 1, 0); PG8_STAGE(PG8_SA(0, 1), a2 + hstep, voffA);
            PG8_WAIT_V(8); PG8_WAIT_L(0); PG8_BAR; PG8_MMA(0, 0, At, B0); PG8_MMA(0, 1, At, B1); PG8_BAR; PG8_SCHED;
            PG8_LDA(At, 1, 1); PG8_STAGE(PG8_SB(1, 0), b3, voffB); PG8_STAGE(PG8_SB(1, 1), b3 + hstep, voffB); PG8_STAGE(PG8_SA(1, 0), a3, voffA);
            PG8_WAIT_V(8); PG8_WAIT_L(0); PG8_BAR; PG8_MMA(1, 0, At, B0); PG8_MMA(1, 1, At, B1); PG8_BAR; PG8_SCHED;
            } else {
            PG8_LDB(B0, 0, 0); PG8_SCHED; PG8_LDA(At, 0, 0); PG8_STAGE(PG8_SA(1, 1), a1 + hstep, voffA);
            PG8_WAIT_L(8); PG8_BAR; PG8_WAIT_L(0); PG8_MMA(0, 0, At, B0); PG8_BAR; PG8_SCHED;
            PG8_LDB(B1, 0, 1); PG8_STAGE(PG8_SB(0, 0), b2, voffB);
            PG8_BAR; PG8_WAIT_L(0); PG8_MMA(0, 1, At, B1); PG8_BAR;
            PG8_LDA(At, 0, 1); PG8_STAGE(PG8_SA(0, 0), a2, voffA);
            PG8_BAR; PG8_WAIT_L(0); PG8_MMA(1, 0, At, B0); PG8_BAR; PG8_SCHED;
            PG8_STAGE(PG8_SB(0, 1), b2 + hstep, voffB);
            PG8_WAIT_V(6); PG8_BAR; PG8_MMA(1, 1, At, B1); PG8_BAR;
            PG8_LDB(B0, 1, 0); PG8_SCHED; PG8_LDA(At, 1, 0); PG8_STAGE(PG8_SA(0, 1), a2 + hstep, voffA);
            PG8_WAIT_L(8); PG8_BAR; PG8_WAIT_L(0); PG8_MMA(0, 0, At, B0); PG8_BAR; PG8_SCHED;
            PG8_LDB(B1, 1, 1); PG8_STAGE(PG8_SB(1, 0), b3, voffB);
            PG8_BAR; PG8_WAIT_L(0); PG8_MMA(0, 1, At, B1); PG8_BAR;
            PG8_LDA(At, 1, 1); PG8_STAGE(PG8_SA(1, 0), a3, voffA);
            PG8_BAR; PG8_WAIT_L(0); PG8_MMA(1, 0, At, B0); PG8_BAR; PG8_SCHED;
            PG8_STAGE(PG8_SB(1, 1), b3 + hstep, voffB);
            PG8_WAIT_V(6); PG8_BAR; PG8_MMA(1, 1, At, B1); PG8_BAR;
            }
        }
        if constexpr (ALIGN_EPI) { if (wr == 0) PG8_BAR; }
        if constexpr (!Epi::AFTER_DRAIN) { E(acc, cur, wr, wc, fr, fq); S.done(cur); }
        if (!has_next) break;
#pragma unroll
        for (int a = 0; a < 2; ++a)
#pragma unroll
            for (int b = 0; b < 2; ++b)
#pragma unroll
                for (int m = 0; m < 4; ++m)
#pragma unroll
                    for (int n = 0; n < 2; ++n) acc[a][b][m][n] = (f32x4){0.f, 0.f, 0.f, 0.f};
        cur = nxt; cA = nA; cB = nB; ++ui;
        if constexpr (ALIGN_EPI) { if (wr == 1) PG8_BAR; }
    }
    PG8_WAIT_V(0);
    if constexpr (!ALIGN_EPI) { if (wr == 0) PG8_BAR; }
    PG8_BAR;
    if constexpr (Epi::AFTER_DRAIN) { E.fused(acc, cur, wr, wc, fr, fq, lds, wid, lane); S.done(cur); }
#undef PG8_SA
#undef PG8_SB
#undef PG8_STAGE
#undef PG8_LDA
#undef PG8_LDB
#undef PG8_MMA
#undef PG8_WAIT_V
#undef PG8_WAIT_L
#undef PG8_BAR
#undef PG8_SCHED
}
}
constexpr int DM = 1024, FF = 2816, MP = 32768, MS = 256, MT = MP + MS, SEQ = 2048;
constexpr float ALPHA = 1.4142135623730951f;
constexpr float LOG2E = 1.4426950408889634f;
typedef pg8::bf16_t bf16_t;
typedef pg8::bf16x8 bf16x8;
typedef pg8::f32x4 f32x4;
typedef pg8::u32x4 u32x4;
typedef float f32x2v __attribute__((ext_vector_type(2)));
typedef float f32x16 __attribute__((ext_vector_type(16)));
typedef unsigned u32x2 __attribute__((ext_vector_type(2)));
#define LAS __attribute__((address_space(3)))

constexpr size_t MiB = 1u << 20;
constexpr size_t WS_WIN = 1 * MiB;
constexpr size_t WS_WDN = 45 * MiB;
constexpr size_t WS_WQKVA = 67 * MiB;
constexpr size_t WS_WOA = 73 * MiB;
constexpr size_t WS_WQKVB = 75 * MiB;
constexpr size_t WS_WOB = 78 * MiB;
constexpr size_t WS_MISC = 80 * MiB;
constexpr size_t WS_STA = 82 * MiB;
constexpr size_t WS_STB = 87 * MiB;
constexpr size_t WS_ZB = 92 * MiB;
constexpr size_t WS_KSA = 157 * MiB;
constexpr size_t WS_VTSA = 174 * MiB;
constexpr size_t WS_KSB = 191 * MiB;
constexpr size_t WS_VTSB = 193 * MiB;
constexpr size_t WS_BIG = 195 * MiB;
constexpr size_t BIG_K = (size_t)MT * DM * 2, BIG_VT = BIG_K + (size_t)MP * DM * 2;
constexpr size_t WS_END = 388 * MiB;
constexpr int MC_WIN = 0;
constexpr int MC_QKVA = 4 * 2 * 5632;
constexpr int MC_QKVB = MC_QKVA + 2 * 3072;
constexpr int MC_ROPE = MC_QKVB + 2 * 1536;
constexpr int LDS_BYTES = 131072;
struct Args { const float* in[16]; float* out; unsigned char* ws; int ph_lo, ph_hi; };
typedef const __attribute__((address_space(4))) Args* ArgsP;
__device__ __forceinline__ ArgsP get_args() { ArgsP p = (ArgsP)__builtin_amdgcn_kernarg_segment_ptr(); asm volatile("" : "+s"(p)); return p; }
constexpr size_t OUT_YP = 0, OUT_YS = (size_t)MP * DM, OUT_AKP = OUT_YS + (size_t)MS * DM, OUT_AVP = OUT_AKP + (size_t)16 * 512 * 1024, OUT_BKP = OUT_AVP + (size_t)16 * 512 * 1024,
                 OUT_BVP = OUT_BKP + (size_t)16 * 128 * 256, OUT_AKS = OUT_BVP + (size_t)16 * 128 * 256, OUT_AVS = OUT_AKS + (size_t)16 * 16 * 1024, OUT_BKS = OUT_AVS + (size_t)16 * 16 * 1024,
                 OUT_BVS = OUT_BKS + (size_t)16 * 16 * 256, OUT_END = OUT_BVS + (size_t)16 * 16 * 256;


__device__ __forceinline__ unsigned f2bf(float f) { unsigned u = __builtin_bit_cast(unsigned, f); return (u + 0x7fffu + ((u >> 16) & 1u)) >> 16; }
__device__ __forceinline__ unsigned pk2(float lo, float hi) { return f2bf(lo) | (f2bf(hi) << 16); }
__device__ __forceinline__ float bfround(float f) { return __builtin_bit_cast(float, f2bf(f) << 16); }
__device__ __forceinline__ u32x2 pk4(f32x4 v) { u32x2 r; r.x = pg8::cvt_pk_bf16(v[0], v[1]); r.y = pg8::cvt_pk_bf16(v[2], v[3]); return r; }
__device__ __forceinline__ float wave_sum(float v) {
#pragma unroll
    for (int o = 1; o < 64; o <<= 1) v += __shfl_xor(v, o);
    return v;
}

namespace pg8 {
__device__ __forceinline__ void row_mean_rstd(const float* st, int row, int fq, float& mean, float& rstd) {
    const f32x4* p = (const f32x4*)(st + (unsigned)row * 32 + 8 * fq);
    const f32x4 a = p[0], b = p[1];
    float s = (a[0] + a[2]) + (b[0] + b[2]), q = (a[1] + a[3]) + (b[1] + b[3]);
    s += __shfl_xor(s, 16); s += __shfl_xor(s, 32); q += __shfl_xor(q, 16); q += __shfl_xor(q, 32);
    mean = s * (1.0f / 1024.0f);
    const float var = fmaxf(q * (1.0f / 1024.0f) - mean * mean, 0.f);
    rstd = 1.0f / sqrtf(var + 1e-5f);
}

struct EpiSwiglu {
    static constexpr bool PERM = false, AFTER_DRAIN = false;
    int w, cnt;
    __device__ __forceinline__ void operator()(const f32x4 (&acc)[2][2][4][2], const Unit& u, int wr, int wc, int fr, int fq) const {
        unsigned char* wsp = get_args()->ws;
        bf16_t* H = (bf16_t*)(wsp + WS_BIG); const float* st = cnt == 0 ? nullptr : (const float*)(wsp + ((cnt & 1) ? WS_STA : WS_STB));
        const float* c1 = (const float*)(wsp + WS_MISC) + MC_WIN + w * 2 * 5632; const float* c2 = c1 + 5632;
        const int sb0 = u.pn * 256 + wc * 32 + 4 * fq;
        const int ff0 = u.pn * 128 + wc * 16 + 4 * fq;
        const bool fold = (st != nullptr);
#pragma unroll
        for (int ai = 0; ai < 2; ++ai)
#pragma unroll
            for (int m = 0; m < 4; ++m) {
                const int row = u.pm * 256 + ai * 128 + wr * 64 + m * 16 + fr;
                float mean = 0.f, rstd = 1.f;
                if (fold) row_mean_rstd(st, row, fq, mean, rstd);
#pragma unroll
                for (int bj = 0; bj < 2; ++bj) {
                    f32x4 g = acc[ai][bj][m][0], up = acc[ai][bj][m][1];
                    if (fold) {
                        const f32x4 c1g = *(const f32x4*)(c1 + sb0 + bj * 128), c1u = *(const f32x4*)(c1 + sb0 + bj * 128 + 16);
                        const f32x4 c2g = *(const f32x4*)(c2 + sb0 + bj * 128), c2u = *(const f32x4*)(c2 + sb0 + bj * 128 + 16);
                        g = (g - mean * c1g) * rstd + c2g; up = (up - mean * c1u) * rstd + c2u;
                    }
                    f32x4 hv;
#pragma unroll
                    for (int j = 0; j < 4; ++j) hv[j] = g[j] * __builtin_amdgcn_rcpf(1.0f + __expf(-g[j])) * up[j];
                    *(u32x2*)(H + (unsigned)row * FF + ff0 + bj * 64) = pk4(hv);
                }
            }
    }
};

struct EpiResid {
    static constexpr bool PERM = false, AFTER_DRAIN = false;
    int cnt; float cs;
    __device__ __forceinline__ void operator()(const f32x4 (&acc)[2][2][4][2], const Unit& u, int wr, int wc, int fr, int fq) const {
        unsigned char* wsp = get_args()->ws;
        float* Z = get_args()->out; const float* xp = get_args()->in[0]; const float* xs = get_args()->in[1];
        const float* stp = cnt == 0 ? nullptr : (const float*)(wsp + ((cnt & 1) ? WS_STA : WS_STB)); float* stn = (float*)(wsp + ((cnt & 1) ? WS_STB : WS_STA));
        const int lni = cnt > 0 ? cnt - 1 : 0;
        const float* g = get_args()->in[6] + lni * DM; const float* b = get_args()->in[7] + lni * DM; bf16_t* Zb = (bf16_t*)(wsp + WS_ZB);
        const int col0 = u.pn * 256 + wc * 32 + 4 * fq;
        const bool first = (stp == nullptr);
#pragma unroll
        for (int ai = 0; ai < 2; ++ai)
#pragma unroll
            for (int m = 0; m < 4; ++m) {
                const int row = u.pm * 256 + ai * 128 + wr * 64 + m * 16 + fr;
                float mean = 0.f, rstd = 1.f;
                if (!first) row_mean_rstd(stp, row, fq, mean, rstd);
                const float* src = first ? (u.pm < 128 ? xp + (unsigned)row * DM : xs + (unsigned)(row - MP) * DM) : Z + (unsigned)row * DM;
                float s = 0.f, q = 0.f;
#pragma unroll
                for (int bj = 0; bj < 2; ++bj)
#pragma unroll
                    for (int n = 0; n < 2; ++n) {
                        const int col = col0 + bj * 128 + n * 16;
                        f32x4 x = *(const f32x4*)(src + col);
                        if (!first) { const f32x4 gv = *(const f32x4*)(g + col), bv = *(const f32x4*)(b + col); x = (x - mean) * rstd * gv + bv; }
                        const f32x4 zn = ALPHA * x + cs * acc[ai][bj][m][n];
                        *(f32x4*)(Z + (unsigned)row * DM + col) = zn;
                        *(u32x2*)(Zb + (unsigned)row * DM + col) = pk4(zn);
                        s += (zn[0] + zn[1]) + (zn[2] + zn[3]);
                        q += (zn[0] * zn[0] + zn[1] * zn[1]) + (zn[2] * zn[2] + zn[3] * zn[3]);
                    }
                s += __shfl_xor(s, 16); s += __shfl_xor(s, 32); q += __shfl_xor(q, 16); q += __shfl_xor(q, 32);
                if (fq == 0) *(f32x2v*)(stn + (unsigned)row * 32 + (u.pn * 4 + wc) * 2) = (f32x2v){s, q};
            }
    }
};

struct EpiQkvA {
    static constexpr bool PERM = false, AFTER_DRAIN = false;
    int cnt;
    __device__ __forceinline__ void operator()(const f32x4 (&acc)[2][2][4][2], const Unit& u, int wr, int wc, int fr, int fq) const {
        unsigned char* wsp = get_args()->ws; float* outp = get_args()->out;
        const float* st = (const float*)(wsp + ((cnt & 1) ? WS_STA : WS_STB)); const float* c1 = (const float*)(wsp + WS_MISC) + MC_QKVA; const float* c2 = c1 + 3072;
        bf16_t* Q = (bf16_t*)(wsp + WS_BIG); bf16_t* Kp = (bf16_t*)(wsp + WS_BIG + BIG_K); bf16_t* Vtp = (bf16_t*)(wsp + WS_BIG + BIG_VT); bf16_t* Ks = (bf16_t*)(wsp + WS_KSA); bf16_t* Vts = (bf16_t*)(wsp + WS_VTSA);
        float* okp = outp + OUT_AKP; float* ovp = outp + OUT_AVP; float* oks = outp + OUT_AKS; float* ovs = outp + OUT_AVS;
        const int typ = u.pn >> 2, hc0 = (u.pn & 3) * 256 + wc * 32 + 4 * fq, ns0 = u.pn * 256 + wc * 32 + 4 * fq;
        const bool sample = (u.pm == 128);
#pragma unroll
        for (int ai = 0; ai < 2; ++ai)
#pragma unroll
            for (int m = 0; m < 4; ++m) {
                const int row = u.pm * 256 + ai * 128 + wr * 64 + m * 16 + fr;
                float mean, rstd; row_mean_rstd(st, row, fq, mean, rstd);
                int b, pos; if (!sample) { b = row >> 11; pos = row & 2047; } else { const int r = row - MP; b = r >> 4; pos = r & 15; }
#pragma unroll
                for (int bj = 0; bj < 2; ++bj)
#pragma unroll
                    for (int n = 0; n < 2; ++n) {
                        const int hc = hc0 + bj * 128 + n * 16;
                        const f32x4 v = (acc[ai][bj][m][n] - mean * *(const f32x4*)(c1 + ns0 + bj * 128 + n * 16)) * rstd + *(const f32x4*)(c2 + ns0 + bj * 128 + n * 16);
                        if (typ == 0) { *(u32x2*)(Q + (unsigned)row * DM + hc) = pk4(v); }
                        else if (typ == 1) {
                            if (!sample) { *(u32x2*)(Kp + (unsigned)row * DM + hc) = pk4(v); if (pos >= 1536) *(f32x4*)(okp + ((unsigned)(b * 512 + pos - 1536) * DM + hc)) = v; }
                            else { *(u32x2*)(Ks + ((unsigned)(b * 544 + 512 + pos) * DM + hc)) = pk4(v); *(f32x4*)(oks + ((unsigned)(b * 16 + pos) * DM + hc)) = v; }
                        } else {
                            const int h = hc >> 6, d = hc & 63;
                            if (!sample) {
                                bf16_t* vt = Vtp + ((unsigned)((b * 16 + h) * 64 + d) * 2048 + pos);
#pragma unroll
                                for (int j = 0; j < 4; ++j) vt[(unsigned)j * 2048] = (bf16_t)f2bf(v[j]);
                                if (pos >= 1536) *(f32x4*)(ovp + ((unsigned)(b * 512 + pos - 1536) * DM + hc)) = v;
                            } else {
                                bf16_t* vt = Vts + ((unsigned)((b * 16 + h) * 64 + d) * 544 + 512 + pos);
#pragma unroll
                                for (int j = 0; j < 4; ++j) vt[(unsigned)j * 544] = (bf16_t)f2bf(v[j]);
                                *(f32x4*)(ovs + ((unsigned)(b * 16 + pos) * DM + hc)) = v;
                            }
                        }
                    }
            }
    }
};

struct EpiQkvB {
    static constexpr bool PERM = false, AFTER_DRAIN = false;
    int cnt;
    __device__ __forceinline__ void operator()(const f32x4 (&acc)[2][2][4][2], const Unit& u, int wr, int wc, int fr, int fq) const {
        unsigned char* wsp = get_args()->ws; float* outp = get_args()->out;
        const float* st = (const float*)(wsp + ((cnt & 1) ? WS_STA : WS_STB)); const float* c1 = (const float*)(wsp + WS_MISC) + MC_QKVB; const float* c2 = c1 + 1536; const float* rope = (const float*)(wsp + WS_MISC) + MC_ROPE;
        bf16_t* Q = (bf16_t*)(wsp + WS_BIG); bf16_t* Kp = (bf16_t*)(wsp + WS_BIG + BIG_K); bf16_t* Vtp = (bf16_t*)(wsp + WS_BIG + BIG_VT); bf16_t* Ks = (bf16_t*)(wsp + WS_KSB); bf16_t* Vts = (bf16_t*)(wsp + WS_VTSB);
        float* okp = outp + OUT_BKP; float* ovp = outp + OUT_BVP; float* oks = outp + OUT_BKS; float* ovs = outp + OUT_BVS;
        const int ns0 = u.pn * 256 + wc * 32 + 4 * fq;
        const bool sample = (u.pm == 128);
        const int dlo = 16 * (wc & 1) + 4 * fq;
#pragma unroll
        for (int ai = 0; ai < 2; ++ai)
#pragma unroll
            for (int m = 0; m < 4; ++m) {
                const int row = u.pm * 256 + ai * 128 + wr * 64 + m * 16 + fr;
                float mean, rstd; row_mean_rstd(st, row, fq, mean, rstd);
                int b, pos; if (!sample) { b = row >> 11; pos = row & 2047; } else { const int r = row - MP; b = r >> 4; pos = r & 15; }
                if (u.pn < 5) {
                    const int rp = sample ? 2048 + pos : pos;
                    const f32x4 cs0 = *(const f32x4*)(rope + ((unsigned)rp * 32 + dlo) * 2), cs1 = *(const f32x4*)(rope + ((unsigned)rp * 32 + dlo) * 2 + 4);
                    const f32x4 cc = (f32x4){cs0[0], cs0[2], cs1[0], cs1[2]}, ss = (f32x4){cs0[1], cs0[3], cs1[1], cs1[3]};
#pragma unroll
                    for (int bj = 0; bj < 2; ++bj) {
                        const f32x4 x1 = (acc[ai][bj][m][0] - mean * *(const f32x4*)(c1 + ns0 + bj * 128)) * rstd + *(const f32x4*)(c2 + ns0 + bj * 128);
                        const f32x4 x2 = (acc[ai][bj][m][1] - mean * *(const f32x4*)(c1 + ns0 + bj * 128 + 16)) * rstd + *(const f32x4*)(c2 + ns0 + bj * 128 + 16);
                        const f32x4 lo = x1 * cc - x2 * ss, hi = x2 * cc + x1 * ss;
                        const int hit = bj * 2 + (wc >> 1);
                        if (u.pn < 4) {
                            const int hc = (u.pn * 4 + hit) * 64 + dlo;
                            *(u32x2*)(Q + (unsigned)row * DM + hc) = pk4(lo); *(u32x2*)(Q + (unsigned)row * DM + hc + 32) = pk4(hi);
                        } else {
                            const int kc = hit * 64 + dlo;
                            if (!sample) {
                                *(u32x2*)(Kp + (unsigned)row * 256 + kc) = pk4(lo); *(u32x2*)(Kp + (unsigned)row * 256 + kc + 32) = pk4(hi);
                                if (pos >= 1920) { float* o = okp + ((unsigned)(b * 128 + pos - 1920) * 256 + kc); *(f32x4*)o = lo; *(f32x4*)(o + 32) = hi; }
                            } else {
                                bf16_t* kd = Ks + ((unsigned)(b * 160 + 128 + pos) * 256 + kc); *(u32x2*)kd = pk4(lo); *(u32x2*)(kd + 32) = pk4(hi);
                                float* o = oks + ((unsigned)(b * 16 + pos) * 256 + kc); *(f32x4*)o = lo; *(f32x4*)(o + 32) = hi;
                            }
                        }
                    }
                } else {
#pragma unroll
                    for (int bj = 0; bj < 2; ++bj)
#pragma unroll
                        for (int n = 0; n < 2; ++n) {
                            const int hc = bj * 128 + wc * 32 + n * 16 + 4 * fq, kvh = hc >> 6, d = hc & 63;
                            const f32x4 v = (acc[ai][bj][m][n] - mean * *(const f32x4*)(c1 + ns0 + bj * 128 + n * 16)) * rstd + *(const f32x4*)(c2 + ns0 + bj * 128 + n * 16);
                            if (!sample) {
                                bf16_t* vt = Vtp + ((unsigned)((b * 4 + kvh) * 64 + d) * 2048 + pos);
#pragma unroll
                                for (int j = 0; j < 4; ++j) vt[(unsigned)j * 2048] = (bf16_t)f2bf(v[j]);
                                if (pos >= 1920) *(f32x4*)(ovp + ((unsigned)(b * 128 + pos - 1920) * 256 + hc)) = v;
                            } else {
                                bf16_t* vt = Vts + ((unsigned)((b * 4 + kvh) * 64 + d) * 160 + 128 + pos);
#pragma unroll
                                for (int j = 0; j < 4; ++j) vt[(unsigned)j * 160] = (bf16_t)f2bf(v[j]);
                                *(f32x4*)(ovs + ((unsigned)(b * 16 + pos) * 256 + hc)) = v;
                            }
                        }
                }
            }
    }
};
}
template <bool MODE_A>
__device__ __forceinline__ void attn_wave(const bf16_t* Qrow0, int ldq, int nq, const bf16_t* Kb, int ldk, const bf16_t* Vt, int ldv,
                                          int kt0, int kt1, int nvalid, int qpos0, const float* tab, float sink, bf16_t* Orow0, int ldo, int lane) {
    const int r = lane & 31, h = lane >> 5;
    const int qr = r < nq ? r : nq - 1;
    bf16x8 qf[4];
#pragma unroll
    for (int s = 0; s < 4; ++s) qf[s] = *(const bf16x8*)(Qrow0 + (size_t)qr * ldq + 16 * s + 8 * h);
    const int pr = (r & ~12) | ((r & 4) << 1) | ((r & 8) >> 1);
    f32x16 O0, O1;
#pragma unroll
    for (int i = 0; i < 16; ++i) { O0[i] = 0.f; O1[i] = 0.f; }
    float mrun = MODE_A ? -1e30f : sink * LOG2E;
    float l = MODE_A ? 0.f : (h == 0 ? 1.f : 0.f);
    const float SC = 0.125f * LOG2E;
    const float tconst = MODE_A ? tab[256] * LOG2E : 0.f;
    for (int kt = kt0; kt < kt1; ++kt) {
        const int k0 = kt * 32;
        const bf16_t* kp = Kb + (size_t)(k0 + pr) * ldk + 8 * h;
        bf16x8 kf[4], vf[2][2];
#pragma unroll
        for (int s = 0; s < 4; ++s) kf[s] = *(const bf16x8*)(kp + 16 * s);
#pragma unroll
        for (int dt = 0; dt < 2; ++dt)
#pragma unroll
            for (int s = 0; s < 2; ++s) vf[dt][s] = *(const bf16x8*)(Vt + (size_t)(dt * 32 + r) * ldv + k0 + 16 * s + 8 * h);
        f32x16 S;
#pragma unroll
        for (int i = 0; i < 16; ++i) S[i] = 0.f;
#pragma unroll
        for (int s = 0; s < 4; ++s) S = __builtin_amdgcn_mfma_f32_32x32x16_bf16(kf[s], qf[s], S, 0, 0, 0);
        float t[16];
        const int qp = qpos0 + r;
        const bool farblk = MODE_A && (qpos0 - (k0 + 31) >= 128);
        float mx = -1e30f;
#pragma unroll
        for (int i = 0; i < 16; ++i) {
            const int key = k0 + 16 * (i >> 3) + 8 * h + (i & 7);
            float bias = 0.f;
            if (MODE_A) {
                if (farblk) bias = tconst;
                else { int rel = qp - key; rel = rel < -128 ? -128 : (rel > 128 ? 128 : rel); bias = tab[rel + 128] * LOG2E; }
            }
            float v = S[i] * SC + bias;
            if (key >= nvalid) v = -1e30f;
            t[i] = v; mx = fmaxf(mx, v);
        }
        mx = fmaxf(mx, __shfl_xor(mx, 32));
        const float mnew = fmaxf(mrun, mx);
        const float alpha = __builtin_amdgcn_exp2f(mrun - mnew);
        mrun = mnew;
        float ps = 0.f;
#pragma unroll
        for (int i = 0; i < 16; ++i) { t[i] = __builtin_amdgcn_exp2f(t[i] - mnew); ps += t[i]; }
        l = l * alpha + ps;
#pragma unroll
        for (int i = 0; i < 16; ++i) { O0[i] *= alpha; O1[i] *= alpha; }
        bf16x8 pf[2];
#pragma unroll
        for (int s = 0; s < 2; ++s) {
            u32x4 w; w.x = pg8::cvt_pk_bf16(t[8 * s + 0], t[8 * s + 1]); w.y = pg8::cvt_pk_bf16(t[8 * s + 2], t[8 * s + 3]);
            w.z = pg8::cvt_pk_bf16(t[8 * s + 4], t[8 * s + 5]); w.w = pg8::cvt_pk_bf16(t[8 * s + 6], t[8 * s + 7]);
            pf[s] = __builtin_bit_cast(bf16x8, w);
        }
        O0 = __builtin_amdgcn_mfma_f32_32x32x16_bf16(vf[0][0], pf[0], O0, 0, 0, 0);
        O0 = __builtin_amdgcn_mfma_f32_32x32x16_bf16(vf[0][1], pf[1], O0, 0, 0, 0);
        O1 = __builtin_amdgcn_mfma_f32_32x32x16_bf16(vf[1][0], pf[0], O1, 0, 0, 0);
        O1 = __builtin_amdgcn_mfma_f32_32x32x16_bf16(vf[1][1], pf[1], O1, 0, 0, 0);
    }
    l += __shfl_xor(l, 32);
    const float inv = 1.0f / l;
    if (r < nq) {
        bf16_t* op = Orow0 + (size_t)r * ldo + 4 * h;
#pragma unroll
        for (int g = 0; g < 4; ++g) {
            f32x4 a = (f32x4){O0[4 * g], O0[4 * g + 1], O0[4 * g + 2], O0[4 * g + 3]} * inv;
            f32x4 b = (f32x4){O1[4 * g], O1[4 * g + 1], O1[4 * g + 2], O1[4 * g + 3]} * inv;
            *(u32x2*)(op + 8 * g) = pk4(a);
            *(u32x2*)(op + 32 + 8 * g) = pk4(b);
        }
    }
}

__device__ __forceinline__ void prep_weight_item(const float* W, int K, int N, int cb0, int cb1, const float* g, const float* b, bf16_t* Bt, int row0, float* c1, float* c2,
                                                 LAS float* scr, int lane) {
    const int c = lane & 31, col = c < 16 ? cb0 + c : cb1 + c - 16;
    float a1 = 0.f, a2 = 0.f;
    for (int k0 = 0; k0 < K; k0 += 64) {
#pragma unroll 8
        for (int i = 0; i < 32; ++i) {
            const int kk = 2 * i + (lane >> 5);
            const float w = W[(size_t)(k0 + kk) * N + col];
            float v = w;
            if (g) { v = w * g[k0 + kk]; a2 += w * b[k0 + kk]; }
            v = bfround(v); a1 += v;
            scr[kk * 33 + c] = v;
        }
        asm volatile("s_waitcnt lgkmcnt(0)" ::: "memory");
        const int c8 = lane & 7;
#pragma unroll
        for (int j = 0; j < 4; ++j) {
            const int n = (lane >> 3) + 8 * j; const LAS float* s = scr + (8 * c8) * 33 + n;
            u32x4 o;
            o.x = (__builtin_bit_cast(unsigned, s[0 * 33]) >> 16) | (__builtin_bit_cast(unsigned, s[1 * 33]) & 0xffff0000u);
            o.y = (__builtin_bit_cast(unsigned, s[2 * 33]) >> 16) | (__builtin_bit_cast(unsigned, s[3 * 33]) & 0xffff0000u);
            o.z = (__builtin_bit_cast(unsigned, s[4 * 33]) >> 16) | (__builtin_bit_cast(unsigned, s[5 * 33]) & 0xffff0000u);
            o.w = (__builtin_bit_cast(unsigned, s[6 * 33]) >> 16) | (__builtin_bit_cast(unsigned, s[7 * 33]) & 0xffff0000u);
            *(u32x4*)(Bt + (size_t)(row0 + n) * K + k0 + 8 * c8) = o;
        }
        asm volatile("s_waitcnt lgkmcnt(0)" ::: "memory");
    }
    a1 += __shfl_xor(a1, 32); a2 += __shfl_xor(a2, 32);
    if (c1 && lane < 32) { c1[row0 + c] = a1; c2[row0 + c] = a2; }
}
constexpr int N_PHASES = 16;
__device__ const double ROPE_INV[32] = {1.0, 0.7498942093324559, 0.5623413251903491, 0.4216965034285822, 0.31622776601683794, 0.23713737056616552, 0.1778279410038923, 0.1333521432163324, 0.1,
    0.07498942093324558, 0.05623413251903491, 0.042169650342858224, 0.03162277660168379, 0.023713737056616554, 0.01778279410038923, 0.01333521432163324, 0.01, 0.007498942093324558,
    0.005623413251903491, 0.004216965034285823, 0.0031622776601683794, 0.0023713737056616554, 0.0017782794100389228, 0.001333521432163324, 0.001, 0.0007498942093324559, 0.0005623413251903491,
    0.00042169650342858224, 0.00031622776601683794, 0.00023713737056616554, 0.00017782794100389227, 0.0001333521432163324};


#define AIN(i) ((const float*)get_args()->in[i])
#define x_p AIN(0)
#define x_s AIN(1)
#define cak AIN(2)
#define cav AIN(3)
#define cbk AIN(4)
#define cbv AIN(5)
#define ln_g AIN(6)
#define ln_b AIN(7)
#define w_in AIN(8)
#define w_dn AIN(9)
#define w_qkva AIN(10)
#define w_oa AIN(11)
#define relb AIN(12)
#define w_qkvb AIN(13)
#define w_ob AIN(14)
#define sinks AIN(15)
#define out ((float*)get_args()->out)
#define WSP ((unsigned char*)get_args()->ws)
#define Win ((bf16_t*)(WSP + WS_WIN))
#define Wdn ((bf16_t*)(WSP + WS_WDN))
#define Wqkva ((bf16_t*)(WSP + WS_WQKVA))
#define Woa ((bf16_t*)(WSP + WS_WOA))
#define Wqkvb ((bf16_t*)(WSP + WS_WQKVB))
#define Wob ((bf16_t*)(WSP + WS_WOB))
#define misc ((float*)(WSP + WS_MISC))
#define stA ((float*)(WSP + WS_STA))
#define stB ((float*)(WSP + WS_STB))
#define Zb ((bf16_t*)(WSP + WS_ZB))
#define Ksa ((bf16_t*)(WSP + WS_KSA))
#define Vtsa ((bf16_t*)(WSP + WS_VTSA))
#define Ksb ((bf16_t*)(WSP + WS_KSB))
#define Vtsb ((bf16_t*)(WSP + WS_VTSB))
#define Hb ((bf16_t*)(WSP + WS_BIG))
#define Qb ((bf16_t*)(WSP + WS_BIG))
#define Kpb ((bf16_t*)(WSP + WS_BIG + BIG_K))
#define Vtpb ((bf16_t*)(WSP + WS_BIG + BIG_VT))
#define rope (misc + MC_ROPE)
__global__ void __launch_bounds__(512, 2) fwd_kernel(Args args) {
    extern __shared__ __attribute__((aligned(16))) unsigned char lds_raw[];
    LAS unsigned char* lds = (LAS unsigned char*)lds_raw;
    cg::grid_group grid = cg::this_grid();
    const int tid = threadIdx.x, lane = tid & 63, wave = __builtin_amdgcn_readfirstlane(tid >> 6);
    const int G = gridDim.x, bid = blockIdx.x;
    const int lo = args.ph_lo, hi = args.ph_hi;
#define IN(k) (lo <= (k) && (k) < hi)
#define SEAM(k) do { if (IN(k) && IN((k) + 1)) grid.sync(); } while (0)

    if (IN(0)) {
        const int gw = bid * 8 + wave, NGW = G * 8;
        const long gt = (long)bid * 512 + tid, NGT = (long)G * 512;
        LAS float* scr = (LAS float*)(lds + wave * 16384);
        for (int it = gw; it < 1040; it += NGW) {
            int r = it;
            if (r < 704) { const int w = r / 176, grp = r % 176;
                const int lnidx = (w == 1) ? 1 : (w == 2) ? 2 : 4;
                const float* g = (w == 0) ? nullptr : ln_g + lnidx * DM; const float* b = (w == 0) ? nullptr : ln_b + lnidx * DM;
                prep_weight_item(w_in + (size_t)w * DM * 2 * FF, DM, 2 * FF, grp * 16, FF + grp * 16, g, b, Win + (size_t)w * 2 * FF * DM, grp * 32,
                                 misc + MC_WIN + w * 2 * 5632, misc + MC_WIN + w * 2 * 5632 + 5632, scr, lane);
                continue; }
            r -= 704;
            if (r < 128) { const int w = r / 32, grp = r % 32;
                prep_weight_item(w_dn + (size_t)w * FF * DM, FF, DM, grp * 32, grp * 32 + 16, nullptr, nullptr, Wdn + (size_t)w * DM * FF, grp * 32, nullptr, nullptr, scr, lane);
                continue; }
            r -= 128;
            if (r < 96) { prep_weight_item(w_qkva, DM, 3072, r * 32, r * 32 + 16, ln_g + 0 * DM, ln_b + 0 * DM, Wqkva, r * 32, misc + MC_QKVA, misc + MC_QKVA + 3072, scr, lane); continue; }
            r -= 96;
            if (r < 32) { prep_weight_item(w_oa, DM, DM, r * 32, r * 32 + 16, nullptr, nullptr, Woa, r * 32, nullptr, nullptr, scr, lane); continue; }
            r -= 32;
            if (r < 48) { int cb0, cb1; if (r < 40) { cb0 = (r >> 1) * 64 + 16 * (r & 1); cb1 = cb0 + 32; } else { cb0 = r * 32; cb1 = cb0 + 16; }
                prep_weight_item(w_qkvb, DM, 1536, cb0, cb1, ln_g + 3 * DM, ln_b + 3 * DM, Wqkvb, r * 32, misc + MC_QKVB, misc + MC_QKVB + 1536, scr, lane); continue; }
            r -= 48;
            prep_weight_item(w_ob, DM, DM, r * 32, r * 32 + 16, nullptr, nullptr, Wob, r * 32, nullptr, nullptr, scr, lane);
        }
        for (long i = gt; i < (long)MT * 128; i += NGT) {
            const int row = (int)(i >> 7), c8 = (int)(i & 127);
            const float* src = (row < MP ? x_p + (size_t)row * DM : x_s + (size_t)(row - MP) * DM) + c8 * 8;
            const f32x4 a = *(const f32x4*)src, b = *(const f32x4*)(src + 4);
            u32x4 o; o.x = pk2(a[0], a[1]); o.y = pk2(a[2], a[3]); o.z = pk2(b[0], b[1]); o.w = pk2(b[2], b[3]);
            *(u32x4*)(Zb + (size_t)row * DM + c8 * 8) = o;
        }
        for (long i = gt; i < 2064 * 32; i += NGT) {
            const int pos = (int)(i >> 5), fi = (int)(i & 31);
            const double a = (double)pos * ROPE_INV[fi];
            const double n = __builtin_floor(a * 0.15915494309189535);
            const float rr = (float)__builtin_fma(-n, 6.283185307179586, a);
            rope[2 * i] = cosf(rr); rope[2 * i + 1] = sinf(rr);
        }
        for (long i = gt; i < 16L * 544 * 128; i += NGT) {
            const int c8 = (int)(i & 127); const int bp = (int)(i >> 7); const int b = bp / 544, pos = bp % 544;
            u32x4 o = (u32x4){0u, 0u, 0u, 0u};
            if (pos < 512) { const float* src = cak + ((size_t)(b * 512 + pos) * DM + c8 * 8); const f32x4 a = *(const f32x4*)src, c = *(const f32x4*)(src + 4);
                o.x = pk2(a[0], a[1]); o.y = pk2(a[2], a[3]); o.z = pk2(c[0], c[1]); o.w = pk2(c[2], c[3]); }
            if (pos < 512 || pos >= 528) *(u32x4*)(Ksa + (size_t)bp * DM + c8 * 8) = o;
        }
        for (long i = gt; i < 16L * 16 * 68 * 64; i += NGT) {
            const int d = (int)(i & 63); long t = i >> 6; const int p8 = (int)(t % 68); t /= 68; const int h = (int)(t & 15), b = (int)(t >> 4);
            u32x4 o = (u32x4){0u, 0u, 0u, 0u};
            if (p8 < 64) { float v[8];
#pragma unroll
                for (int e = 0; e < 8; ++e) v[e] = cav[((size_t)(b * 512 + p8 * 8 + e) * 16 + h) * 64 + d];
                o.x = pk2(v[0], v[1]); o.y = pk2(v[2], v[3]); o.z = pk2(v[4], v[5]); o.w = pk2(v[6], v[7]); }
            if (p8 < 64 || p8 >= 66) *(u32x4*)(Vtsa + ((size_t)((b * 16 + h) * 64 + d) * 544 + p8 * 8)) = o;
        }
        for (long i = gt; i < 16L * 160 * 32; i += NGT) {
            const int c8 = (int)(i & 31); const int bp = (int)(i >> 5); const int b = bp / 160, pos = bp % 160;
            u32x4 o = (u32x4){0u, 0u, 0u, 0u};
            if (pos < 128) { const float* src = cbk + ((size_t)(b * 128 + pos) * 256 + c8 * 8); const f32x4 a = *(const f32x4*)src, c = *(const f32x4*)(src + 4);
                o.x = pk2(a[0], a[1]); o.y = pk2(a[2], a[3]); o.z = pk2(c[0], c[1]); o.w = pk2(c[2], c[3]); }
            if (pos < 128 || pos >= 144) *(u32x4*)(Ksb + (size_t)bp * 256 + c8 * 8) = o;
        }
        for (long i = gt; i < 16L * 4 * 20 * 64; i += NGT) {
            const int d = (int)(i & 63); long t = i >> 6; const int p8 = (int)(t % 20); t /= 20; const int h = (int)(t & 3), b = (int)(t >> 2);
            u32x4 o = (u32x4){0u, 0u, 0u, 0u};
            if (p8 < 16) { float v[8];
#pragma unroll
                for (int e = 0; e < 8; ++e) v[e] = cbv[((size_t)(b * 128 + p8 * 8 + e) * 4 + h) * 64 + d];
                o.x = pk2(v[0], v[1]); o.y = pk2(v[2], v[3]); o.z = pk2(v[4], v[5]); o.w = pk2(v[6], v[7]); }
            if (p8 < 16 || p8 >= 18) *(u32x4*)(Vtsb + ((size_t)((b * 4 + h) * 64 + d) * 160 + p8 * 8)) = o;
        }
    }
    SEAM(0);

#pragma unroll 1
    for (int s = 0; s < 14; ++s) {
        if (IN(s + 1)) {
            const int L = s / 7, k = s % 7;
            const int c = 3 * L + (k > 1) + (k > 4);
            if (false) {}
#ifndef NO_SW
            else if (k == 0 || k == 5) {
                const int w = 2 * L + (k == 5);
                pg8::Gemm g{Zb, Win + (size_t)w * 2 * FF * DM, MT, 2 * FF, DM}; pg8::StaticOrder S; S.init(MT, 2 * FF, G, bid);
                pg8::EpiSwiglu E{w, c};
                pg8::gemm_phase<pg8::EpiSwiglu, pg8::StaticOrder, true, true>(lds, g, S, E);
            }
#endif
#ifndef NO_RES
            else if (k == 1 || k == 6 || k == 4) {
                const bool wo = (k == 4);
                const bf16_t* Bt = wo ? (L == 0 ? Woa : Wob) : Wdn + (size_t)(2 * L + (k == 6)) * DM * FF;
                pg8::Gemm g{wo ? Qb : Hb, Bt, MT, DM, wo ? DM : FF}; pg8::StaticOrder S; S.init(MT, DM, G, bid);
                pg8::EpiResid E{c, wo ? 1.0f : 0.5f};
                pg8::gemm_phase<pg8::EpiResid, pg8::StaticOrder, true, true>(lds, g, S, E);
            }
#endif
#ifndef NO_QKV
            else if (k == 2) {
                if (L == 0) {
                    pg8::Gemm g{Zb, Wqkva, MT, 3072, DM}; pg8::StaticOrder S; S.init(MT, 3072, G, bid);
                    pg8::EpiQkvA E{c};
                    pg8::gemm_phase<pg8::EpiQkvA, pg8::StaticOrder, true, true>(lds, g, S, E);
                } else {
                    pg8::Gemm g{Zb, Wqkvb, MT, 1536, DM}; pg8::StaticOrder S; S.init(MT, 1536, G, bid);
                    pg8::EpiQkvB E{c};
                    pg8::gemm_phase<pg8::EpiQkvB, pg8::StaticOrder, true, true>(lds, g, S, E);
                }
            }
#endif
#ifndef NO_ATT
            else {
                int lane_o = threadIdx.x & 63; asm volatile("" : "+v"(lane_o)); const int lane = lane_o;
                for (int bu = bid; bu < 2048 + 32; bu += G) {
                    if (L == 0) {
                        if (bu < 2048) { const int b = bu >> 7, h = (bu >> 3) & 15, chunk = (bu & 7) * 4 + (wave >> 1), half = wave & 1;
                            const size_t row0 = (size_t)b * 2048 + chunk * 64 + half * 32;
                            attn_wave<true>(Qb + row0 * DM + h * 64, DM, 32, Kpb + (size_t)b * 2048 * DM + h * 64, DM, Vtpb + (size_t)((b * 16 + h) * 64) * 2048, 2048,
                                            (chunk > 8 ? chunk - 8 : 0) * 2, (chunk + 1) * 2, 1 << 30, chunk * 64 + half * 32, relb + h * 257, 0.f, Qb + row0 * DM + h * 64, DM, lane);
                        } else { const int wu = (bu - 2048) * 8 + wave, b = wu >> 4, h = wu & 15; const size_t row0 = (size_t)MP + b * 16;
                            attn_wave<true>(Qb + row0 * DM + h * 64, DM, 16, Ksa + (size_t)b * 544 * DM + h * 64, DM, Vtsa + (size_t)((b * 16 + h) * 64) * 544, 544,
                                            0, 17, 528, 512, relb + h * 257, 0.f, Qb + row0 * DM + h * 64, DM, lane);
                        }
                    } else {
                        if (bu < 2048) { const int b = bu >> 7, kvh = (bu >> 5) & 3, chunk = bu & 31, qh = kvh * 4 + (wave >> 1), half = wave & 1;
                            const size_t row0 = (size_t)b * 2048 + chunk * 64 + half * 32;
                            attn_wave<false>(Qb + row0 * DM + qh * 64, DM, 32, Kpb + (size_t)b * 2048 * 256 + kvh * 64, 256, Vtpb + (size_t)((b * 4 + kvh) * 64) * 2048, 2048,
                                             (chunk > 2 ? chunk - 2 : 0) * 2, (chunk + 1) * 2, 1 << 30, 0, nullptr, sinks[qh], Qb + row0 * DM + qh * 64, DM, lane);
                        } else { const int wu = (bu - 2048) * 8 + wave, b = wu >> 4, qh = wu & 15, kvh = qh >> 2; const size_t row0 = (size_t)MP + b * 16;
                            attn_wave<false>(Qb + row0 * DM + qh * 64, DM, 16, Ksb + (size_t)b * 160 * 256 + kvh * 64, 256, Vtsb + (size_t)((b * 4 + kvh) * 64) * 160, 160,
                                             0, 5, 144, 0, nullptr, sinks[qh], Qb + row0 * DM + qh * 64, DM, lane);
                        }
                    }
                }
            }
#endif
        }
        SEAM(s + 1);
    }
    if (IN(15)) {
        const int gw = bid * 8 + wave, NGW = G * 8;
        const float* g = ln_g + 5 * DM; const float* b = ln_b + 5 * DM;
        f32x4 gv[4], bv[4];
#pragma unroll
        for (int j = 0; j < 4; ++j) { gv[j] = *(const f32x4*)(g + 4 * lane + 256 * j); bv[j] = *(const f32x4*)(b + 4 * lane + 256 * j); }
        for (int row = gw; row < MT; row += NGW) {
            float* zr = out + (size_t)row * DM + 4 * lane;
            f32x4 v[4]; float s = 0.f;
#pragma unroll
            for (int j = 0; j < 4; ++j) { v[j] = *(const f32x4*)(zr + 256 * j); s += (v[j][0] + v[j][1]) + (v[j][2] + v[j][3]); }
            const float mean = wave_sum(s) * (1.0f / DM); float s2 = 0.f;
#pragma unroll
            for (int j = 0; j < 4; ++j) { v[j] = v[j] - mean; s2 += (v[j][0] * v[j][0] + v[j][1] * v[j][1]) + (v[j][2] * v[j][2] + v[j][3] * v[j][3]); }
            const float rstd = 1.0f / sqrtf(wave_sum(s2) * (1.0f / DM) + 1e-5f);
#pragma unroll
            for (int j = 0; j < 4; ++j) *(f32x4*)(zr + 256 * j) = v[j] * rstd * gv[j] + bv[j];
        }
    }
#undef IN
#undef SEAM
}

#undef AIN
#undef x_p
#undef x_s
#undef cak
#undef cav
#undef cbk
#undef cbv
#undef ln_g
#undef ln_b
#undef w_in
#undef w_dn
#undef w_qkva
#undef w_oa
#undef relb
#undef w_qkvb
#undef w_ob
#undef sinks
#undef out
#undef WSP
#undef Win
#undef Wdn
#undef Wqkva
#undef Woa
#undef Wqkvb
#undef Wob
#undef misc
#undef stA
#undef stB
#undef Zb
#undef Ksa
#undef Vtsa
#undef Ksb
#undef Vtsb
#undef Hb
#undef Qb
#undef Kpb
#undef Vtpb
#undef rope
#ifndef N_LAUNCH_MODE
#define N_LAUNCH_MODE 1
#endif
extern "C" void kernel_launch(void* const* d_in, const int* in_sizes, int n_in, void* d_out, int out_size, void* d_ws, size_t ws_size, hipStream_t stream) {
    static int grid = 0;
    if (grid == 0) {
        if (n_in != 16 || ws_size < WS_END || (size_t)out_size != OUT_END) { fprintf(stderr, "kernel_launch: unexpected problem (n_in %d, out %d, ws %zu)\n", n_in, out_size, ws_size); grid = -1; return; }
        int dev = 0, cus = 0, per_cu = 0;
        (void)hipGetDevice(&dev); (void)hipDeviceGetAttribute(&cus, hipDeviceAttributeMultiprocessorCount, dev);
        if (hipFuncSetAttribute((const void*)fwd_kernel, hipFuncAttributeMaxDynamicSharedMemorySize, LDS_BYTES) != hipSuccess) { fprintf(stderr, "kernel_launch: hipFuncSetAttribute failed\n"); grid = -1; return; }
        if (hipOccupancyMaxActiveBlocksPerMultiprocessor(&per_cu, (const void*)fwd_kernel, 512, LDS_BYTES) != hipSuccess || per_cu < 1) { fprintf(stderr, "kernel_launch: occupancy query gave %d\n", per_cu); per_cu = 1; }
        (void)hipGetLastError();
        grid = cus * per_cu;
        fprintf(stderr, "kernel_launch: grid %d (cus %d x %d)\n", grid, cus, per_cu);
    }
    if (grid < 0) return;
    Args a{};
    for (int i = 0; i < 16; ++i) a.in[i] = (const float*)d_in[i];
    a.out = (float*)d_out; a.ws = (unsigned char*)d_ws;
    if (N_LAUNCH_MODE == 1) {
        a.ph_lo = 0; a.ph_hi = N_PHASES;
        void* kargs[] = {&a};
        hipError_t e = hipLaunchCooperativeKernel((const void*)fwd_kernel, dim3(grid), dim3(512), kargs, LDS_BYTES, stream);
        if (e != hipSuccess) fprintf(stderr, "cooperative launch failed: %s (grid %d)\n", hipGetErrorString(e), grid);
    } else {
        for (int p = 0; p < N_PHASES; ++p) { a.ph_lo = p; a.ph_hi = p + 1; hipLaunchKernelGGL(fwd_kernel, dim3(grid), dim3(512), LDS_BYTES, stream, a); }
    }
}
```

```cpp
#include <hip/hip_runtime.h>
#include <hip/hip_cooperative_groups.h>
#include <cstdio>
#include <cstdint>
namespace cg = cooperative_groups;
namespace pg8 {
#define PG8_LAS __attribute__((address_space(3)))
typedef unsigned short bf16_t;
typedef short bf16x8 __attribute__((ext_vector_type(8)));
typedef float f32x4 __attribute__((ext_vector_type(4)));
typedef unsigned u32x4 __attribute__((ext_vector_type(4)));
constexpr int BM = 256, BK = 64, HALF = 128, HTB = HALF * BK * 2  , STAGE_BYTES = 8 * HTB, NXCD = 8, WGM = 8;

__host__ __device__ __forceinline__ int lds_byte(int r, int c) { const int st = (r >> 4) * 2 + (c >> 5), rr = r & 15, cc = c & 31, ob = rr * 64 + cc * 2; return st * 1024 + (ob ^ (((ob >> 9) & 1) << 5)); }
__host__ __device__ __forceinline__ void stage_rc(int b, int& R, int& C) { const int st = b / 1024, sb = b % 1024, swz = sb ^ (((sb >> 9) & 1) << 5); R = (st >> 1) * 16 + swz / 64; C = (st & 1) * 32 + (swz % 64) / 2; }
__host__ __device__ __forceinline__ int perm32(int rho) { const int n = rho >> 4, i = rho & 15; return 8 * (i >> 2) + 4 * n + (i & 3); }

struct Unit { int pm, pn; };
struct Gemm { const bf16_t* A; const bf16_t* Bt; int M, N, K; };

struct StaticOrder {
    int nM, nN, nwg, G, c;
    __host__ __device__ void init(int M, int N, int G_, int c_) { nM = M / BM; nN = N / BM; nwg = nM * nN; G = G_; c = c_; }
    __host__ __device__ bool next(int i, Unit& u) const {
        const long L = (long)i * G + c; if (L >= nwg) return false;
        int wgid = (int)L; { const int q = nwg / NXCD, r = nwg % NXCD, xcd = wgid % NXCD, off = wgid / NXCD; wgid = (xcd < r ? xcd * (q + 1) : r * (q + 1) + (xcd - r) * q) + off; }
        const int nig = WGM * nN, gid = wgid / nig, fm = gid * WGM, gsz = (nM - fm) < WGM ? (nM - fm) : WGM;
        u.pm = fm + ((wgid % nig) % gsz); u.pn = (wgid % nig) / gsz; return true;
    }
    __device__ __forceinline__ void a_ready(const Unit&) const {}
    __device__ __forceinline__ void done(const Unit&) const {}
};

__device__ __forceinline__ unsigned cvt_pk_bf16(float lo, float hi) { unsigned r; asm volatile("v_cvt_pk_bf16_f32 %0, %1, %2" : "=v"(r) : "v"(lo), "v"(hi)); return r; }
template <class Epi, class Sched, bool ALIGN_EPI = false, bool SP2 = false>
__device__ __forceinline__ void gemm_phase(PG8_LAS unsigned char* lds, const Gemm g, const Sched& S, const Epi& E) {
    int tid_o = threadIdx.x; asm volatile("" : "+v"(tid_o));
    const int tid = tid_o, wid = __builtin_amdgcn_readfirstlane(tid >> 6), lane = tid & 63, wr = wid >> 2, wc = wid & 3, fr = lane & 15, fq = lane >> 4;
    const int K = g.K, nt = K / BK;
    unsigned voffA[2], voffB[2];
#pragma unroll
    for (int i = 0; i < 2; ++i) { int R, C; stage_rc(tid * 16 + i * 8192, R, C); const int Rb = Epi::PERM ? ((R & ~31) + perm32(R & 31)) : R;
        voffA[i] = (unsigned)(R * K + C) * 2u; voffB[i] = (unsigned)(Rb * K + C) * 2u; }
    const size_t kstep = (size_t)(BK * 2);
    const size_t hstep = (size_t)HALF * K * 2;
    const size_t tstep = 2 * hstep;
    const unsigned ldsw = (unsigned)wid * 1024u;
    const int aoff = lds_byte(wr * 64 + fr, fq * 8), boff = lds_byte(wc * 32 + fr, fq * 8);
#define PG8_SA(b, h) (((b) * 2 + (h)) * HTB)
#define PG8_SB(b, h) ((4 + (b) * 2 + (h)) * HTB)
#define PG8_STAGE(bufoff, gbase, voff) do { _Pragma("unroll") for (int _i = 0; _i < 2; ++_i) \
        __builtin_amdgcn_global_load_lds((const unsigned*)((const char*)(gbase) + (voff)[_i]), (PG8_LAS unsigned*)(lds + (bufoff) + ldsw + _i * 8192), 16, 0, 0); } while (0)
#define PG8_LDA(dst, b, h) do { _Pragma("unroll") for (int m = 0; m < 4; ++m) _Pragma("unroll") for (int k = 0; k < 2; ++k) dst[m][k] = *(const PG8_LAS bf16x8*)(lds + PG8_SA(b, h) + aoff + m * 2048 + k * 1024); } while (0)
#define PG8_LDB(dst, b, h) do { _Pragma("unroll") for (int n = 0; n < 2; ++n) _Pragma("unroll") for (int k = 0; k < 2; ++k) dst[n][k] = *(const PG8_LAS bf16x8*)(lds + PG8_SB(b, h) + boff + n * 2048 + k * 1024); } while (0)
#define PG8_MMA(ai, bj, At, Bt) do { __builtin_amdgcn_s_setprio(1); _Pragma("unroll") for (int m = 0; m < 4; ++m) _Pragma("unroll") for (int n = 0; n < 2; ++n) _Pragma("unroll") for (int k = 0; k < 2; ++k) \
        acc[ai][bj][m][n] = __builtin_amdgcn_mfma_f32_16x16x32_bf16(Bt[n][k], At[m][k], acc[ai][bj][m][n], 0, 0, 0); __builtin_amdgcn_s_setprio(0); } while (0)
#define PG8_WAIT_V(n) asm volatile("s_waitcnt vmcnt(" #n ")" ::: "memory")
#define PG8_WAIT_L(n) asm volatile("s_waitcnt lgkmcnt(" #n ")" ::: "memory")
#define PG8_BAR __builtin_amdgcn_s_barrier()
#define PG8_SCHED __builtin_amdgcn_sched_barrier(0)
    Unit cur, nxt; int ui = 0;
    if (!S.next(0, cur)) return;
    f32x4 acc[2][2][4][2];
#pragma unroll
    for (int a = 0; a < 2; ++a)
#pragma unroll
        for (int b = 0; b < 2; ++b)
#pragma unroll
            for (int m = 0; m < 4; ++m)
#pragma unroll
                for (int n = 0; n < 2; ++n) acc[a][b][m][n] = (f32x4){0.f, 0.f, 0.f, 0.f};
    bf16x8 At[4][2], B0[2][2], B1[2][2];
    const char* cA = (const char*)g.A + (size_t)cur.pm * tstep; const char* cB = (const char*)g.Bt + (size_t)cur.pn * tstep;
    S.a_ready(cur);
    if constexpr (SP2) {
        PG8_STAGE(PG8_SB(0, 0), cB, voffB); PG8_STAGE(PG8_SB(0, 1), cB + hstep, voffB); PG8_STAGE(PG8_SA(0, 0), cA, voffA); PG8_STAGE(PG8_SA(0, 1), cA + hstep, voffA);
        if (wr == 1) PG8_BAR;
        PG8_WAIT_V(2); PG8_BAR;
        PG8_STAGE(PG8_SB(1, 0), cB + kstep, voffB); PG8_STAGE(PG8_SA(1, 0), cA + kstep, voffA); PG8_STAGE(PG8_SB(1, 1), cB + hstep + kstep, voffB);
        PG8_WAIT_V(6); PG8_BAR;
    } else {
        PG8_STAGE(PG8_SB(0, 0), cB, voffB); PG8_STAGE(PG8_SA(0, 0), cA, voffA); PG8_STAGE(PG8_SB(0, 1), cB + hstep, voffB); PG8_STAGE(PG8_SA(0, 1), cA + hstep, voffA);
        if (wr == 1) PG8_BAR;
        PG8_WAIT_V(4); PG8_BAR;
        PG8_STAGE(PG8_SB(1, 0), cB + kstep, voffB); PG8_STAGE(PG8_SA(1, 0), cA + kstep, voffA); PG8_STAGE(PG8_SB(1, 1), cB + hstep + kstep, voffB);
        PG8_WAIT_V(6); PG8_BAR;
    }
    for (;;) {
        const bool has_next = S.next(ui + 1, nxt);
        const char* nA = has_next ? (const char*)g.A + (size_t)nxt.pm * tstep : cA; const char* nB = has_next ? (const char*)g.Bt + (size_t)nxt.pn * tstep : cB;
        for (int t = 0; t < nt; t += 2) {
            const bool last = (t == nt - 2);
            const char* a1 = cA + (size_t)(t + 1) * kstep;
            const char* a2 = last ? nA : cA + (size_t)(t + 2) * kstep; const char* b2 = last ? nB : cB + (size_t)(t + 2) * kstep;
            const char* a3 = a2 + kstep; const char* b3 = b2 + kstep;
            if (last && has_next) S.a_ready(nxt);
            if constexpr (SP2) {
            PG8_LDB(B0, 0, 0); PG8_LDB(B1, 0, 1); PG8_SCHED; PG8_LDA(At, 0, 0); PG8_STAGE(PG8_SA(1, 1), a1 + hstep, voffA);
            PG8_WAIT_V(8); PG8_WAIT_L(0); PG8_BAR; PG8_MMA(0, 0, At, B0); PG8_MMA(0, 1, At, B1); PG8_BAR; PG8_SCHED;
            PG8_LDA(At, 0, 1); PG8_STAGE(PG8_SB(0, 0), b2, voffB); PG8_STAGE(PG8_SB(0, 1), b2 + hstep, voffB); PG8_STAGE(PG8_SA(0, 0), a2, voffA);
            PG8_WAIT_V(8); PG8_WAIT_L(0); PG8_BAR; PG8_MMA(1, 0, At, B0); PG8_MMA(1, 1, At, B1); PG8_BAR; PG8_SCHED;
            PG8_LDB(B0, 1, 0); PG8_LDB(B1, 1, 1); PG8_SCHED; PG8_LDA(At, 1, 0); PG8_STAGE(PG8_SA(0, 1), a2 + hstep, voffA);
            PG8_WAIT_V(8); PG8_WAIT_L(0); PG8_BAR; PG8_MMA(0, 0, At, B0); PG8_MMA(0, 1, At, B1); PG8_BAR; PG8_SCHED;
            PG8_LDA(At, 1, 1); PG8_STAGE(PG8_SB(1, 0), b3, voffB); PG8_STAGE(PG8_SB(1, 1), b3 + hstep, voffB); PG8_STAGE(PG8_SA(1, 0), a3, voffA);
            PG8_WAIT_V(8); PG8_WAIT_L(0); PG8_BAR; PG8_MMA(1, 0, At, B0); PG8_MMA(1, 1, At, B1); PG8_BAR; PG8_SCHED;
            } else {
            PG8_LDB(B0, 0, 0); PG8_SCHED; PG8_LDA(At, 0, 0); PG8_STAGE(PG8_SA(1, 1), a1 + hstep, voffA);
            PG8_WAIT_L(8); PG8_BAR; PG8_WAIT_L(0); PG8_MMA(0, 0, At, B0); PG8_BAR; PG8_SCHED;
            PG8_LDB(B1, 0, 1); PG8_STAGE(PG8_SB(0, 0), b2, voffB);
            PG8_BAR; PG8_WAIT_L(0); PG8_MMA(0, 1, At, B1); PG8_BAR;
            PG8_LDA(At, 0, 1); PG8_STAGE(PG8_SA(0, 0), a2, voffA);
            PG8_BAR; PG8_WAIT_L(0); PG8_MMA(1, 0, At, B0); PG8_BAR; PG8_SCHED;
            PG8_STAGE(PG8_SB(0, 1), b2 + hstep, voffB);
            PG8_WAIT_V(6); PG8_BAR; PG8_MMA(1, 1, At, B1); PG8_BAR;
            PG8_LDB(B0, 1, 0); PG8_SCHED; PG8_LDA(At, 1, 0); PG8_STAGE(PG8_SA(0, 1), a2 + hstep, voffA);
            PG8_WAIT_L(8); PG8_BAR; PG8_WAIT_L(0); PG8_MMA(0, 0, At, B0); PG8_BAR; PG8_SCHED;
            PG8_LDB(B1, 1, 1); PG8_STAGE(PG8_SB(1, 0), b3, voffB);
            PG8_BAR; PG8_WAIT_L(0); PG8_MMA(0, 1, At, B1); PG8_BAR;
            PG8_LDA(At, 1, 1); PG8_STAGE(PG8_SA(1, 0), a3, voffA);
            PG8_BAR; PG8_WAIT_L(0); PG8_MMA(1, 0, At, B0); PG8_BAR; PG8_SCHED;
            PG8_STAGE(PG8_SB(1, 1), b3 + hstep, voffB);
            PG8_WAIT_V(6); PG8_BAR; PG8_MMA(1, 1, At, B1); PG8_BAR;
            }
        }
        if constexpr (ALIGN_EPI) { if (wr == 0) PG8_BAR; }
        if constexpr (!Epi::AFTER_DRAIN) { E(acc, cur, wr, wc, fr, fq); S.done(cur); }
        if (!has_next) break;
#pragma unroll
        for (int a = 0; a < 2; ++a)
#pragma unroll
            for (int b = 0; b < 2; ++b)
#pragma unroll
                for (int m = 0; m < 4; ++m)
#pragma unroll
                    for (int n = 0; n < 2; ++n) acc[a][b][m][n] = (f32x4){0.f, 0.f, 0.f, 0.f};
        cur = nxt; cA = nA; cB = nB; ++ui;
        if constexpr (ALIGN_EPI) { if (wr == 1) PG8_BAR; }
    }
    PG8_WAIT_V(0);
    if constexpr (!ALIGN_EPI) { if (wr == 0) PG8_BAR; }
    PG8_BAR;
    if constexpr (Epi::AFTER_DRAIN) { E.fused(acc, cur, wr, wc, fr, fq, lds, wid, lane); S.done(cur); }
#undef PG8_SA
#undef PG8_SB
#undef PG8_STAGE
#undef PG8_LDA
#undef PG8_LDB
#undef PG8_MMA
#undef PG8_WAIT_V
#undef PG8_WAIT_L
#undef PG8_BAR
#undef PG8_SCHED
}
}
constexpr int DM = 1024, FF = 2816, MP = 32768, MS = 256, MT = MP + MS, SEQ = 2048;
constexpr float ALPHA = 1.4142135623730951f;
constexpr float LOG2E = 1.4426950408889634f;
typedef pg8::bf16_t bf16_t;
typedef pg8::bf16x8 bf16x8;
typedef pg8::f32x4 f32x4;
typedef pg8::u32x4 u32x4;
typedef float f32x2v __attribute__((ext_vector_type(2)));
typedef float f32x16 __attribute__((ext_vector_type(16)));
typedef unsigned u32x2 __attribute__((ext_vector_type(2)));
#define LAS __attribute__((address_space(3)))

constexpr size_t MiB = 1u << 20;
constexpr size_t WS_WIN = 1 * MiB;
constexpr size_t WS_WDN = 45 * MiB;
constexpr size_t WS_WQKVA = 67 * MiB;
constexpr size_t WS_WOA = 73 * MiB;
constexpr size_t WS_WQKVB = 75 * MiB;
constexpr size_t WS_WOB = 78 * MiB;
constexpr size_t WS_MISC = 80 * MiB;
constexpr size_t WS_STA = 82 * MiB;
constexpr size_t WS_STB = 87 * MiB;
constexpr size_t WS_ZB = 92 * MiB;
constexpr size_t WS_KSA = 157 * MiB;
constexpr size_t WS_VTSA = 174 * MiB;
constexpr size_t WS_KSB = 191 * MiB;
constexpr size_t WS_VTSB = 193 * MiB;
constexpr size_t WS_BIG = 195 * MiB;
constexpr size_t BIG_K = (size_t)MT * DM * 2, BIG_VT = BIG_K + (size_t)MP * DM * 2;
constexpr size_t WS_END = 388 * MiB;
constexpr int MC_WIN = 0;
constexpr int MC_QKVA = 4 * 2 * 5632;
constexpr int MC_QKVB = MC_QKVA + 2 * 3072;
constexpr int MC_ROPE = MC_QKVB + 2 * 1536;
constexpr int LDS_BYTES = 131072;
struct Args { const float* in[16]; float* out; unsigned char* ws; int ph_lo, ph_hi; };
typedef const __attribute__((address_space(4))) Args* ArgsP;
__device__ __forceinline__ ArgsP get_args() { ArgsP p = (ArgsP)__builtin_amdgcn_kernarg_segment_ptr(); asm volatile("" : "+s"(p)); return p; }
constexpr size_t OUT_YP = 0, OUT_YS = (size_t)MP * DM, OUT_AKP = OUT_YS + (size_t)MS * DM, OUT_AVP = OUT_AKP + (size_t)16 * 512 * 1024, OUT_BKP = OUT_AVP + (size_t)16 * 512 * 1024,
                 OUT_BVP = OUT_BKP + (size_t)16 * 128 * 256, OUT_AKS = OUT_BVP + (size_t)16 * 128 * 256, OUT_AVS = OUT_AKS + (size_t)16 * 16 * 1024, OUT_BKS = OUT_AVS + (size_t)16 * 16 * 1024,
                 OUT_BVS = OUT_BKS + (size_t)16 * 16 * 256, OUT_END = OUT_BVS + (size_t)16 * 16 * 256;


__device__ __forceinline__ unsigned f2bf(float f) { unsigned u = __builtin_bit_cast(unsigned, f); return (u + 0x7fffu + ((u >> 16) & 1u)) >> 16; }
__device__ __forceinline__ unsigned pk2(float lo, float hi) { return f2bf(lo) | (f2bf(hi) << 16); }
__device__ __forceinline__ float bfround(float f) { return __builtin_bit_cast(float, f2bf(f) << 16); }
__device__ __forceinline__ u32x2 pk4(f32x4 v) { u32x2 r; r.x = pg8::cvt_pk_bf16(v[0], v[1]); r.y = pg8::cvt_pk_bf16(v[2], v[3]); return r; }
__device__ __forceinline__ float wave_sum(float v) {
#pragma unroll
    for (int o = 1; o < 64; o <<= 1) v += __shfl_xor(v, o);
    return v;
}

namespace pg8 {
__device__ __forceinline__ void row_mean_rstd(const float* st, int row, int fq, float& mean, float& rstd) {
    const f32x4* p = (const f32x4*)(st + (unsigned)row * 32 + 8 * fq);
    const f32x4 a = p[0], b = p[1];
    float s = (a[0] + a[2]) + (b[0] + b[2]), q = (a[1] + a[3]) + (b[1] + b[3]);
    s += __shfl_xor(s, 16); s += __shfl_xor(s, 32); q += __shfl_xor(q, 16); q += __shfl_xor(q, 32);
    mean = s * (1.0f / 1024.0f);
    const float var = fmaxf(q * (1.0f / 1024.0f) - mean * mean, 0.f);
    rstd = 1.0f / sqrtf(var + 1e-5f);
}

#define PG8_EPI_WALK() \
    __device__ __forceinline__ void operator()(const f32x4 (&acc)[2][2][4][2], const Unit& u, int wr, int wc, int fr, int fq) const { \
        const Ctx cx = ctx(); \
        _Pragma("unroll") for (int ai = 0; ai < 2; ++ai) _Pragma("unroll") for (int m = 0; m < 4; ++m) { \
            const int row = u.pm * 256 + ai * 128 + wr * 64 + m * 16 + fr; \
            const f32x4 v[2][2] = {{acc[ai][0][m][0], acc[ai][0][m][1]}, {acc[ai][1][m][0], acc[ai][1][m][1]}}; \
            row_op(cx, u.pm, u.pn, wc, row, fq, v); } }

struct EpiSwiglu {
    static constexpr bool PERM = false, AFTER_DRAIN = false;
    int w, cnt;
    struct Ctx { bf16_t* H; const float* st; const float* c1; const float* c2; };
    __device__ __forceinline__ Ctx ctx() const {
        unsigned char* wsp = get_args()->ws; Ctx c;
        c.H = (bf16_t*)(wsp + WS_BIG); c.st = cnt == 0 ? nullptr : (const float*)(wsp + ((cnt & 1) ? WS_STA : WS_STB));
        c.c1 = (const float*)(wsp + WS_MISC) + MC_WIN + w * 2 * 5632; c.c2 = c.c1 + 5632; return c; }
    __device__ __forceinline__ void row_op(const Ctx& cx, int pm, int pn, int wc, int row, int fq, const f32x4 (&v)[2][2]) const {
        const int sb0 = pn * 256 + wc * 32 + 4 * fq, ff0 = pn * 128 + wc * 16 + 4 * fq;
        const bool fold = (cx.st != nullptr);
        float mean = 0.f, rstd = 1.f;
        if (fold) row_mean_rstd(cx.st, row, fq, mean, rstd);
#pragma unroll
        for (int bj = 0; bj < 2; ++bj) {
            f32x4 g = v[bj][0], up = v[bj][1];
            if (fold) {
                const f32x4 c1g = *(const f32x4*)(cx.c1 + sb0 + bj * 128), c1u = *(const f32x4*)(cx.c1 + sb0 + bj * 128 + 16);
                const f32x4 c2g = *(const f32x4*)(cx.c2 + sb0 + bj * 128), c2u = *(const f32x4*)(cx.c2 + sb0 + bj * 128 + 16);
                g = (g - mean * c1g) * rstd + c2g; up = (up - mean * c1u) * rstd + c2u;
            }
            f32x4 hv;
#pragma unroll
            for (int j = 0; j < 4; ++j) hv[j] = g[j] * __builtin_amdgcn_rcpf(1.0f + __expf(-g[j])) * up[j];
            *(u32x2*)(cx.H + (unsigned)row * FF + ff0 + bj * 64) = pk4(hv);
        }
    }
    PG8_EPI_WALK()
};

struct EpiResid {
    static constexpr bool PERM = false, AFTER_DRAIN = false;
    int cnt; float cs;
    struct Ctx { float* Z; const float* xp; const float* xs; const float* stp; const float* g; const float* b; float* stn; bf16_t* Zb; };
    __device__ __forceinline__ Ctx ctx() const {
        unsigned char* wsp = get_args()->ws; Ctx c;
        c.Z = get_args()->out; c.xp = get_args()->in[0]; c.xs = get_args()->in[1];
        c.stp = cnt == 0 ? nullptr : (const float*)(wsp + ((cnt & 1) ? WS_STA : WS_STB)); c.stn = (float*)(wsp + ((cnt & 1) ? WS_STB : WS_STA));
        const int lni = cnt > 0 ? cnt - 1 : 0;
        c.g = get_args()->in[6] + lni * DM; c.b = get_args()->in[7] + lni * DM; c.Zb = (bf16_t*)(wsp + WS_ZB); return c; }
    __device__ __forceinline__ void row_op(const Ctx& cx, int pm, int pn, int wc, int row, int fq, const f32x4 (&v)[2][2]) const {
        const int col0 = pn * 256 + wc * 32 + 4 * fq;
        const bool first = (cx.stp == nullptr);
        float mean = 0.f, rstd = 1.f;
        if (!first) row_mean_rstd(cx.stp, row, fq, mean, rstd);
        const float* src = first ? (pm < 128 ? cx.xp + (unsigned)row * DM : cx.xs + (unsigned)(row - MP) * DM) : cx.Z + (unsigned)row * DM;
        float s = 0.f, q = 0.f;
#pragma unroll
        for (int bj = 0; bj < 2; ++bj)
#pragma unroll
            for (int n = 0; n < 2; ++n) {
                const int col = col0 + bj * 128 + n * 16;
                f32x4 x = *(const f32x4*)(src + col);
                if (!first) { const f32x4 gv = *(const f32x4*)(cx.g + col), bv = *(const f32x4*)(cx.b + col); x = (x - mean) * rstd * gv + bv; }
                const f32x4 zn = ALPHA * x + cs * v[bj][n];
                *(f32x4*)(cx.Z + (unsigned)row * DM + col) = zn;
                *(u32x2*)(cx.Zb + (unsigned)row * DM + col) = pk4(zn);
                s += (zn[0] + zn[1]) + (zn[2] + zn[3]);
                q += (zn[0] * zn[0] + zn[1] * zn[1]) + (zn[2] * zn[2] + zn[3] * zn[3]);
            }
        s += __shfl_xor(s, 16); s += __shfl_xor(s, 32); q += __shfl_xor(q, 16); q += __shfl_xor(q, 32);
        if (fq == 0) *(f32x2v*)(cx.stn + (unsigned)row * 32 + (pn * 4 + wc) * 2) = (f32x2v){s, q};
    }
    PG8_EPI_WALK()
};

struct EpiQkvA {
    static constexpr bool PERM = false, AFTER_DRAIN = false;
    int cnt;
    struct Ctx { const float* st; const float* c1; const float* c2; bf16_t* Q; bf16_t* Kp; bf16_t* Vtp; bf16_t* Ks; bf16_t* Vts; float* outp; };
    __device__ __forceinline__ Ctx ctx() const {
        unsigned char* wsp = get_args()->ws; Ctx c; c.outp = get_args()->out;
        c.st = (const float*)(wsp + ((cnt & 1) ? WS_STA : WS_STB)); c.c1 = (const float*)(wsp + WS_MISC) + MC_QKVA; c.c2 = c.c1 + 3072;
        c.Q = (bf16_t*)(wsp + WS_BIG); c.Kp = (bf16_t*)(wsp + WS_BIG + BIG_K); c.Vtp = (bf16_t*)(wsp + WS_BIG + BIG_VT); c.Ks = (bf16_t*)(wsp + WS_KSA); c.Vts = (bf16_t*)(wsp + WS_VTSA); return c; }
    __device__ __forceinline__ void row_op(const Ctx& cx, int pm, int pn, int wc, int row, int fq, const f32x4 (&va)[2][2]) const {
        const int typ = pn >> 2, hc0 = (pn & 3) * 256 + wc * 32 + 4 * fq, ns0 = pn * 256 + wc * 32 + 4 * fq;
        const bool sample = (pm == 128);
        float* okp = cx.outp + OUT_AKP; float* ovp = cx.outp + OUT_AVP; float* oks = cx.outp + OUT_AKS; float* ovs = cx.outp + OUT_AVS;
        float mean, rstd; row_mean_rstd(cx.st, row, fq, mean, rstd);
        int b, pos; if (!sample) { b = row >> 11; pos = row & 2047; } else { const int r = row - MP; b = r >> 4; pos = r & 15; }
#pragma unroll
        for (int bj = 0; bj < 2; ++bj)
#pragma unroll
            for (int n = 0; n < 2; ++n) {
                const int hc = hc0 + bj * 128 + n * 16;
                const f32x4 v = (va[bj][n] - mean * *(const f32x4*)(cx.c1 + ns0 + bj * 128 + n * 16)) * rstd + *(const f32x4*)(cx.c2 + ns0 + bj * 128 + n * 16);
                if (typ == 0) { *(u32x2*)(cx.Q + (unsigned)row * DM + hc) = pk4(v); }
                else if (typ == 1) {
                    if (!sample) { *(u32x2*)(cx.Kp + (unsigned)row * DM + hc) = pk4(v); if (pos >= 1536) *(f32x4*)(okp + ((unsigned)(b * 512 + pos - 1536) * DM + hc)) = v; }
                    else { *(u32x2*)(cx.Ks + ((unsigned)(b * 544 + 512 + pos) * DM + hc)) = pk4(v); *(f32x4*)(oks + ((unsigned)(b * 16 + pos) * DM + hc)) = v; }
                } else {
                    const int h = hc >> 6, d = hc & 63;
                    if (!sample) {
                        bf16_t* vt = cx.Vtp + ((unsigned)((b * 16 + h) * 64 + d) * 2048 + pos);
#pragma unroll
                        for (int j = 0; j < 4; ++j) vt[(unsigned)j * 2048] = (bf16_t)f2bf(v[j]);
                        if (pos >= 1536) *(f32x4*)(ovp + ((unsigned)(b * 512 + pos - 1536) * DM + hc)) = v;
                    } else {
                        bf16_t* vt = cx.Vts + ((unsigned)((b * 16 + h) * 64 + d) * 544 + 512 + pos);
#pragma unroll
                        for (int j = 0; j < 4; ++j) vt[(unsigned)j * 544] = (bf16_t)f2bf(v[j]);
                        *(f32x4*)(ovs + ((unsigned)(b * 16 + pos) * DM + hc)) = v;
                    }
                }
            }
    }
    PG8_EPI_WALK()
};

struct EpiQkvB {
    static constexpr bool PERM = false, AFTER_DRAIN = false;
    int cnt;
    struct Ctx { const float* st; const float* c1; const float* c2; const float* rope; bf16_t* Q; bf16_t* Kp; bf16_t* Vtp; bf16_t* Ks; bf16_t* Vts; float* outp; };
    __device__ __forceinline__ Ctx ctx() const {
        unsigned char* wsp = get_args()->ws; Ctx c; c.outp = get_args()->out;
        c.st = (const float*)(wsp + ((cnt & 1) ? WS_STA : WS_STB)); c.c1 = (const float*)(wsp + WS_MISC) + MC_QKVB; c.c2 = c.c1 + 1536; c.rope = (const float*)(wsp + WS_MISC) + MC_ROPE;
        c.Q = (bf16_t*)(wsp + WS_BIG); c.Kp = (bf16_t*)(wsp + WS_BIG + BIG_K); c.Vtp = (bf16_t*)(wsp + WS_BIG + BIG_VT); c.Ks = (bf16_t*)(wsp + WS_KSB); c.Vts = (bf16_t*)(wsp + WS_VTSB); return c; }
    __device__ __forceinline__ void row_op(const Ctx& cx, int pm, int pn, int wc, int row, int fq, const f32x4 (&va)[2][2]) const {
        const int ns0 = pn * 256 + wc * 32 + 4 * fq;
        const bool sample = (pm == 128);
        float* okp = cx.outp + OUT_BKP; float* ovp = cx.outp + OUT_BVP; float* oks = cx.outp + OUT_BKS; float* ovs = cx.outp + OUT_BVS;
        const int dlo = 16 * (wc & 1) + 4 * fq;
        float mean, rstd; row_mean_rstd(cx.st, row, fq, mean, rstd);
        int b, pos; if (!sample) { b = row >> 11; pos = row & 2047; } else { const int r = row - MP; b = r >> 4; pos = r & 15; }
        if (pn < 5) {
            const int rp = sample ? 2048 + pos : pos;
            const f32x4 cs0 = *(const f32x4*)(cx.rope + ((unsigned)rp * 32 + dlo) * 2), cs1 = *(const f32x4*)(cx.rope + ((unsigned)rp * 32 + dlo) * 2 + 4);
            const f32x4 cc = (f32x4){cs0[0], cs0[2], cs1[0], cs1[2]}, ss = (f32x4){cs0[1], cs0[3], cs1[1], cs1[3]};
#pragma unroll
            for (int bj = 0; bj < 2; ++bj) {
                const f32x4 x1 = (va[bj][0] - mean * *(const f32x4*)(cx.c1 + ns0 + bj * 128)) * rstd + *(const f32x4*)(cx.c2 + ns0 + bj * 128);
                const f32x4 x2 = (va[bj][1] - mean * *(const f32x4*)(cx.c1 + ns0 + bj * 128 + 16)) * rstd + *(const f32x4*)(cx.c2 + ns0 + bj * 128 + 16);
                const f32x4 lo = x1 * cc - x2 * ss, hi = x2 * cc + x1 * ss;
                const int hit = bj * 2 + (wc >> 1);
                if (pn < 4) {
                    const int hc = (pn * 4 + hit) * 64 + dlo;
                    *(u32x2*)(cx.Q + (unsigned)row * DM + hc) = pk4(lo); *(u32x2*)(cx.Q + (unsigned)row * DM + hc + 32) = pk4(hi);
                } else {
                    const int kc = hit * 64 + dlo;
                    if (!sample) {
                        *(u32x2*)(cx.Kp + (unsigned)row * 256 + kc) = pk4(lo); *(u32x2*)(cx.Kp + (unsigned)row * 256 + kc + 32) = pk4(hi);
                        if (pos >= 1920) { float* o = okp + ((unsigned)(b * 128 + pos - 1920) * 256 + kc); *(f32x4*)o = lo; *(f32x4*)(o + 32) = hi; }
                    } else {
                        bf16_t* kd = cx.Ks + ((unsigned)(b * 160 + 128 + pos) * 256 + kc); *(u32x2*)kd = pk4(lo); *(u32x2*)(kd + 32) = pk4(hi);
                        float* o = oks + ((unsigned)(b * 16 + pos) * 256 + kc); *(f32x4*)o = lo; *(f32x4*)(o + 32) = hi;
                    }
                }
            }
        } else {
#pragma unroll
            for (int bj = 0; bj < 2; ++bj)
#pragma unroll
                for (int n = 0; n < 2; ++n) {
                    const int hc = bj * 128 + wc * 32 + n * 16 + 4 * fq, kvh = hc >> 6, d = hc & 63;
                    const f32x4 v = (va[bj][n] - mean * *(const f32x4*)(cx.c1 + ns0 + bj * 128 + n * 16)) * rstd + *(const f32x4*)(cx.c2 + ns0 + bj * 128 + n * 16);
                    if (!sample) {
                        bf16_t* vt = cx.Vtp + ((unsigned)((b * 4 + kvh) * 64 + d) * 2048 + pos);
#pragma unroll
                        for (int j = 0; j < 4; ++j) vt[(unsigned)j * 2048] = (bf16_t)f2bf(v[j]);
                        if (pos >= 1920) *(f32x4*)(ovp + ((unsigned)(b * 128 + pos - 1920) * 256 + hc)) = v;
                    } else {
                        bf16_t* vt = cx.Vts + ((unsigned)((b * 4 + kvh) * 64 + d) * 160 + 128 + pos);
#pragma unroll
                        for (int j = 0; j < 4; ++j) vt[(unsigned)j * 160] = (bf16_t)f2bf(v[j]);
                        *(f32x4*)(ovs + ((unsigned)(b * 16 + pos) * 256 + hc)) = v;
                    }
                }
        }
    }
    PG8_EPI_WALK()
};

template <class Epi>
__device__ __forceinline__ void small_gemm(PG8_LAS unsigned char* lds, const bf16_t* A, const bf16_t* Bt, int N, int K, const Epi& E) {
    typedef float f32x16 __attribute__((ext_vector_type(16)));
    int tid_o = threadIdx.x; asm volatile("" : "+v"(tid_o));
    const int tid = tid_o, wid = __builtin_amdgcn_readfirstlane(tid >> 6), lane = tid & 63, r = lane & 31, h = lane >> 5;
    const int ntiles = 8 * (N / 64), ks = K / 8;
    PG8_LAS float* part = (PG8_LAS float*)lds;
    const typename Epi::Ctx cx = E.ctx();
    for (int tile = blockIdx.x; tile < ntiles; tile += gridDim.x) {
        const int tm = tile & 7, tn = tile >> 3, pn = tn >> 2, wc = tn & 3;
        const bf16_t* ap = A + (size_t)(MP + tm * 32 + r) * K + wid * ks + 8 * h;
        const bf16_t* bp0 = Bt + (size_t)(pn * 256 + wc * 32 + r) * K + wid * ks + 8 * h;
        const bf16_t* bp1 = bp0 + (size_t)128 * K;
        f32x16 acc0, acc1;
#pragma unroll
        for (int i = 0; i < 16; ++i) { acc0[i] = 0.f; acc1[i] = 0.f; }
#pragma unroll 2
        for (int k0 = 0; k0 < ks; k0 += 16) {
            const bf16x8 a = *(const bf16x8*)(ap + k0), b0 = *(const bf16x8*)(bp0 + k0), b1 = *(const bf16x8*)(bp1 + k0);
            acc0 = __builtin_amdgcn_mfma_f32_32x32x16_bf16(b0, a, acc0, 0, 0, 0);
            acc1 = __builtin_amdgcn_mfma_f32_32x32x16_bf16(b1, a, acc1, 0, 0, 0);
        }
#pragma unroll
        for (int g = 0; g < 4; ++g) {
            *(PG8_LAS f32x4*)(part + ((wid * 2 + 0) * 32 + r) * 36 + 8 * g + 4 * h) = (f32x4){acc0[4 * g], acc0[4 * g + 1], acc0[4 * g + 2], acc0[4 * g + 3]};
            *(PG8_LAS f32x4*)(part + ((wid * 2 + 1) * 32 + r) * 36 + 8 * g + 4 * h) = (f32x4){acc1[4 * g], acc1[4 * g + 1], acc1[4 * g + 2], acc1[4 * g + 3]};
        }
        __syncthreads();
        if (wid < 2) {
            const int fr = lane & 15, fq = lane >> 4, rr = wid * 16 + fr;
            f32x4 v[2][2];
#pragma unroll
            for (int bj = 0; bj < 2; ++bj)
#pragma unroll
                for (int n = 0; n < 2; ++n) {
                    f32x4 s = *(const PG8_LAS f32x4*)(part + ((0 * 2 + bj) * 32 + rr) * 36 + 16 * n + 4 * fq);
#pragma unroll
                    for (int w = 1; w < 8; ++w) s += *(const PG8_LAS f32x4*)(part + ((w * 2 + bj) * 32 + rr) * 36 + 16 * n + 4 * fq);
                    v[bj][n] = s;
                }
            E.row_op(cx, 128, pn, wc, MP + tm * 32 + rr, fq, v);
        }
        __syncthreads();
    }
}
}
template <bool MODE_A>
__device__ __forceinline__ void attn_wave(const bf16_t* Qrow0, int ldq, int nq, const bf16_t* Kb, int ldk, const bf16_t* Vt, int ldv,
                                          int kt0, int kt1, int nvalid, int qpos0, const float* tab, float sink, bf16_t* Orow0, int ldo, int lane) {
    const int r = lane & 31, h = lane >> 5;
    const int qr = r < nq ? r : nq - 1;
    bf16x8 qf[4];
#pragma unroll
    for (int s = 0; s < 4; ++s) qf[s] = *(const bf16x8*)(Qrow0 + (size_t)qr * ldq + 16 * s + 8 * h);
    const int pr = (r & ~12) | ((r & 4) << 1) | ((r & 8) >> 1);
    f32x16 O0, O1;
#pragma unroll
    for (int i = 0; i < 16; ++i) { O0[i] = 0.f; O1[i] = 0.f; }
    float mrun = MODE_A ? -1e30f : sink * LOG2E;
    float l = MODE_A ? 0.f : (h == 0 ? 1.f : 0.f);
    const float SC = 0.125f * LOG2E;
    const float tconst = MODE_A ? tab[256] * LOG2E : 0.f;
    for (int kt = kt0; kt < kt1; ++kt) {
        const int k0 = kt * 32;
        const bf16_t* kp = Kb + (size_t)(k0 + pr) * ldk + 8 * h;
        bf16x8 kf[4], vf[2][2];
#pragma unroll
        for (int s = 0; s < 4; ++s) kf[s] = *(const bf16x8*)(kp + 16 * s);
#pragma unroll
        for (int dt = 0; dt < 2; ++dt)
#pragma unroll
            for (int s = 0; s < 2; ++s) vf[dt][s] = *(const bf16x8*)(Vt + (size_t)(dt * 32 + r) * ldv + k0 + 16 * s + 8 * h);
        f32x16 S;
#pragma unroll
        for (int i = 0; i < 16; ++i) S[i] = 0.f;
#pragma unroll
        for (int s = 0; s < 4; ++s) S = __builtin_amdgcn_mfma_f32_32x32x16_bf16(kf[s], qf[s], S, 0, 0, 0);
        float t[16];
        const int qp = qpos0 + r;
        const bool farblk = MODE_A && (qpos0 - (k0 + 31) >= 128);
        float mx = -1e30f;
#pragma unroll
        for (int i = 0; i < 16; ++i) {
            const int key = k0 + 16 * (i >> 3) + 8 * h + (i & 7);
            float bias = 0.f;
            if (MODE_A) {
                if (farblk) bias = tconst;
                else { int rel = qp - key; rel = rel < -128 ? -128 : (rel > 128 ? 128 : rel); bias = tab[rel + 128] * LOG2E; }
            }
            float v = S[i] * SC + bias;
            if (key >= nvalid) v = -1e30f;
            t[i] = v; mx = fmaxf(mx, v);
        }
        mx = fmaxf(mx, __shfl_xor(mx, 32));
        const float mnew = fmaxf(mrun, mx);
        const float alpha = __builtin_amdgcn_exp2f(mrun - mnew);
        mrun = mnew;
        float ps = 0.f;
#pragma unroll
        for (int i = 0; i < 16; ++i) { t[i] = __builtin_amdgcn_exp2f(t[i] - mnew); ps += t[i]; }
        l = l * alpha + ps;
#pragma unroll
        for (int i = 0; i < 16; ++i) { O0[i] *= alpha; O1[i] *= alpha; }
        bf16x8 pf[2];
#pragma unroll
        for (int s = 0; s < 2; ++s) {
            u32x4 w; w.x = pg8::cvt_pk_bf16(t[8 * s + 0], t[8 * s + 1]); w.y = pg8::cvt_pk_bf16(t[8 * s + 2], t[8 * s + 3]);
            w.z = pg8::cvt_pk_bf16(t[8 * s + 4], t[8 * s + 5]); w.w = pg8::cvt_pk_bf16(t[8 * s + 6], t[8 * s + 7]);
            pf[s] = __builtin_bit_cast(bf16x8, w);
        }
        O0 = __builtin_amdgcn_mfma_f32_32x32x16_bf16(vf[0][0], pf[0], O0, 0, 0, 0);
        O0 = __builtin_amdgcn_mfma_f32_32x32x16_bf16(vf[0][1], pf[1], O0, 0, 0, 0);
        O1 = __builtin_amdgcn_mfma_f32_32x32x16_bf16(vf[1][0], pf[0], O1, 0, 0, 0);
        O1 = __builtin_amdgcn_mfma_f32_32x32x16_bf16(vf[1][1], pf[1], O1, 0, 0, 0);
    }
    l += __shfl_xor(l, 32);
    const float inv = 1.0f / l;
    if (r < nq) {
        bf16_t* op = Orow0 + (size_t)r * ldo + 4 * h;
#pragma unroll
        for (int g = 0; g < 4; ++g) {
            f32x4 a = (f32x4){O0[4 * g], O0[4 * g + 1], O0[4 * g + 2], O0[4 * g + 3]} * inv;
            f32x4 b = (f32x4){O1[4 * g], O1[4 * g + 1], O1[4 * g + 2], O1[4 * g + 3]} * inv;
            *(u32x2*)(op + 8 * g) = pk4(a);
            *(u32x2*)(op + 32 + 8 * g) = pk4(b);
        }
    }
}

__device__ __forceinline__ void prep_weight_item(const float* W, int K, int N, int cb0, int cb1, const float* g, const float* b, bf16_t* Bt, int row0, float* c1, float* c2,
                                                 LAS float* scr, int lane) {
    const int c = lane & 31, col = c < 16 ? cb0 + c : cb1 + c - 16;
    float a1 = 0.f, a2 = 0.f;
    for (int k0 = 0; k0 < K; k0 += 64) {
#pragma unroll 8
        for (int i = 0; i < 32; ++i) {
            const int kk = 2 * i + (lane >> 5);
            const float w = W[(size_t)(k0 + kk) * N + col];
            float v = w;
            if (g) { v = w * g[k0 + kk]; a2 += w * b[k0 + kk]; }
            v = bfround(v); a1 += v;
            scr[kk * 33 + c] = v;
        }
        asm volatile("s_waitcnt lgkmcnt(0)" ::: "memory");
        const int c8 = lane & 7;
#pragma unroll
        for (int j = 0; j < 4; ++j) {
            const int n = (lane >> 3) + 8 * j; const LAS float* s = scr + (8 * c8) * 33 + n;
            u32x4 o;
            o.x = (__builtin_bit_cast(unsigned, s[0 * 33]) >> 16) | (__builtin_bit_cast(unsigned, s[1 * 33]) & 0xffff0000u);
            o.y = (__builtin_bit_cast(unsigned, s[2 * 33]) >> 16) | (__builtin_bit_cast(unsigned, s[3 * 33]) & 0xffff0000u);
            o.z = (__builtin_bit_cast(unsigned, s[4 * 33]) >> 16) | (__builtin_bit_cast(unsigned, s[5 * 33]) & 0xffff0000u);
            o.w = (__builtin_bit_cast(unsigned, s[6 * 33]) >> 16) | (__builtin_bit_cast(unsigned, s[7 * 33]) & 0xffff0000u);
            *(u32x4*)(Bt + (size_t)(row0 + n) * K + k0 + 8 * c8) = o;
        }
        asm volatile("s_waitcnt lgkmcnt(0)" ::: "memory");
    }
    a1 += __shfl_xor(a1, 32); a2 += __shfl_xor(a2, 32);
    if (c1 && lane < 32) { c1[row0 + c] = a1; c2[row0 + c] = a2; }
}
constexpr int N_PHASES = 16;
__device__ const double ROPE_INV[32] = {1.0, 0.7498942093324559, 0.5623413251903491, 0.4216965034285822, 0.31622776601683794, 0.23713737056616552, 0.1778279410038923, 0.1333521432163324, 0.1,
    0.07498942093324558, 0.05623413251903491, 0.042169650342858224, 0.03162277660168379, 0.023713737056616554, 0.01778279410038923, 0.01333521432163324, 0.01, 0.007498942093324558,
    0.005623413251903491, 0.004216965034285823, 0.0031622776601683794, 0.0023713737056616554, 0.0017782794100389228, 0.001333521432163324, 0.001, 0.0007498942093324559, 0.0005623413251903491,
    0.00042169650342858224, 0.00031622776601683794, 0.00023713737056616554, 0.00017782794100389227, 0.0001333521432163324};


#define AIN(i) ((const float*)get_args()->in[i])
#define x_p AIN(0)
#define x_s AIN(1)
#define cak AIN(2)
#define cav AIN(3)
#define cbk AIN(4)
#define cbv AIN(5)
#define ln_g AIN(6)
#define ln_b AIN(7)
#define w_in AIN(8)
#define w_dn AIN(9)
#define w_qkva AIN(10)
#define w_oa AIN(11)
#define relb AIN(12)
#define w_qkvb AIN(13)
#define w_ob AIN(14)
#define sinks AIN(15)
#define out ((float*)get_args()->out)
#define WSP ((unsigned char*)get_args()->ws)
#define Win ((bf16_t*)(WSP + WS_WIN))
#define Wdn ((bf16_t*)(WSP + WS_WDN))
#define Wqkva ((bf16_t*)(WSP + WS_WQKVA))
#define Woa ((bf16_t*)(WSP + WS_WOA))
#define Wqkvb ((bf16_t*)(WSP + WS_WQKVB))
#define Wob ((bf16_t*)(WSP + WS_WOB))
#define misc ((float*)(WSP + WS_MISC))
#define stA ((float*)(WSP + WS_STA))
#define stB ((float*)(WSP + WS_STB))
#define Zb ((bf16_t*)(WSP + WS_ZB))
#define Ksa ((bf16_t*)(WSP + WS_KSA))
#define Vtsa ((bf16_t*)(WSP + WS_VTSA))
#define Ksb ((bf16_t*)(WSP + WS_KSB))
#define Vtsb ((bf16_t*)(WSP + WS_VTSB))
#define Hb ((bf16_t*)(WSP + WS_BIG))
#define Qb ((bf16_t*)(WSP + WS_BIG))
#define Kpb ((bf16_t*)(WSP + WS_BIG + BIG_K))
#define Vtpb ((bf16_t*)(WSP + WS_BIG + BIG_VT))
#define rope (misc + MC_ROPE)
__global__ void __launch_bounds__(512, 2) fwd_kernel(Args args) {
    extern __shared__ __attribute__((aligned(16))) unsigned char lds_raw[];
    LAS unsigned char* lds = (LAS unsigned char*)lds_raw;
    cg::grid_group grid = cg::this_grid();
    const int tid = threadIdx.x, lane = tid & 63, wave = __builtin_amdgcn_readfirstlane(tid >> 6);
    const int G = gridDim.x, bid = blockIdx.x;
    const int lo = args.ph_lo, hi = args.ph_hi;
#define IN(k) (lo <= (k) && (k) < hi)
#define SEAM(k) do { if (IN(k) && IN((k) + 1)) grid.sync(); } while (0)

    if (IN(0)) {
        const int gw = bid * 8 + wave, NGW = G * 8;
        const long gt = (long)bid * 512 + tid, NGT = (long)G * 512;
        LAS float* scr = (LAS float*)(lds + wave * 16384);
        for (int it = gw; it < 1040; it += NGW) {
            int r = it;
            if (r < 704) { const int w = r / 176, grp = r % 176;
                const int lnidx = (w == 1) ? 1 : (w == 2) ? 2 : 4;
                const float* g = (w == 0) ? nullptr : ln_g + lnidx * DM; const float* b = (w == 0) ? nullptr : ln_b + lnidx * DM;
                prep_weight_item(w_in + (size_t)w * DM * 2 * FF, DM, 2 * FF, grp * 16, FF + grp * 16, g, b, Win + (size_t)w * 2 * FF * DM, grp * 32,
                                 misc + MC_WIN + w * 2 * 5632, misc + MC_WIN + w * 2 * 5632 + 5632, scr, lane);
                continue; }
            r -= 704;
            if (r < 128) { const int w = r / 32, grp = r % 32;
                prep_weight_item(w_dn + (size_t)w * FF * DM, FF, DM, grp * 32, grp * 32 + 16, nullptr, nullptr, Wdn + (size_t)w * DM * FF, grp * 32, nullptr, nullptr, scr, lane);
                continue; }
            r -= 128;
            if (r < 96) { prep_weight_item(w_qkva, DM, 3072, r * 32, r * 32 + 16, ln_g + 0 * DM, ln_b + 0 * DM, Wqkva, r * 32, misc + MC_QKVA, misc + MC_QKVA + 3072, scr, lane); continue; }
            r -= 96;
            if (r < 32) { prep_weight_item(w_oa, DM, DM, r * 32, r * 32 + 16, nullptr, nullptr, Woa, r * 32, nullptr, nullptr, scr, lane); continue; }
            r -= 32;
            if (r < 48) { int cb0, cb1; if (r < 40) { cb0 = (r >> 1) * 64 + 16 * (r & 1); cb1 = cb0 + 32; } else { cb0 = r * 32; cb1 = cb0 + 16; }
                prep_weight_item(w_qkvb, DM, 1536, cb0, cb1, ln_g + 3 * DM, ln_b + 3 * DM, Wqkvb, r * 32, misc + MC_QKVB, misc + MC_QKVB + 1536, scr, lane); continue; }
            r -= 48;
            prep_weight_item(w_ob, DM, DM, r * 32, r * 32 + 16, nullptr, nullptr, Wob, r * 32, nullptr, nullptr, scr, lane);
        }
        for (long i = gt; i < (long)MT * 128; i += NGT) {
            const int row = (int)(i >> 7), c8 = (int)(i & 127);
            const float* src = (row < MP ? x_p + (size_t)row * DM : x_s + (size_t)(row - MP) * DM) + c8 * 8;
            const f32x4 a = *(const f32x4*)src, b = *(const f32x4*)(src + 4);
            u32x4 o; o.x = pk2(a[0], a[1]); o.y = pk2(a[2], a[3]); o.z = pk2(b[0], b[1]); o.w = pk2(b[2], b[3]);
            *(u32x4*)(Zb + (size_t)row * DM + c8 * 8) = o;
        }
        for (long i = gt; i < 2064 * 32; i += NGT) {
            const int pos = (int)(i >> 5), fi = (int)(i & 31);
            const double a = (double)pos * ROPE_INV[fi];
            const double n = __builtin_floor(a * 0.15915494309189535);
            const float rr = (float)__builtin_fma(-n, 6.283185307179586, a);
            rope[2 * i] = cosf(rr); rope[2 * i + 1] = sinf(rr);
        }
        for (long i = gt; i < 16L * 544 * 128; i += NGT) {
            const int c8 = (int)(i & 127); const int bp = (int)(i >> 7); const int b = bp / 544, pos = bp % 544;
            u32x4 o = (u32x4){0u, 0u, 0u, 0u};
            if (pos < 512) { const float* src = cak + ((size_t)(b * 512 + pos) * DM + c8 * 8); const f32x4 a = *(const f32x4*)src, c = *(const f32x4*)(src + 4);
                o.x = pk2(a[0], a[1]); o.y = pk2(a[2], a[3]); o.z = pk2(c[0], c[1]); o.w = pk2(c[2], c[3]); }
            if (pos < 512 || pos >= 528) *(u32x4*)(Ksa + (size_t)bp * DM + c8 * 8) = o;
        }
        for (long i = gt; i < 16L * 16 * 68 * 64; i += NGT) {
            const int d = (int)(i & 63); long t = i >> 6; const int p8 = (int)(t % 68); t /= 68; const int h = (int)(t & 15), b = (int)(t >> 4);
            u32x4 o = (u32x4){0u, 0u, 0u, 0u};
            if (p8 < 64) { float v[8];
#pragma unroll
                for (int e = 0; e < 8; ++e) v[e] = cav[((size_t)(b * 512 + p8 * 8 + e) * 16 + h) * 64 + d];
                o.x = pk2(v[0], v[1]); o.y = pk2(v[2], v[3]); o.z = pk2(v[4], v[5]); o.w = pk2(v[6], v[7]); }
            if (p8 < 64 || p8 >= 66) *(u32x4*)(Vtsa + ((size_t)((b * 16 + h) * 64 + d) * 544 + p8 * 8)) = o;
        }
        for (long i = gt; i < 16L * 160 * 32; i += NGT) {
            const int c8 = (int)(i & 31); const int bp = (int)(i >> 5); const int b = bp / 160, pos = bp % 160;
            u32x4 o = (u32x4){0u, 0u, 0u, 0u};
            if (pos < 128) { const float* src = cbk + ((size_t)(b * 128 + pos) * 256 + c8 * 8); const f32x4 a = *(const f32x4*)src, c = *(const f32x4*)(src + 4);
                o.x = pk2(a[0], a[1]); o.y = pk2(a[2], a[3]); o.z = pk2(c[0], c[1]); o.w = pk2(c[2], c[3]); }
            if (pos < 128 || pos >= 144) *(u32x4*)(Ksb + (size_t)bp * 256 + c8 * 8) = o;
        }
        for (long i = gt; i < 16L * 4 * 20 * 64; i += NGT) {
            const int d = (int)(i & 63); long t = i >> 6; const int p8 = (int)(t % 20); t /= 20; const int h = (int)(t & 3), b = (int)(t >> 2);
            u32x4 o = (u32x4){0u, 0u, 0u, 0u};
            if (p8 < 16) { float v[8];
#pragma unroll
                for (int e = 0; e < 8; ++e) v[e] = cbv[((size_t)(b * 128 + p8 * 8 + e) * 4 + h) * 64 + d];
                o.x = pk2(v[0], v[1]); o.y = pk2(v[2], v[3]); o.z = pk2(v[4], v[5]); o.w = pk2(v[6], v[7]); }
            if (p8 < 16 || p8 >= 18) *(u32x4*)(Vtsb + ((size_t)((b * 4 + h) * 64 + d) * 160 + p8 * 8)) = o;
        }
    }
    SEAM(0);

#pragma unroll 1
    for (int s = 0; s < 14; ++s) {
        if (IN(s + 1)) {
            const int L = s / 7, k = s % 7;
            const int c = 3 * L + (k > 1) + (k > 4);
            if (false) {}
#ifndef NO_SW
            else if (k == 0 || k == 5) {
                const int w = 2 * L + (k == 5);
                pg8::Gemm g{Zb, Win + (size_t)w * 2 * FF * DM, MP, 2 * FF, DM}; pg8::StaticOrder S; S.init(MP, 2 * FF, G, bid);
                pg8::EpiSwiglu E{w, c};
                pg8::small_gemm<pg8::EpiSwiglu>(lds, g.A, g.Bt, g.N, g.K, E);
                pg8::gemm_phase<pg8::EpiSwiglu, pg8::StaticOrder, true, true>(lds, g, S, E);
            }
#endif
#ifndef NO_RES
            else if (k == 1 || k == 6 || k == 4) {
                const bool wo = (k == 4);
                const bf16_t* Bt = wo ? (L == 0 ? Woa : Wob) : Wdn + (size_t)(2 * L + (k == 6)) * DM * FF;
                pg8::Gemm g{wo ? Qb : Hb, Bt, MP, DM, wo ? DM : FF}; pg8::StaticOrder S; S.init(MP, DM, G, bid);
                pg8::EpiResid E{c, wo ? 1.0f : 0.5f};
                pg8::small_gemm<pg8::EpiResid>(lds, g.A, g.Bt, g.N, g.K, E);
                pg8::gemm_phase<pg8::EpiResid, pg8::StaticOrder, true, true>(lds, g, S, E);
            }
#endif
#ifndef NO_QKV
            else if (k == 2) {
                if (L == 0) {
                    pg8::Gemm g{Zb, Wqkva, MP, 3072, DM}; pg8::StaticOrder S; S.init(MP, 3072, G, bid);
                    pg8::EpiQkvA E{c};
                    pg8::small_gemm<pg8::EpiQkvA>(lds, g.A, g.Bt, g.N, g.K, E);
                    pg8::gemm_phase<pg8::EpiQkvA, pg8::StaticOrder, true, true>(lds, g, S, E);
                } else {
                    pg8::Gemm g{Zb, Wqkvb, MP, 1536, DM}; pg8::StaticOrder S; S.init(MP, 1536, G, bid);
                    pg8::EpiQkvB E{c};
                    pg8::small_gemm<pg8::EpiQkvB>(lds, g.A, g.Bt, g.N, g.K, E);
                    pg8::gemm_phase<pg8::EpiQkvB, pg8::StaticOrder, true, true>(lds, g, S, E);
                }
            }
#endif
#ifndef NO_ATT
            else {
                int lane_o = threadIdx.x & 63; asm volatile("" : "+v"(lane_o)); const int lane = lane_o;
                for (int bu = bid; bu < 2048 + 32; bu += G) {
                    if (L == 0) {
                        if (bu < 2048) { const int b = bu >> 7, h = (bu >> 3) & 15, chunk = (bu & 7) * 4 + (wave >> 1), half = wave & 1;
                            const size_t row0 = (size_t)b * 2048 + chunk * 64 + half * 32;
                            attn_wave<true>(Qb + row0 * DM + h * 64, DM, 32, Kpb + (size_t)b * 2048 * DM + h * 64, DM, Vtpb + (size_t)((b * 16 + h) * 64) * 2048, 2048,
                                            (chunk > 8 ? chunk - 8 : 0) * 2, (chunk + 1) * 2, 1 << 30, chunk * 64 + half * 32, relb + h * 257, 0.f, Qb + row0 * DM + h * 64, DM, lane);
                        } else { const int wu = (bu - 2048) * 8 + wave, b = wu >> 4, h = wu & 15; const size_t row0 = (size_t)MP + b * 16;
                            attn_wave<true>(Qb + row0 * DM + h * 64, DM, 16, Ksa + (size_t)b * 544 * DM + h * 64, DM, Vtsa + (size_t)((b * 16 + h) * 64) * 544, 544,
                                            0, 17, 528, 512, relb + h * 257, 0.f, Qb + row0 * DM + h * 64, DM, lane);
                        }
                    } else {
                        if (bu < 2048) { const int b = bu >> 7, kvh = (bu >> 5) & 3, chunk = bu & 31, qh = kvh * 4 + (wave >> 1), half = wave & 1;
                            const size_t row0 = (size_t)b * 2048 + chunk * 64 + half * 32;
                            attn_wave<false>(Qb + row0 * DM + qh * 64, DM, 32, Kpb + (size_t)b * 2048 * 256 + kvh * 64, 256, Vtpb + (size_t)((b * 4 + kvh) * 64) * 2048, 2048,
                                             (chunk > 2 ? chunk - 2 : 0) * 2, (chunk + 1) * 2, 1 << 30, 0, nullptr, sinks[qh], Qb + row0 * DM + qh * 64, DM, lane);
                        } else { const int wu = (bu - 2048) * 8 + wave, b = wu >> 4, qh = wu & 15, kvh = qh >> 2; const size_t row0 = (size_t)MP + b * 16;
                            attn_wave<false>(Qb + row0 * DM + qh * 64, DM, 16, Ksb + (size_t)b * 160 * 256 + kvh * 64, 256, Vtsb + (size_t)((b * 4 + kvh) * 64) * 160, 160,
                                             0, 5, 144, 0, nullptr, sinks[qh], Qb + row0 * DM + qh * 64, DM, lane);
                        }
                    }
                }
            }
#endif
        }
        SEAM(s + 1);
    }
    if (IN(15)) {
        const int gw = bid * 8 + wave, NGW = G * 8;
        const float* g = ln_g + 5 * DM; const float* b = ln_b + 5 * DM;
        f32x4 gv[4], bv[4];
#pragma unroll
        for (int j = 0; j < 4; ++j) { gv[j] = *(const f32x4*)(g + 4 * lane + 256 * j); bv[j] = *(const f32x4*)(b + 4 * lane + 256 * j); }
        for (int row = gw; row < MT; row += NGW) {
            float* zr = out + (size_t)row * DM + 4 * lane;
            f32x4 v[4]; float s = 0.f;
#pragma unroll
            for (int j = 0; j < 4; ++j) { v[j] = *(const f32x4*)(zr + 256 * j); s += (v[j][0] + v[j][1]) + (v[j][2] + v[j][3]); }
            const float mean = wave_sum(s) * (1.0f / DM); float s2 = 0.f;
#pragma unroll
            for (int j = 0; j < 4; ++j) { v[j] = v[j] - mean; s2 += (v[j][0] * v[j][0] + v[j][1] * v[j][1]) + (v[j][2] * v[j][2] + v[j][3] * v[j][3]); }
            const float rstd = 1.0f / sqrtf(wave_sum(s2) * (1.0f / DM) + 1e-5f);
#pragma unroll
            for (int j = 0; j < 4; ++j) *(f32x4*)(zr + 256 * j) = v[j] * rstd * gv[j] + bv[j];
        }
    }
#undef IN
#undef SEAM
}

#undef AIN
#undef x_p
#undef x_s
#undef cak
#undef cav
#undef cbk
#undef cbv
#undef ln_g
#undef ln_b
#undef w_in
#undef w_dn
#undef w_qkva
#undef w_oa
#undef relb
#undef w_qkvb
#undef w_ob
#undef sinks
#undef out
#undef WSP
#undef Win
#undef Wdn
#undef Wqkva
#undef Woa
#undef Wqkvb
#undef Wob
#undef misc
#undef stA
#undef stB
#undef Zb
#undef Ksa
#undef Vtsa
#undef Ksb
#undef Vtsb
#undef Hb
#undef Qb
#undef Kpb
#undef Vtpb
#undef rope
#ifndef N_LAUNCH_MODE
#define N_LAUNCH_MODE 1
#endif
extern "C" void kernel_launch(void* const* d_in, const int* in_sizes, int n_in, void* d_out, int out_size, void* d_ws, size_t ws_size, hipStream_t stream) {
    static int grid = 0;
    if (grid == 0) {
        if (n_in != 16 || ws_size < WS_END || (size_t)out_size != OUT_END) { fprintf(stderr, "kernel_launch: unexpected problem (n_in %d, out %d, ws %zu)\n", n_in, out_size, ws_size); grid = -1; return; }
        int dev = 0, cus = 0, per_cu = 0;
        (void)hipGetDevice(&dev); (void)hipDeviceGetAttribute(&cus, hipDeviceAttributeMultiprocessorCount, dev);
        if (hipFuncSetAttribute((const void*)fwd_kernel, hipFuncAttributeMaxDynamicSharedMemorySize, LDS_BYTES) != hipSuccess) { fprintf(stderr, "kernel_launch: hipFuncSetAttribute failed\n"); grid = -1; return; }
        if (hipOccupancyMaxActiveBlocksPerMultiprocessor(&per_cu, (const void*)fwd_kernel, 512, LDS_BYTES) != hipSuccess || per_cu < 1) { fprintf(stderr, "kernel_launch: occupancy query gave %d\n", per_cu); per_cu = 1; }
        (void)hipGetLastError();
        grid = cus * per_cu;
        fprintf(stderr, "kernel_launch: grid %d (cus %d x %d)\n", grid, cus, per_cu);
    }
    if (grid < 0) return;
    Args a{};
    for (int i = 0; i < 16; ++i) a.in[i] = (const float*)d_in[i];
    a.out = (float*)d_out; a.ws = (unsigned char*)d_ws;
    if (N_LAUNCH_MODE == 1) {
        a.ph_lo = 0; a.ph_hi = N_PHASES;
        void* kargs[] = {&a};
        hipError_t e = hipLaunchCooperativeKernel((const void*)fwd_kernel, dim3(grid), dim3(512), kargs, LDS_BYTES, stream);
        if (e != hipSuccess) fprintf(stderr, "cooperative launch failed: %s (grid %d)\n", hipGetErrorString(e), grid);
    } else {
        for (int p = 0; p < N_PHASES; ++p) { a.ph_lo = p; a.ph_hi = p + 1; hipLaunchKernelGGL(fwd_kernel, dim3(grid), dim3(512), LDS_BYTES, stream, a); }
    }
}
```

```cpp
#include <hip/hip_runtime.h>
#include <hip/hip_cooperative_groups.h>
#include <cstdio>
#include <cstdint>
namespace cg = cooperative_groups;
namespace pg8 {
#define PG8_LAS __attribute__((address_space(3)))
typedef unsigned short bf16_t;
typedef short bf16x8 __attribute__((ext_vector_type(8)));
typedef float f32x4 __attribute__((ext_vector_type(4)));
typedef unsigned u32x4 __attribute__((ext_vector_type(4)));
constexpr int BM = 256, BK = 64, HALF = 128, HTB = HALF * BK * 2  , STAGE_BYTES = 8 * HTB, NXCD = 8, WGM = 8;

__host__ __device__ __forceinline__ int lds_byte(int r, int c) { const int st = (r >> 4) * 2 + (c >> 5), rr = r & 15, cc = c & 31, ob = rr * 64 + cc * 2; return st * 1024 + (ob ^ (((ob >> 9) & 1) << 5)); }
__host__ __device__ __forceinline__ void stage_rc(int b, int& R, int& C) { const int st = b / 1024, sb = b % 1024, swz = sb ^ (((sb >> 9) & 1) << 5); R = (st >> 1) * 16 + swz / 64; C = (st & 1) * 32 + (swz % 64) / 2; }
__host__ __device__ __forceinline__ int perm32(int rho) { const int n = rho >> 4, i = rho & 15; return 8 * (i >> 2) + 4 * n + (i & 3); }

struct Unit { int pm, pn; };
struct Gemm { const bf16_t* A; const bf16_t* Bt; int M, N, K; };

struct StaticOrder {
    int nM, nN, nwg, G, c;
    __host__ __device__ void init(int M, int N, int G_, int c_) { nM = M / BM; nN = N / BM; nwg = nM * nN; G = G_; c = c_; }
    __host__ __device__ bool next(int i, Unit& u) const {
        const long L = (long)i * G + c; if (L >= nwg) return false;
        int wgid = (int)L; { const int q = nwg / NXCD, r = nwg % NXCD, xcd = wgid % NXCD, off = wgid / NXCD; wgid = (xcd < r ? xcd * (q + 1) : r * (q + 1) + (xcd - r) * q) + off; }
        const int nig = WGM * nN, gid = wgid / nig, fm = gid * WGM, gsz = (nM - fm) < WGM ? (nM - fm) : WGM;
        u.pm = fm + ((wgid % nig) % gsz); u.pn = (wgid % nig) / gsz; return true;
    }
    __device__ __forceinline__ void a_ready(const Unit&) const {}
    __device__ __forceinline__ void done(const Unit&) const {}
};

__device__ __forceinline__ unsigned cvt_pk_bf16(float lo, float hi) { unsigned r; asm volatile("v_cvt_pk_bf16_f32 %0, %1, %2" : "=v"(r) : "v"(lo), "v"(hi)); return r; }
template <class Epi, class Sched, bool ALIGN_EPI = false, bool SP2 = false>
__device__ __forceinline__ void gemm_phase(PG8_LAS unsigned char* lds, const Gemm g, const Sched& S, const Epi& E) {
    int tid_o = threadIdx.x; asm volatile("" : "+v"(tid_o));
    const int tid = tid_o, wid = __builtin_amdgcn_readfirstlane(tid >> 6), lane = tid & 63, wr = wid >> 2, wc = wid & 3, fr = lane & 15, fq = lane >> 4;
    const int K = g.K, nt = K / BK;
    unsigned voffA[2], voffB[2];
#pragma unroll
    for (int i = 0; i < 2; ++i) { int R, C; stage_rc(tid * 16 + i * 8192, R, C); const int Rb = Epi::PERM ? ((R & ~31) + perm32(R & 31)) : R;
        voffA[i] = (unsigned)(R * K + C) * 2u; voffB[i] = (unsigned)(Rb * K + C) * 2u; }
    const size_t kstep = (size_t)(BK * 2);
    const size_t hstep = (size_t)HALF * K * 2;
    const size_t tstep = 2 * hstep;
    const unsigned ldsw = (unsigned)wid * 1024u;
    const int aoff = lds_byte(wr * 64 + fr, fq * 8), boff = lds_byte(wc * 32 + fr, fq * 8);
#define PG8_SA(b, h) (((b) * 2 + (h)) * HTB)
#define PG8_SB(b, h) ((4 + (b) * 2 + (h)) * HTB)
#define PG8_STAGE(bufoff, gbase, voff) do { _Pragma("unroll") for (int _i = 0; _i < 2; ++_i) \
        __builtin_amdgcn_global_load_lds((const unsigned*)((const char*)(gbase) + (voff)[_i]), (PG8_LAS unsigned*)(lds + (bufoff) + ldsw + _i * 8192), 16, 0, 0); } while (0)
#define PG8_LDA(dst, b, h) do { _Pragma("unroll") for (int m = 0; m < 4; ++m) _Pragma("unroll") for (int k = 0; k < 2; ++k) dst[m][k] = *(const PG8_LAS bf16x8*)(lds + PG8_SA(b, h) + aoff + m * 2048 + k * 1024); } while (0)
#define PG8_LDB(dst, b, h) do { _Pragma("unroll") for (int n = 0; n < 2; ++n) _Pragma("unroll") for (int k = 0; k < 2; ++k) dst[n][k] = *(const PG8_LAS bf16x8*)(lds + PG8_SB(b, h) + boff + n * 2048 + k * 1024); } while (0)
#define PG8_MMA(ai, bj, At, Bt) do { __builtin_amdgcn_s_setprio(1); _Pragma("unroll") for (int m = 0; m < 4; ++m) _Pragma("unroll") for (int n = 0; n < 2; ++n) _Pragma("unroll") for (int k = 0; k < 2; ++k) \
        acc[ai][bj][m][n] = __builtin_amdgcn_mfma_f32_16x16x32_bf16(Bt[n][k], At[m][k], acc[ai][bj][m][n], 0, 0, 0); __builtin_amdgcn_s_setprio(0); } while (0)
#define PG8_WAIT_V(n) asm volatile("s_waitcnt vmcnt(" #n ")" ::: "memory")
#define PG8_WAIT_L(n) asm volatile("s_waitcnt lgkmcnt(" #n ")" ::: "memory")
#define PG8_BAR __builtin_amdgcn_s_barrier()
#define PG8_SCHED __builtin_amdgcn_sched_barrier(0)
    Unit cur, nxt; int ui = 0;
    if (!S.next(0, cur)) return;
    f32x4 acc[2][2][4][2];
#pragma unroll
    for (int a = 0; a < 2; ++a)
#pragma unroll
        for (int b = 0; b < 2; ++b)
#pragma unroll
            for (int m = 0; m < 4; ++m)
#pragma unroll
                for (int n = 0; n < 2; ++n) acc[a][b][m][n] = (f32x4){0.f, 0.f, 0.f, 0.f};
    bf16x8 At[4][2], B0[2][2], B1[2][2];
    const char* cA = (const char*)g.A + (size_t)cur.pm * tstep; const char* cB = (const char*)g.Bt + (size_t)cur.pn * tstep;
    S.a_ready(cur);
    if constexpr (SP2) {
        PG8_STAGE(PG8_SB(0, 0), cB, voffB); PG8_STAGE(PG8_SB(0, 1), cB + hstep, voffB); PG8_STAGE(PG8_SA(0, 0), cA, voffA); PG8_STAGE(PG8_SA(0, 1), cA + hstep, voffA);
        if (wr == 1) PG8_BAR;
        PG8_WAIT_V(2); PG8_BAR;
        PG8_STAGE(PG8_SB(1, 0), cB + kstep, voffB); PG8_STAGE(PG8_SA(1, 0), cA + kstep, voffA); PG8_STAGE(PG8_SB(1, 1), cB + hstep + kstep, voffB);
        PG8_WAIT_V(6); PG8_BAR;
    } else {
        PG8_STAGE(PG8_SB(0, 0), cB, voffB); PG8_STAGE(PG8_SA(0, 0), cA, voffA); PG8_STAGE(PG8_SB(0, 1), cB + hstep, voffB); PG8_STAGE(PG8_SA(0, 1), cA + hstep, voffA);
        if (wr == 1) PG8_BAR;
        PG8_WAIT_V(4); PG8_BAR;
        PG8_STAGE(PG8_SB(1, 0), cB + kstep, voffB); PG8_STAGE(PG8_SA(1, 0), cA + kstep, voffA); PG8_STAGE(PG8_SB(1, 1), cB + hstep + kstep, voffB);
        PG8_WAIT_V(6); PG8_BAR;
    }
    for (;;) {
        const bool has_next = S.next(ui + 1, nxt);
        const char* nA = has_next ? (const char*)g.A + (size_t)nxt.pm * tstep : cA; const char* nB = has_next ? (const char*)g.Bt + (size_t)nxt.pn * tstep : cB;
        for (int t = 0; t < nt; t += 2) {
            const bool last = (t == nt - 2);
            const char* a1 = cA + (size_t)(t + 1) * kstep;
            const char* a2 = last ? nA : cA + (size_t)(t + 2) * kstep; const char* b2 = last ? nB : cB + (size_t)(t + 2) * kstep;
            const char* a3 = a2 + kstep; const char* b3 = b2 + kstep;
            if (last && has_next) S.a_ready(nxt);
            if constexpr (SP2) {
            PG8_LDB(B0, 0, 0); PG8_LDB(B1, 0, 1); PG8_SCHED; PG8_LDA(At, 0, 0); PG8_STAGE(PG8_SA(1, 1), a1 + hstep, voffA);
            PG8_WAIT_V(8); PG8_WAIT_L(0); PG8_BAR; PG8_MMA(0, 0, At, B0); PG8_MMA(0, 1, At, B1); PG8_BAR; PG8_SCHED;
            PG8_LDA(At, 0, 1); PG8_STAGE(PG8_SB(0, 0), b2, voffB); PG8_STAGE(PG8_SB(0, 1), b2 + hstep, voffB); PG8_STAGE(PG8_SA(0, 0), a2, voffA);
            PG8_WAIT_V(8); PG8_WAIT_L(0); PG8_BAR; PG8_MMA(1, 0, At, B0); PG8_MMA(1, 1, At, B1); PG8_BAR; PG8_SCHED;
            PG8_LDB(B0, 1, 0); PG8_LDB(B1, 1, 1); PG8_SCHED; PG8_LDA(At, 1, 0); PG8_STAGE(PG8_SA(0, 1), a2 + hstep, voffA);
            PG8_WAIT_V(8); PG8_WAIT_L(0); PG8_BAR; PG8_MMA(0, 0, At, B0); PG8_MMA(0, 1, At, B1); PG8_BAR; PG8_SCHED;
            PG8_LDA(At, 1, 1); PG8_STAGE(PG8_SB(1, 0), b3, voffB); PG8_STAGE(PG8_SB(1, 1), b3 + hstep, voffB); PG8_STAGE(PG8_SA(1, 0), a3, voffA);
            PG8_WAIT_V(8); PG8_WAIT_L(0); PG8_BAR; PG8_MMA(1, 0, At, B0); PG8_MMA(1, 1, At, B1); PG8_BAR; PG8_SCHED;
            } else {
            PG8_LDB(B0, 0, 0); PG8_SCHED; PG8_LDA(At, 0, 0); PG8_STAGE(PG8_SA(1, 1), a1 + hstep, voffA);
            PG8_WAIT_L(8); PG8_BAR; PG8_WAIT_L(0); PG8_MMA(0, 0, At, B0); PG8_BAR; PG8_SCHED;
            PG8_LDB(B1, 0, 1); PG8_STAGE(PG8_SB(0, 0), b2, voffB);
            PG8_BAR; PG8_WAIT_L(0); PG8_MMA(0, 1, At, B1); PG8_BAR;
            PG8_LDA(At, 0, 1); PG8_STAGE(PG8_SA(0, 0), a2, voffA);
            PG8_BAR; PG8_WAIT_L(0); PG8_MMA(1, 0, At, B0); PG8_BAR; PG8_SCHED;
            PG8_STAGE(PG8_SB(0, 1), b2 + hstep, voffB);
            PG8_WAIT_V(6); PG8_BAR; PG8_MMA(1, 1, At, B1); PG8_BAR;
            PG8_LDB(B0, 1, 0); PG8_SCHED; PG8_LDA(At, 1, 0); PG8_STAGE(PG8_SA(0, 1), a2 + hstep, voffA);
            PG8_WAIT_L(8); PG8_BAR; PG8_WAIT_L(0); PG8_MMA(0, 0, At, B0); PG8_BAR; PG8_SCHED;
            PG8_LDB(B1, 1, 1); PG8_STAGE(PG8_SB(1, 0), b3, voffB);
            PG8_BAR; PG8_WAIT_L(0); PG8_MMA(0, 1, At, B1); PG8_BAR;
            PG8_LDA(At, 1, 1); PG8_STAGE(PG8_SA(1, 0), a3, voffA);
            PG8_BAR; PG8_WAIT_L(0); PG8_MMA(1, 0, At, B0); PG8_BAR; PG8_SCHED;
            PG8_STAGE(PG8_SB(1, 1), b3 + hstep, voffB);
            PG8_WAIT_V(6); PG8_BAR; PG8_MMA(1, 1, At, B1); PG8_BAR;
            }
        }
        if constexpr (ALIGN_EPI) { if (wr == 0) PG8_BAR; }
        if constexpr (!Epi::AFTER_DRAIN) { E(acc, cur, wr, wc, fr, fq); S.done(cur); }
        if (!has_next) break;
#pragma unroll
        for (int a = 0; a < 2; ++a)
#pragma unroll
            for (int b = 0; b < 2; ++b)
#pragma unroll
                for (int m = 0; m < 4; ++m)
#pragma unroll
                    for (int n = 0; n < 2; ++n) acc[a][b][m][n] = (f32x4){0.f, 0.f, 0.f, 0.f};
        cur = nxt; cA = nA; cB = nB; ++ui;
        if constexpr (ALIGN_EPI) { if (wr == 1) PG8_BAR; }
    }
    PG8_WAIT_V(0);
    if constexpr (!ALIGN_EPI) { if (wr == 0) PG8_BAR; }
    PG8_BAR;
    if constexpr (Epi::AFTER_DRAIN) { E.fused(acc, cur, wr, wc, fr, fq, lds, wid, lane); S.done(cur); }
#undef PG8_SA
#undef PG8_SB
#undef PG8_STAGE
#undef PG8_LDA
#undef PG8_LDB
#undef PG8_MMA
#undef PG8_WAIT_V
#undef PG8_WAIT_L
#undef PG8_BAR
#undef PG8_SCHED
}
}
constexpr int DM = 1024, FF = 2816, MP = 32768, MS = 256, MT = MP + MS, SEQ = 2048;
constexpr float ALPHA = 1.4142135623730951f;
constexpr float LOG2E = 1.4426950408889634f;
typedef pg8::bf16_t bf16_t;
typedef pg8::bf16x8 bf16x8;
typedef pg8::f32x4 f32x4;
typedef pg8::u32x4 u32x4;
typedef float f32x2v __attribute__((ext_vector_type(2)));
typedef float f32x16 __attribute__((ext_vector_type(16)));
typedef unsigned u32x2 __attribute__((ext_vector_type(2)));
#define LAS __attribute__((address_space(3)))

constexpr size_t MiB = 1u << 20;
constexpr size_t WS_WIN = 1 * MiB;
constexpr size_t WS_WDN = 45 * MiB;
constexpr size_t WS_WQKVA = 67 * MiB;
constexpr size_t WS_WOA = 73 * MiB;
constexpr size_t WS_WQKVB = 75 * MiB;
constexpr size_t WS_WOB = 78 * MiB;
constexpr size_t WS_MISC = 80 * MiB;
constexpr size_t WS_STA = 82 * MiB;
constexpr size_t WS_STB = 87 * MiB;
constexpr size_t WS_ZB = 92 * MiB;
constexpr size_t WS_KSA = 157 * MiB;
constexpr size_t WS_VTSA = 174 * MiB;
constexpr size_t WS_KSB = 191 * MiB;
constexpr size_t WS_VTSB = 193 * MiB;
constexpr size_t WS_BIG = 195 * MiB;
constexpr size_t BIG_K = (size_t)MT * DM * 2, BIG_VT = BIG_K + (size_t)MP * DM * 2;
constexpr size_t WS_END = 388 * MiB;
constexpr int MC_WIN = 0;
constexpr int MC_QKVA = 4 * 2 * 5632;
constexpr int MC_QKVB = MC_QKVA + 2 * 3072;
constexpr int MC_ROPE = MC_QKVB + 2 * 1536;
constexpr int LDS_BYTES = 131072 + 64;
struct Args { const float* in[16]; float* out; unsigned char* ws; int ph_lo, ph_hi; };
typedef const __attribute__((address_space(4))) Args* ArgsP;
__device__ __forceinline__ ArgsP get_args() { ArgsP p = (ArgsP)__builtin_amdgcn_kernarg_segment_ptr(); asm volatile("" : "+s"(p)); return p; }
constexpr size_t OUT_YP = 0, OUT_YS = (size_t)MP * DM, OUT_AKP = OUT_YS + (size_t)MS * DM, OUT_AVP = OUT_AKP + (size_t)16 * 512 * 1024, OUT_BKP = OUT_AVP + (size_t)16 * 512 * 1024,
                 OUT_BVP = OUT_BKP + (size_t)16 * 128 * 256, OUT_AKS = OUT_BVP + (size_t)16 * 128 * 256, OUT_AVS = OUT_AKS + (size_t)16 * 16 * 1024, OUT_BKS = OUT_AVS + (size_t)16 * 16 * 1024,
                 OUT_BVS = OUT_BKS + (size_t)16 * 16 * 256, OUT_END = OUT_BVS + (size_t)16 * 16 * 256;


__device__ __forceinline__ unsigned f2bf(float f) { unsigned u = __builtin_bit_cast(unsigned, f); return (u + 0x7fffu + ((u >> 16) & 1u)) >> 16; }
__device__ __forceinline__ unsigned pk2(float lo, float hi) { return f2bf(lo) | (f2bf(hi) << 16); }
__device__ __forceinline__ float bfround(float f) { return __builtin_bit_cast(float, f2bf(f) << 16); }
__device__ __forceinline__ u32x2 pk4(f32x4 v) { u32x2 r; r.x = pg8::cvt_pk_bf16(v[0], v[1]); r.y = pg8::cvt_pk_bf16(v[2], v[3]); return r; }
__device__ __forceinline__ float wave_sum(float v) {
#pragma unroll
    for (int o = 1; o < 64; o <<= 1) v += __shfl_xor(v, o);
    return v;
}

namespace pg8 {
__device__ __forceinline__ void row_mean_rstd(const float* st, int row, int fq, float& mean, float& rstd) {
    const f32x4* p = (const f32x4*)(st + (unsigned)row * 32 + 8 * fq);
    const f32x4 a = p[0], b = p[1];
    float s = (a[0] + a[2]) + (b[0] + b[2]), q = (a[1] + a[3]) + (b[1] + b[3]);
    s += __shfl_xor(s, 16); s += __shfl_xor(s, 32); q += __shfl_xor(q, 16); q += __shfl_xor(q, 32);
    mean = s * (1.0f / 1024.0f);
    const float var = fmaxf(q * (1.0f / 1024.0f) - mean * mean, 0.f);
    rstd = 1.0f / sqrtf(var + 1e-5f);
}

#define PG8_EPI_WALK() \
    __device__ __forceinline__ void operator()(const f32x4 (&acc)[2][2][4][2], const Unit& u, int wr, int wc, int fr, int fq) const { \
        const Ctx cx = ctx(); \
        _Pragma("unroll") for (int ai = 0; ai < 2; ++ai) _Pragma("unroll") for (int m = 0; m < 4; ++m) { \
            const int row = u.pm * 256 + ai * 128 + wr * 64 + m * 16 + fr; \
            const f32x4 v[2][2] = {{acc[ai][0][m][0], acc[ai][0][m][1]}, {acc[ai][1][m][0], acc[ai][1][m][1]}}; \
            row_op(cx, u.pm, u.pn, wc, row, fq, v); } }

struct EpiSwiglu {
    static constexpr bool PERM = false, AFTER_DRAIN = false;
    int w, cnt;
    struct Ctx { bf16_t* H; const float* st; const float* c1; const float* c2; };
    __device__ __forceinline__ Ctx ctx() const {
        unsigned char* wsp = get_args()->ws; Ctx c;
        c.H = (bf16_t*)(wsp + WS_BIG); c.st = cnt == 0 ? nullptr : (const float*)(wsp + ((cnt & 1) ? WS_STA : WS_STB));
        c.c1 = (const float*)(wsp + WS_MISC) + MC_WIN + w * 2 * 5632; c.c2 = c.c1 + 5632; return c; }
    __device__ __forceinline__ void row_op(const Ctx& cx, int pm, int pn, int wc, int row, int fq, const f32x4 (&v)[2][2]) const {
        const int sb0 = pn * 256 + wc * 32 + 4 * fq, ff0 = pn * 128 + wc * 16 + 4 * fq;
        const bool fold = (cx.st != nullptr);
        float mean = 0.f, rstd = 1.f;
        if (fold) row_mean_rstd(cx.st, row, fq, mean, rstd);
#pragma unroll
        for (int bj = 0; bj < 2; ++bj) {
            f32x4 g = v[bj][0], up = v[bj][1];
            if (fold) {
                const f32x4 c1g = *(const f32x4*)(cx.c1 + sb0 + bj * 128), c1u = *(const f32x4*)(cx.c1 + sb0 + bj * 128 + 16);
                const f32x4 c2g = *(const f32x4*)(cx.c2 + sb0 + bj * 128), c2u = *(const f32x4*)(cx.c2 + sb0 + bj * 128 + 16);
                g = (g - mean * c1g) * rstd + c2g; up = (up - mean * c1u) * rstd + c2u;
            }
            f32x4 hv;
#pragma unroll
            for (int j = 0; j < 4; ++j) hv[j] = g[j] * __builtin_amdgcn_rcpf(1.0f + __expf(-g[j])) * up[j];
            *(u32x2*)(cx.H + (unsigned)row * FF + ff0 + bj * 64) = pk4(hv);
        }
    }
    PG8_EPI_WALK()
};

struct EpiResid {
    static constexpr bool PERM = false, AFTER_DRAIN = false;
    int cnt; float cs;
    struct Ctx { float* Z; const float* xp; const float* xs; const float* stp; const float* g; const float* b; float* stn; bf16_t* Zb; };
    __device__ __forceinline__ Ctx ctx() const {
        unsigned char* wsp = get_args()->ws; Ctx c;
        c.Z = get_args()->out; c.xp = get_args()->in[0]; c.xs = get_args()->in[1];
        c.stp = cnt == 0 ? nullptr : (const float*)(wsp + ((cnt & 1) ? WS_STA : WS_STB)); c.stn = (float*)(wsp + ((cnt & 1) ? WS_STB : WS_STA));
        const int lni = cnt > 0 ? cnt - 1 : 0;
        c.g = get_args()->in[6] + lni * DM; c.b = get_args()->in[7] + lni * DM; c.Zb = (bf16_t*)(wsp + WS_ZB); return c; }
    __device__ __forceinline__ void row_op(const Ctx& cx, int pm, int pn, int wc, int row, int fq, const f32x4 (&v)[2][2]) const {
        const int col0 = pn * 256 + wc * 32 + 4 * fq;
        const bool first = (cx.stp == nullptr);
        float mean = 0.f, rstd = 1.f;
        if (!first) row_mean_rstd(cx.stp, row, fq, mean, rstd);
        const float* src = first ? (pm < 128 ? cx.xp + (unsigned)row * DM : cx.xs + (unsigned)(row - MP) * DM) : cx.Z + (unsigned)row * DM;
        float s = 0.f, q = 0.f;
#pragma unroll
        for (int bj = 0; bj < 2; ++bj)
#pragma unroll
            for (int n = 0; n < 2; ++n) {
                const int col = col0 + bj * 128 + n * 16;
                f32x4 x = *(const f32x4*)(src + col);
                if (!first) { const f32x4 gv = *(const f32x4*)(cx.g + col), bv = *(const f32x4*)(cx.b + col); x = (x - mean) * rstd * gv + bv; }
                const f32x4 zn = ALPHA * x + cs * v[bj][n];
                *(f32x4*)(cx.Z + (unsigned)row * DM + col) = zn;
                *(u32x2*)(cx.Zb + (unsigned)row * DM + col) = pk4(zn);
                s += (zn[0] + zn[1]) + (zn[2] + zn[3]);
                q += (zn[0] * zn[0] + zn[1] * zn[1]) + (zn[2] * zn[2] + zn[3] * zn[3]);
            }
        s += __shfl_xor(s, 16); s += __shfl_xor(s, 32); q += __shfl_xor(q, 16); q += __shfl_xor(q, 32);
        if (fq == 0) *(f32x2v*)(cx.stn + (unsigned)row * 32 + (pn * 4 + wc) * 2) = (f32x2v){s, q};
    }
    PG8_EPI_WALK()
};

struct EpiQkvA {
    static constexpr bool PERM = false, AFTER_DRAIN = false;
    int cnt;
    struct Ctx { const float* st; const float* c1; const float* c2; bf16_t* Q; bf16_t* Kp; bf16_t* Vtp; bf16_t* Ks; bf16_t* Vts; float* outp; };
    __device__ __forceinline__ Ctx ctx() const {
        unsigned char* wsp = get_args()->ws; Ctx c; c.outp = get_args()->out;
        c.st = (const float*)(wsp + ((cnt & 1) ? WS_STA : WS_STB)); c.c1 = (const float*)(wsp + WS_MISC) + MC_QKVA; c.c2 = c.c1 + 3072;
        c.Q = (bf16_t*)(wsp + WS_BIG); c.Kp = (bf16_t*)(wsp + WS_BIG + BIG_K); c.Vtp = (bf16_t*)(wsp + WS_BIG + BIG_VT); c.Ks = (bf16_t*)(wsp + WS_KSA); c.Vts = (bf16_t*)(wsp + WS_VTSA); return c; }
    __device__ __forceinline__ void row_op(const Ctx& cx, int pm, int pn, int wc, int row, int fq, const f32x4 (&va)[2][2]) const {
        const int typ = pn >> 2, hc0 = (pn & 3) * 256 + wc * 32 + 4 * fq, ns0 = pn * 256 + wc * 32 + 4 * fq;
        const bool sample = (pm == 128);
        float* okp = cx.outp + OUT_AKP; float* ovp = cx.outp + OUT_AVP; float* oks = cx.outp + OUT_AKS; float* ovs = cx.outp + OUT_AVS;
        float mean, rstd; row_mean_rstd(cx.st, row, fq, mean, rstd);
        int b, pos; if (!sample) { b = row >> 11; pos = row & 2047; } else { const int r = row - MP; b = r >> 4; pos = r & 15; }
#pragma unroll
        for (int bj = 0; bj < 2; ++bj)
#pragma unroll
            for (int n = 0; n < 2; ++n) {
                const int hc = hc0 + bj * 128 + n * 16;
                const f32x4 v = (va[bj][n] - mean * *(const f32x4*)(cx.c1 + ns0 + bj * 128 + n * 16)) * rstd + *(const f32x4*)(cx.c2 + ns0 + bj * 128 + n * 16);
                if (typ == 0) { *(u32x2*)(cx.Q + (unsigned)row * DM + hc) = pk4(v); }
                else if (typ == 1) {
                    if (!sample) { *(u32x2*)(cx.Kp + (unsigned)row * DM + hc) = pk4(v); if (pos >= 1536) *(f32x4*)(okp + ((unsigned)(b * 512 + pos - 1536) * DM + hc)) = v; }
                    else { *(u32x2*)(cx.Ks + ((unsigned)(b * 544 + 512 + pos) * DM + hc)) = pk4(v); *(f32x4*)(oks + ((unsigned)(b * 16 + pos) * DM + hc)) = v; }
                } else {
                    const int h = hc >> 6, d = hc & 63;
                    if (!sample) {
                        bf16_t* vt = cx.Vtp + ((unsigned)((b * 16 + h) * 64 + d) * 2048 + pos);
#pragma unroll
                        for (int j = 0; j < 4; ++j) vt[(unsigned)j * 2048] = (bf16_t)f2bf(v[j]);
                        if (pos >= 1536) *(f32x4*)(ovp + ((unsigned)(b * 512 + pos - 1536) * DM + hc)) = v;
                    } else {
                        bf16_t* vt = cx.Vts + ((unsigned)((b * 16 + h) * 64 + d) * 544 + 512 + pos);
#pragma unroll
                        for (int j = 0; j < 4; ++j) vt[(unsigned)j * 544] = (bf16_t)f2bf(v[j]);
                        *(f32x4*)(ovs + ((unsigned)(b * 16 + pos) * DM + hc)) = v;
                    }
                }
            }
    }
    PG8_EPI_WALK()
};

struct EpiQkvB {
    static constexpr bool PERM = false, AFTER_DRAIN = false;
    int cnt;
    struct Ctx { const float* st; const float* c1; const float* c2; const float* rope; bf16_t* Q; bf16_t* Kp; bf16_t* Vtp; bf16_t* Ks; bf16_t* Vts; float* outp; };
    __device__ __forceinline__ Ctx ctx() const {
        unsigned char* wsp = get_args()->ws; Ctx c; c.outp = get_args()->out;
        c.st = (const float*)(wsp + ((cnt & 1) ? WS_STA : WS_STB)); c.c1 = (const float*)(wsp + WS_MISC) + MC_QKVB; c.c2 = c.c1 + 1536; c.rope = (const float*)(wsp + WS_MISC) + MC_ROPE;
        c.Q = (bf16_t*)(wsp + WS_BIG); c.Kp = (bf16_t*)(wsp + WS_BIG + BIG_K); c.Vtp = (bf16_t*)(wsp + WS_BIG + BIG_VT); c.Ks = (bf16_t*)(wsp + WS_KSB); c.Vts = (bf16_t*)(wsp + WS_VTSB); return c; }
    __device__ __forceinline__ void row_op(const Ctx& cx, int pm, int pn, int wc, int row, int fq, const f32x4 (&va)[2][2]) const {
        const int ns0 = pn * 256 + wc * 32 + 4 * fq;
        const bool sample = (pm == 128);
        float* okp = cx.outp + OUT_BKP; float* ovp = cx.outp + OUT_BVP; float* oks = cx.outp + OUT_BKS; float* ovs = cx.outp + OUT_BVS;
        const int dlo = 16 * (wc & 1) + 4 * fq;
        float mean, rstd; row_mean_rstd(cx.st, row, fq, mean, rstd);
        int b, pos; if (!sample) { b = row >> 11; pos = row & 2047; } else { const int r = row - MP; b = r >> 4; pos = r & 15; }
        if (pn < 5) {
            const int rp = sample ? 2048 + pos : pos;
            const f32x4 cs0 = *(const f32x4*)(cx.rope + ((unsigned)rp * 32 + dlo) * 2), cs1 = *(const f32x4*)(cx.rope + ((unsigned)rp * 32 + dlo) * 2 + 4);
            const f32x4 cc = (f32x4){cs0[0], cs0[2], cs1[0], cs1[2]}, ss = (f32x4){cs0[1], cs0[3], cs1[1], cs1[3]};
#pragma unroll
            for (int bj = 0; bj < 2; ++bj) {
                const f32x4 x1 = (va[bj][0] - mean * *(const f32x4*)(cx.c1 + ns0 + bj * 128)) * rstd + *(const f32x4*)(cx.c2 + ns0 + bj * 128);
                const f32x4 x2 = (va[bj][1] - mean * *(const f32x4*)(cx.c1 + ns0 + bj * 128 + 16)) * rstd + *(const f32x4*)(cx.c2 + ns0 + bj * 128 + 16);
                const f32x4 lo = x1 * cc - x2 * ss, hi = x2 * cc + x1 * ss;
                const int hit = bj * 2 + (wc >> 1);
                if (pn < 4) {
                    const int hc = (pn * 4 + hit) * 64 + dlo;
                    *(u32x2*)(cx.Q + (unsigned)row * DM + hc) = pk4(lo); *(u32x2*)(cx.Q + (unsigned)row * DM + hc + 32) = pk4(hi);
                } else {
                    const int kc = hit * 64 + dlo;
                    if (!sample) {
                        *(u32x2*)(cx.Kp + (unsigned)row * 256 + kc) = pk4(lo); *(u32x2*)(cx.Kp + (unsigned)row * 256 + kc + 32) = pk4(hi);
                        if (pos >= 1920) { float* o = okp + ((unsigned)(b * 128 + pos - 1920) * 256 + kc); *(f32x4*)o = lo; *(f32x4*)(o + 32) = hi; }
                    } else {
                        bf16_t* kd = cx.Ks + ((unsigned)(b * 160 + 128 + pos) * 256 + kc); *(u32x2*)kd = pk4(lo); *(u32x2*)(kd + 32) = pk4(hi);
                        float* o = oks + ((unsigned)(b * 16 + pos) * 256 + kc); *(f32x4*)o = lo; *(f32x4*)(o + 32) = hi;
                    }
                }
            }
        } else {
#pragma unroll
            for (int bj = 0; bj < 2; ++bj)
#pragma unroll
                for (int n = 0; n < 2; ++n) {
                    const int hc = bj * 128 + wc * 32 + n * 16 + 4 * fq, kvh = hc >> 6, d = hc & 63;
                    const f32x4 v = (va[bj][n] - mean * *(const f32x4*)(cx.c1 + ns0 + bj * 128 + n * 16)) * rstd + *(const f32x4*)(cx.c2 + ns0 + bj * 128 + n * 16);
                    if (!sample) {
                        bf16_t* vt = cx.Vtp + ((unsigned)((b * 4 + kvh) * 64 + d) * 2048 + pos);
#pragma unroll
                        for (int j = 0; j < 4; ++j) vt[(unsigned)j * 2048] = (bf16_t)f2bf(v[j]);
                        if (pos >= 1920) *(f32x4*)(ovp + ((unsigned)(b * 128 + pos - 1920) * 256 + hc)) = v;
                    } else {
                        bf16_t* vt = cx.Vts + ((unsigned)((b * 4 + kvh) * 64 + d) * 160 + 128 + pos);
#pragma unroll
                        for (int j = 0; j < 4; ++j) vt[(unsigned)j * 160] = (bf16_t)f2bf(v[j]);
                        *(f32x4*)(ovs + ((unsigned)(b * 16 + pos) * 256 + hc)) = v;
                    }
                }
        }
    }
    PG8_EPI_WALK()
};

template <class Epi>
__device__ __forceinline__ void small_gemm(PG8_LAS unsigned char* lds, const bf16_t* A, const bf16_t* Bt, int N, int K, const Epi& E) {
    typedef float f32x16 __attribute__((ext_vector_type(16)));
    int tid_o = threadIdx.x; asm volatile("" : "+v"(tid_o));
    const int tid = tid_o, wid = __builtin_amdgcn_readfirstlane(tid >> 6), lane = tid & 63, r = lane & 31, h = lane >> 5;
    const int ntiles = 8 * (N / 64), ks = K / 8;
    PG8_LAS float* part = (PG8_LAS float*)lds;
    const typename Epi::Ctx cx = E.ctx();
    for (int tile = blockIdx.x; tile < ntiles; tile += gridDim.x) {
        const int tm = tile & 7, tn = tile >> 3, pn = tn >> 2, wc = tn & 3;
        const bf16_t* ap = A + (size_t)(MP + tm * 32 + r) * K + wid * ks + 8 * h;
        const bf16_t* bp0 = Bt + (size_t)(pn * 256 + wc * 32 + r) * K + wid * ks + 8 * h;
        const bf16_t* bp1 = bp0 + (size_t)128 * K;
        f32x16 acc0, acc1;
#pragma unroll
        for (int i = 0; i < 16; ++i) { acc0[i] = 0.f; acc1[i] = 0.f; }
#pragma unroll 2
        for (int k0 = 0; k0 < ks; k0 += 16) {
            const bf16x8 a = *(const bf16x8*)(ap + k0), b0 = *(const bf16x8*)(bp0 + k0), b1 = *(const bf16x8*)(bp1 + k0);
            acc0 = __builtin_amdgcn_mfma_f32_32x32x16_bf16(b0, a, acc0, 0, 0, 0);
            acc1 = __builtin_amdgcn_mfma_f32_32x32x16_bf16(b1, a, acc1, 0, 0, 0);
        }
#pragma unroll
        for (int g = 0; g < 4; ++g) {
            *(PG8_LAS f32x4*)(part + ((wid * 2 + 0) * 32 + r) * 36 + 8 * g + 4 * h) = (f32x4){acc0[4 * g], acc0[4 * g + 1], acc0[4 * g + 2], acc0[4 * g + 3]};
            *(PG8_LAS f32x4*)(part + ((wid * 2 + 1) * 32 + r) * 36 + 8 * g + 4 * h) = (f32x4){acc1[4 * g], acc1[4 * g + 1], acc1[4 * g + 2], acc1[4 * g + 3]};
        }
        __syncthreads();
        if (wid < 2) {
            const int fr = lane & 15, fq = lane >> 4, rr = wid * 16 + fr;
            f32x4 v[2][2];
#pragma unroll
            for (int bj = 0; bj < 2; ++bj)
#pragma unroll
                for (int n = 0; n < 2; ++n) {
                    f32x4 s = *(const PG8_LAS f32x4*)(part + ((0 * 2 + bj) * 32 + rr) * 36 + 16 * n + 4 * fq);
#pragma unroll
                    for (int w = 1; w < 8; ++w) s += *(const PG8_LAS f32x4*)(part + ((w * 2 + bj) * 32 + rr) * 36 + 16 * n + 4 * fq);
                    v[bj][n] = s;
                }
            E.row_op(cx, 128, pn, wc, MP + tm * 32 + rr, fq, v);
        }
        __syncthreads();
    }
}
}
template <bool MODE_A>
__device__ __forceinline__ void attn_wave(const bf16_t* Qrow0, int ldq, int nq, const bf16_t* Kb, int ldk, const bf16_t* Vt, int ldv,
                                          int kt0, int kt1, int nvalid, int qpos0, const float* tab, float sink, bf16_t* Orow0, int ldo, int lane) {
    const int r = lane & 31, h = lane >> 5;
    const int qr = r < nq ? r : nq - 1;
    bf16x8 qf[4];
#pragma unroll
    for (int s = 0; s < 4; ++s) qf[s] = *(const bf16x8*)(Qrow0 + (size_t)qr * ldq + 16 * s + 8 * h);
    const int pr = (r & ~12) | ((r & 4) << 1) | ((r & 8) >> 1);
    f32x16 O0, O1;
#pragma unroll
    for (int i = 0; i < 16; ++i) { O0[i] = 0.f; O1[i] = 0.f; }
    float mrun = MODE_A ? -1e30f : sink * LOG2E;
    float l = MODE_A ? 0.f : (h == 0 ? 1.f : 0.f);
    const float SC = 0.125f * LOG2E;
    const float tconst = MODE_A ? tab[256] * LOG2E : 0.f;
    for (int kt = kt0; kt < kt1; ++kt) {
        const int k0 = kt * 32;
        const bf16_t* kp = Kb + (size_t)(k0 + pr) * ldk + 8 * h;
        bf16x8 kf[4], vf[2][2];
#pragma unroll
        for (int s = 0; s < 4; ++s) kf[s] = *(const bf16x8*)(kp + 16 * s);
#pragma unroll
        for (int dt = 0; dt < 2; ++dt)
#pragma unroll
            for (int s = 0; s < 2; ++s) vf[dt][s] = *(const bf16x8*)(Vt + (size_t)(dt * 32 + r) * ldv + k0 + 16 * s + 8 * h);
        f32x16 S;
#pragma unroll
        for (int i = 0; i < 16; ++i) S[i] = 0.f;
#pragma unroll
        for (int s = 0; s < 4; ++s) S = __builtin_amdgcn_mfma_f32_32x32x16_bf16(kf[s], qf[s], S, 0, 0, 0);
        float t[16];
        const int qp = qpos0 + r;
        const bool farblk = MODE_A && (qpos0 - (k0 + 31) >= 128);
        float mx = -1e30f;
#pragma unroll
        for (int i = 0; i < 16; ++i) {
            const int key = k0 + 16 * (i >> 3) + 8 * h + (i & 7);
            float bias = 0.f;
            if (MODE_A) {
                if (farblk) bias = tconst;
                else { int rel = qp - key; rel = rel < -128 ? -128 : (rel > 128 ? 128 : rel); bias = tab[rel + 128] * LOG2E; }
            }
            float v = S[i] * SC + bias;
            if (key >= nvalid) v = -1e30f;
            t[i] = v; mx = fmaxf(mx, v);
        }
        mx = fmaxf(mx, __shfl_xor(mx, 32));
        const float mnew = fmaxf(mrun, mx);
        const float alpha = __builtin_amdgcn_exp2f(mrun - mnew);
        mrun = mnew;
        float ps = 0.f;
#pragma unroll
        for (int i = 0; i < 16; ++i) { t[i] = __builtin_amdgcn_exp2f(t[i] - mnew); ps += t[i]; }
        l = l * alpha + ps;
#pragma unroll
        for (int i = 0; i < 16; ++i) { O0[i] *= alpha; O1[i] *= alpha; }
        bf16x8 pf[2];
#pragma unroll
        for (int s = 0; s < 2; ++s) {
            u32x4 w; w.x = pg8::cvt_pk_bf16(t[8 * s + 0], t[8 * s + 1]); w.y = pg8::cvt_pk_bf16(t[8 * s + 2], t[8 * s + 3]);
            w.z = pg8::cvt_pk_bf16(t[8 * s + 4], t[8 * s + 5]); w.w = pg8::cvt_pk_bf16(t[8 * s + 6], t[8 * s + 7]);
            pf[s] = __builtin_bit_cast(bf16x8, w);
        }
        O0 = __builtin_amdgcn_mfma_f32_32x32x16_bf16(vf[0][0], pf[0], O0, 0, 0, 0);
        O0 = __builtin_amdgcn_mfma_f32_32x32x16_bf16(vf[0][1], pf[1], O0, 0, 0, 0);
        O1 = __builtin_amdgcn_mfma_f32_32x32x16_bf16(vf[1][0], pf[0], O1, 0, 0, 0);
        O1 = __builtin_amdgcn_mfma_f32_32x32x16_bf16(vf[1][1], pf[1], O1, 0, 0, 0);
    }
    l += __shfl_xor(l, 32);
    const float inv = 1.0f / l;
    if (r < nq) {
        bf16_t* op = Orow0 + (size_t)r * ldo + 4 * h;
#pragma unroll
        for (int g = 0; g < 4; ++g) {
            f32x4 a = (f32x4){O0[4 * g], O0[4 * g + 1], O0[4 * g + 2], O0[4 * g + 3]} * inv;
            f32x4 b = (f32x4){O1[4 * g], O1[4 * g + 1], O1[4 * g + 2], O1[4 * g + 3]} * inv;
            *(u32x2*)(op + 8 * g) = pk4(a);
            *(u32x2*)(op + 32 + 8 * g) = pk4(b);
        }
    }
}

__device__ __forceinline__ void prep_weight_item(const float* W, int K, int N, int cb0, int cb1, const float* g, const float* b, bf16_t* Bt, int row0, float* c1, float* c2,
                                                 LAS float* scr, int lane) {
    const int c = lane & 31, col = c < 16 ? cb0 + c : cb1 + c - 16;
    float a1 = 0.f, a2 = 0.f;
    for (int k0 = 0; k0 < K; k0 += 64) {
#pragma unroll 8
        for (int i = 0; i < 32; ++i) {
            const int kk = 2 * i + (lane >> 5);
            const float w = W[(size_t)(k0 + kk) * N + col];
            float v = w;
            if (g) { v = w * g[k0 + kk]; a2 += w * b[k0 + kk]; }
            v = bfround(v); a1 += v;
            scr[kk * 33 + c] = v;
        }
        asm volatile("s_waitcnt lgkmcnt(0)" ::: "memory");
        const int c8 = lane & 7;
#pragma unroll
        for (int j = 0; j < 4; ++j) {
            const int n = (lane >> 3) + 8 * j; const LAS float* s = scr + (8 * c8) * 33 + n;
            u32x4 o;
            o.x = (__builtin_bit_cast(unsigned, s[0 * 33]) >> 16) | (__builtin_bit_cast(unsigned, s[1 * 33]) & 0xffff0000u);
            o.y = (__builtin_bit_cast(unsigned, s[2 * 33]) >> 16) | (__builtin_bit_cast(unsigned, s[3 * 33]) & 0xffff0000u);
            o.z = (__builtin_bit_cast(unsigned, s[4 * 33]) >> 16) | (__builtin_bit_cast(unsigned, s[5 * 33]) & 0xffff0000u);
            o.w = (__builtin_bit_cast(unsigned, s[6 * 33]) >> 16) | (__builtin_bit_cast(unsigned, s[7 * 33]) & 0xffff0000u);
            *(u32x4*)(Bt + (size_t)(row0 + n) * K + k0 + 8 * c8) = o;
        }
        asm volatile("s_waitcnt lgkmcnt(0)" ::: "memory");
    }
    a1 += __shfl_xor(a1, 32); a2 += __shfl_xor(a2, 32);
    if (c1 && lane < 32) { c1[row0 + c] = a1; c2[row0 + c] = a2; }
}
constexpr int N_PHASES = 16;
#include <cstdint>
#include <cstdlib>
#include <vector>

#include <cstdint>
#include <cstdlib>
#include <vector>

#define XB_TMO      128
#define XB_XCNT(j)  (256  + 64 * (j))
#define XB_XSUB(j)  (1280 + 64 * (j))
#define XB_XGEN(j)  (2304 + 64 * (j))
#define XB_TOP      3328
#define XB_TOPGEN   3392
#define XCD_BAR_WORDS 3456
#define XB_SPIN_CAP (1u << 18)

__device__ __forceinline__ unsigned xb_ld(unsigned* p)              { return __hip_atomic_load(p, __ATOMIC_RELAXED, __HIP_MEMORY_SCOPE_AGENT); }
__device__ __forceinline__ unsigned xb_add(unsigned* p, unsigned v) { return __hip_atomic_fetch_add(p, v, __ATOMIC_RELAXED, __HIP_MEMORY_SCOPE_AGENT); }
__device__ __forceinline__ unsigned xb_xcc_id() { return (unsigned)__builtin_amdgcn_s_getreg((3 << 11) | 20) & 0xFu; }
#define XB_SPIN(cond, bar) do { unsigned _sp = 0; while (cond) { __builtin_amdgcn_s_sleep(1); \
    if ((++_sp & 255u) == 0u) { if (xb_ld(&(bar)[XB_TMO])) break; if (_sp > XB_SPIN_CAP) { atomicAdd(&(bar)[XB_TMO], 1u); break; } } } } while (0)

struct XcdBarrier {
    unsigned* bar; unsigned x;
    volatile LAS unsigned* st;
};

__device__ __forceinline__ XcdBarrier xcd_barrier_post(unsigned* bar, volatile LAS unsigned* st) {
    XcdBarrier b; b.bar = bar; b.x = xb_xcc_id(); b.st = st;
    if (threadIdx.x == 0) (void)xb_add(&bar[XB_XCNT(b.x)], 1u);
    return b;
}
__device__ __forceinline__ void xcd_barrier_complete(unsigned* bar, unsigned x, unsigned& nloc, unsigned& nx) {
    const unsigned G = gridDim.x * gridDim.y * gridDim.z;
    unsigned sum, cnt, mine, sp = 0u;
    for (;;) {
        sum = 0u; cnt = 0u; mine = 0u;
#pragma unroll
        for (unsigned j = 0; j < 16; ++j) { const unsigned c = xb_ld(&bar[XB_XCNT(j)]); sum += c; cnt += (c > 0u) ? 1u : 0u; mine = (j == x) ? c : mine; }
        if (sum == G) break;
        __builtin_amdgcn_s_sleep(1);
        if ((++sp & 255u) == 0u) { if (xb_ld(&bar[XB_TMO])) break; if (sp > XB_SPIN_CAP) { atomicAdd(&bar[XB_TMO], 1u); break; } }
    }
    nloc = mine > 0u ? mine : 1u; nx = cnt > 0u ? cnt : 1u;
}

__device__ __forceinline__ void xcd_barrier(const XcdBarrier& b) {
    asm volatile("s_waitcnt vmcnt(0)" ::: "memory");
    __syncthreads();
    if (threadIdx.x == 0) {
        unsigned* bar = b.bar;
        __builtin_amdgcn_s_waitcnt(0);
        unsigned nloc = b.st[0], nx = b.st[1];
        if (nloc == 0u) { xcd_barrier_complete(bar, b.x, nloc, nx); b.st[0] = nloc; b.st[1] = nx; }
        const unsigned old = xb_add(&bar[XB_XSUB(b.x)], 1u);
        const unsigned gen = old / nloc;
        if (old + 1u == (gen + 1u) * nloc) {
            __builtin_amdgcn_fence(__ATOMIC_RELEASE, "agent");
            asm volatile("s_waitcnt vmcnt(0)" ::: "memory");
            const unsigned og = xb_add(&bar[XB_TOP], 1u);
            const unsigned tg = og / nx;
            if (og + 1u == (tg + 1u) * nx) xb_add(&bar[XB_TOPGEN], 1u);
            else XB_SPIN(xb_ld(&bar[XB_TOPGEN]) == tg, bar);
            __builtin_amdgcn_fence(__ATOMIC_ACQUIRE, "agent");
            xb_add(&bar[XB_XGEN(b.x)], 1u);
            asm volatile("s_waitcnt vmcnt(0)" ::: "memory");
        } else {
            XB_SPIN(xb_ld(&bar[XB_XGEN(b.x)]) == gen, bar);
            __builtin_amdgcn_fence(__ATOMIC_ACQUIRE, "agent");
            asm volatile("s_waitcnt vmcnt(0)" ::: "memory");
        }
    }
    __syncthreads();
}


__device__ const double ROPE_INV[32] = {1.0, 0.7498942093324559, 0.5623413251903491, 0.4216965034285822, 0.31622776601683794, 0.23713737056616552, 0.1778279410038923, 0.1333521432163324, 0.1,
    0.07498942093324558, 0.05623413251903491, 0.042169650342858224, 0.03162277660168379, 0.023713737056616554, 0.01778279410038923, 0.01333521432163324, 0.01, 0.007498942093324558,
    0.005623413251903491, 0.004216965034285823, 0.0031622776601683794, 0.0023713737056616554, 0.0017782794100389228, 0.001333521432163324, 0.001, 0.0007498942093324559, 0.0005623413251903491,
    0.00042169650342858224, 0.00031622776601683794, 0.00023713737056616554, 0.00017782794100389227, 0.0001333521432163324};


#define AIN(i) ((const float*)get_args()->in[i])
#define x_p AIN(0)
#define x_s AIN(1)
#define cak AIN(2)
#define cav AIN(3)
#define cbk AIN(4)
#define cbv AIN(5)
#define ln_g AIN(6)
#define ln_b AIN(7)
#define w_in AIN(8)
#define w_dn AIN(9)
#define w_qkva AIN(10)
#define w_oa AIN(11)
#define relb AIN(12)
#define w_qkvb AIN(13)
#define w_ob AIN(14)
#define sinks AIN(15)
#define out ((float*)get_args()->out)
#define WSP ((unsigned char*)get_args()->ws)
#define Win ((bf16_t*)(WSP + WS_WIN))
#define Wdn ((bf16_t*)(WSP + WS_WDN))
#define Wqkva ((bf16_t*)(WSP + WS_WQKVA))
#define Woa ((bf16_t*)(WSP + WS_WOA))
#define Wqkvb ((bf16_t*)(WSP + WS_WQKVB))
#define Wob ((bf16_t*)(WSP + WS_WOB))
#define misc ((float*)(WSP + WS_MISC))
#define stA ((float*)(WSP + WS_STA))
#define stB ((float*)(WSP + WS_STB))
#define Zb ((bf16_t*)(WSP + WS_ZB))
#define Ksa ((bf16_t*)(WSP + WS_KSA))
#define Vtsa ((bf16_t*)(WSP + WS_VTSA))
#define Ksb ((bf16_t*)(WSP + WS_KSB))
#define Vtsb ((bf16_t*)(WSP + WS_VTSB))
#define Hb ((bf16_t*)(WSP + WS_BIG))
#define Qb ((bf16_t*)(WSP + WS_BIG))
#define Kpb ((bf16_t*)(WSP + WS_BIG + BIG_K))
#define Vtpb ((bf16_t*)(WSP + WS_BIG + BIG_VT))
#define rope (misc + MC_ROPE)
__global__ void __launch_bounds__(512, 2) fwd_kernel(Args args) {
    extern __shared__ __attribute__((aligned(16))) unsigned char lds_raw[];
    LAS unsigned char* lds = (LAS unsigned char*)lds_raw;
    cg::grid_group grid = cg::this_grid();
    const int tid = threadIdx.x, lane = tid & 63, wave = __builtin_amdgcn_readfirstlane(tid >> 6);
    const int G = gridDim.x, bid = blockIdx.x;
    if (tid < 4) ((LAS unsigned*)(lds + 131072))[tid] = 0u;
    __syncthreads();
    const XcdBarrier xbar = xcd_barrier_post((unsigned*)WSP, (volatile LAS unsigned*)(lds + 131072));
    const int lo = args.ph_lo, hi = args.ph_hi;
#define IN(k) (lo <= (k) && (k) < hi)
#ifndef PROBE_DUP
#define PROBE_DUP 0
#endif
#define SEAM(k) do { if (IN(k) && IN((k) + 1)) { if ((k) == 0) grid.sync(); else { xcd_barrier(xbar); if (PROBE_DUP & 1) xcd_barrier(xbar); } } } while (0)

    if (IN(0))
#pragma unroll 1
    for (int rep = 0; rep < ((PROBE_DUP & 8) ? 2 : 1); ++rep) {
        const int gw = bid * 8 + wave, NGW = G * 8;
        const long gt = (long)bid * 512 + tid, NGT = (long)G * 512;
        LAS float* scr = (LAS float*)(lds + wave * 16384);
        for (int it = gw; it < 1040; it += NGW) {
            int r = it;
            if (r < 704) { const int w = r / 176, grp = r % 176;
                const int lnidx = (w == 1) ? 1 : (w == 2) ? 2 : 4;
                const float* g = (w == 0) ? nullptr : ln_g + lnidx * DM; const float* b = (w == 0) ? nullptr : ln_b + lnidx * DM;
                prep_weight_item(w_in + (size_t)w * DM * 2 * FF, DM, 2 * FF, grp * 16, FF + grp * 16, g, b, Win + (size_t)w * 2 * FF * DM, grp * 32,
                                 misc + MC_WIN + w * 2 * 5632, misc + MC_WIN + w * 2 * 5632 + 5632, scr, lane);
                continue; }
            r -= 704;
            if (r < 128) { const int w = r / 32, grp = r % 32;
                prep_weight_item(w_dn + (size_t)w * FF * DM, FF, DM, grp * 32, grp * 32 + 16, nullptr, nullptr, Wdn + (size_t)w * DM * FF, grp * 32, nullptr, nullptr, scr, lane);
                continue; }
            r -= 128;
            if (r < 96) { prep_weight_item(w_qkva, DM, 3072, r * 32, r * 32 + 16, ln_g + 0 * DM, ln_b + 0 * DM, Wqkva, r * 32, misc + MC_QKVA, misc + MC_QKVA + 3072, scr, lane); continue; }
            r -= 96;
            if (r < 32) { prep_weight_item(w_oa, DM, DM, r * 32, r * 32 + 16, nullptr, nullptr, Woa, r * 32, nullptr, nullptr, scr, lane); continue; }
            r -= 32;
            if (r < 48) { int cb0, cb1; if (r < 40) { cb0 = (r >> 1) * 64 + 16 * (r & 1); cb1 = cb0 + 32; } else { cb0 = r * 32; cb1 = cb0 + 16; }
                prep_weight_item(w_qkvb, DM, 1536, cb0, cb1, ln_g + 3 * DM, ln_b + 3 * DM, Wqkvb, r * 32, misc + MC_QKVB, misc + MC_QKVB + 1536, scr, lane); continue; }
            r -= 48;
            prep_weight_item(w_ob, DM, DM, r * 32, r * 32 + 16, nullptr, nullptr, Wob, r * 32, nullptr, nullptr, scr, lane);
        }
        for (long i = gt; i < (long)MT * 128; i += NGT) {
            const int row = (int)(i >> 7), c8 = (int)(i & 127);
            const float* src = (row < MP ? x_p + (size_t)row * DM : x_s + (size_t)(row - MP) * DM) + c8 * 8;
            const f32x4 a = *(const f32x4*)src, b = *(const f32x4*)(src + 4);
            u32x4 o; o.x = pk2(a[0], a[1]); o.y = pk2(a[2], a[3]); o.z = pk2(b[0], b[1]); o.w = pk2(b[2], b[3]);
            *(u32x4*)(Zb + (size_t)row * DM + c8 * 8) = o;
        }
        for (long i = gt; i < 2064 * 32; i += NGT) {
            const int pos = (int)(i >> 5), fi = (int)(i & 31);
            const double a = (double)pos * ROPE_INV[fi];
            const double n = __builtin_floor(a * 0.15915494309189535);
            const float rr = (float)__builtin_fma(-n, 6.283185307179586, a);
            rope[2 * i] = cosf(rr); rope[2 * i + 1] = sinf(rr);
        }
        for (long i = gt; i < 16L * 544 * 128; i += NGT) {
            const int c8 = (int)(i & 127); const int bp = (int)(i >> 7); const int b = bp / 544, pos = bp % 544;
            u32x4 o = (u32x4){0u, 0u, 0u, 0u};
            if (pos < 512) { const float* src = cak + ((size_t)(b * 512 + pos) * DM + c8 * 8); const f32x4 a = *(const f32x4*)src, c = *(const f32x4*)(src + 4);
                o.x = pk2(a[0], a[1]); o.y = pk2(a[2], a[3]); o.z = pk2(c[0], c[1]); o.w = pk2(c[2], c[3]); }
            if (pos < 512 || pos >= 528) *(u32x4*)(Ksa + (size_t)bp * DM + c8 * 8) = o;
        }
        for (long i = gt; i < 16L * 16 * 68 * 64; i += NGT) {
            const int d = (int)(i & 63); long t = i >> 6; const int p8 = (int)(t % 68); t /= 68; const int h = (int)(t & 15), b = (int)(t >> 4);
            u32x4 o = (u32x4){0u, 0u, 0u, 0u};
            if (p8 < 64) { float v[8];
#pragma unroll
                for (int e = 0; e < 8; ++e) v[e] = cav[((size_t)(b * 512 + p8 * 8 + e) * 16 + h) * 64 + d];
                o.x = pk2(v[0], v[1]); o.y = pk2(v[2], v[3]); o.z = pk2(v[4], v[5]); o.w = pk2(v[6], v[7]); }
            if (p8 < 64 || p8 >= 66) *(u32x4*)(Vtsa + ((size_t)((b * 16 + h) * 64 + d) * 544 + p8 * 8)) = o;
        }
        for (long i = gt; i < 16L * 160 * 32; i += NGT) {
            const int c8 = (int)(i & 31); const int bp = (int)(i >> 5); const int b = bp / 160, pos = bp % 160;
            u32x4 o = (u32x4){0u, 0u, 0u, 0u};
            if (pos < 128) { const float* src = cbk + ((size_t)(b * 128 + pos) * 256 + c8 * 8); const f32x4 a = *(const f32x4*)src, c = *(const f32x4*)(src + 4);
                o.x = pk2(a[0], a[1]); o.y = pk2(a[2], a[3]); o.z = pk2(c[0], c[1]); o.w = pk2(c[2], c[3]); }
            if (pos < 128 || pos >= 144) *(u32x4*)(Ksb + (size_t)bp * 256 + c8 * 8) = o;
        }
        for (long i = gt; i < 16L * 4 * 20 * 64; i += NGT) {
            const int d = (int)(i & 63); long t = i >> 6; const int p8 = (int)(t % 20); t /= 20; const int h = (int)(t & 3), b = (int)(t >> 2);
            u32x4 o = (u32x4){0u, 0u, 0u, 0u};
            if (p8 < 16) { float v[8];
#pragma unroll
                for (int e = 0; e < 8; ++e) v[e] = cbv[((size_t)(b * 128 + p8 * 8 + e) * 4 + h) * 64 + d];
                o.x = pk2(v[0], v[1]); o.y = pk2(v[2], v[3]); o.z = pk2(v[4], v[5]); o.w = pk2(v[6], v[7]); }
            if (p8 < 16 || p8 >= 18) *(u32x4*)(Vtsb + ((size_t)((b * 4 + h) * 64 + d) * 160 + p8 * 8)) = o;
        }
    }
    SEAM(0);

#pragma unroll 1
    for (int s = 0; s < 14; ++s) {
        if (IN(s + 1)) {
            const int L = s / 7, k = s % 7;
            const int c = 3 * L + (k > 1) + (k > 4);
            if (false) {}
#ifndef NO_SW
            else if (k == 0 || k == 5)
#pragma unroll 1
            for (int rep = 0; rep < ((PROBE_DUP & 2) ? 2 : 1); ++rep) {
                const int w = 2 * L + (k == 5);
                pg8::Gemm g{Zb, Win + (size_t)w * 2 * FF * DM, MP, 2 * FF, DM}; pg8::StaticOrder S; S.init(MP, 2 * FF, G, bid);
                pg8::EpiSwiglu E{w, c};
                pg8::small_gemm<pg8::EpiSwiglu>(lds, g.A, g.Bt, g.N, g.K, E);
                pg8::gemm_phase<pg8::EpiSwiglu, pg8::StaticOrder, true, true>(lds, g, S, E);
            }
#endif
#ifndef NO_RES
            else if (k == 1 || k == 6 || k == 4) {
                const bool wo = (k == 4);
                const bf16_t* Bt = wo ? (L == 0 ? Woa : Wob) : Wdn + (size_t)(2 * L + (k == 6)) * DM * FF;
                pg8::Gemm g{wo ? Qb : Hb, Bt, MP, DM, wo ? DM : FF}; pg8::StaticOrder S; S.init(MP, DM, G, bid);
                pg8::EpiResid E{c, wo ? 1.0f : 0.5f};
                pg8::small_gemm<pg8::EpiResid>(lds, g.A, g.Bt, g.N, g.K, E);
                pg8::gemm_phase<pg8::EpiResid, pg8::StaticOrder, true, true>(lds, g, S, E);
            }
#endif
#ifndef NO_QKV
            else if (k == 2)
#pragma unroll 1
            for (int rep = 0; rep < ((PROBE_DUP & 8) ? 2 : 1); ++rep) {
                if (L == 0) {
                    pg8::Gemm g{Zb, Wqkva, MP, 3072, DM}; pg8::StaticOrder S; S.init(MP, 3072, G, bid);
                    pg8::EpiQkvA E{c};
                    pg8::small_gemm<pg8::EpiQkvA>(lds, g.A, g.Bt, g.N, g.K, E);
                    pg8::gemm_phase<pg8::EpiQkvA, pg8::StaticOrder, true, true>(lds, g, S, E);
                } else {
                    pg8::Gemm g{Zb, Wqkvb, MP, 1536, DM}; pg8::StaticOrder S; S.init(MP, 1536, G, bid);
                    pg8::EpiQkvB E{c};
                    pg8::small_gemm<pg8::EpiQkvB>(lds, g.A, g.Bt, g.N, g.K, E);
                    pg8::gemm_phase<pg8::EpiQkvB, pg8::StaticOrder, true, true>(lds, g, S, E);
                }
            }
#endif
#ifndef NO_ATT
            else
#pragma unroll 1
            for (int rep = 0; rep < ((PROBE_DUP & 4) ? 2 : 1); ++rep) {
                bf16_t* Ob = ((PROBE_DUP & 4) && rep == 0) ? (bf16_t*)(WSP + 400 * MiB) : Qb;
                int lane_o = threadIdx.x & 63; asm volatile("" : "+v"(lane_o)); const int lane = lane_o;
                for (int bu = bid; bu < 2048 + 32; bu += G) {
                    if (L == 0) {
                        if (bu < 2048) { const int b = bu >> 7, h = (bu >> 3) & 15, chunk = (bu & 7) * 4 + (wave >> 1), half = wave & 1;
                            const size_t row0 = (size_t)b * 2048 + chunk * 64 + half * 32;
                            attn_wave<true>(Qb + row0 * DM + h * 64, DM, 32, Kpb + (size_t)b * 2048 * DM + h * 64, DM, Vtpb + (size_t)((b * 16 + h) * 64) * 2048, 2048,
                                            (chunk > 8 ? chunk - 8 : 0) * 2, (chunk + 1) * 2, 1 << 30, chunk * 64 + half * 32, relb + h * 257, 0.f, Ob + row0 * DM + h * 64, DM, lane);
                        } else { const int wu = (bu - 2048) * 8 + wave, b = wu >> 4, h = wu & 15; const size_t row0 = (size_t)MP + b * 16;
                            attn_wave<true>(Qb + row0 * DM + h * 64, DM, 16, Ksa + (size_t)b * 544 * DM + h * 64, DM, Vtsa + (size_t)((b * 16 + h) * 64) * 544, 544,
                                            0, 17, 528, 512, relb + h * 257, 0.f, Ob + row0 * DM + h * 64, DM, lane);
                        }
                    } else {
                        if (bu < 2048) { const int b = bu >> 7, kvh = (bu >> 5) & 3, chunk = bu & 31, qh = kvh * 4 + (wave >> 1), half = wave & 1;
                            const size_t row0 = (size_t)b * 2048 + chunk * 64 + half * 32;
                            attn_wave<false>(Qb + row0 * DM + qh * 64, DM, 32, Kpb + (size_t)b * 2048 * 256 + kvh * 64, 256, Vtpb + (size_t)((b * 4 + kvh) * 64) * 2048, 2048,
                                             (chunk > 2 ? chunk - 2 : 0) * 2, (chunk + 1) * 2, 1 << 30, 0, nullptr, sinks[qh], Ob + row0 * DM + qh * 64, DM, lane);
                        } else { const int wu = (bu - 2048) * 8 + wave, b = wu >> 4, qh = wu & 15, kvh = qh >> 2; const size_t row0 = (size_t)MP + b * 16;
                            attn_wave<false>(Qb + row0 * DM + qh * 64, DM, 16, Ksb + (size_t)b * 160 * 256 + kvh * 64, 256, Vtsb + (size_t)((b * 4 + kvh) * 64) * 160, 160,
                                             0, 5, 144, 0, nullptr, sinks[qh], Ob + row0 * DM + qh * 64, DM, lane);
                        }
                    }
                }
            }
#endif
        }
        SEAM(s + 1);
    }
    if (IN(15)) {
        const int gw = bid * 8 + wave, NGW = G * 8;
        const float* g = ln_g + 5 * DM; const float* b = ln_b + 5 * DM;
        f32x4 gv[4], bv[4];
#pragma unroll
        for (int j = 0; j < 4; ++j) { gv[j] = *(const f32x4*)(g + 4 * lane + 256 * j); bv[j] = *(const f32x4*)(b + 4 * lane + 256 * j); }
        for (int row = gw; row < MT; row += NGW) {
            float* zr = out + (size_t)row * DM + 4 * lane;
            f32x4 v[4]; float s = 0.f;
#pragma unroll
            for (int j = 0; j < 4; ++j) { v[j] = *(const f32x4*)(zr + 256 * j); s += (v[j][0] + v[j][1]) + (v[j][2] + v[j][3]); }
            const float mean = wave_sum(s) * (1.0f / DM); float s2 = 0.f;
#pragma unroll
            for (int j = 0; j < 4; ++j) { v[j] = v[j] - mean; s2 += (v[j][0] * v[j][0] + v[j][1] * v[j][1]) + (v[j][2] * v[j][2] + v[j][3] * v[j][3]); }
            const float rstd = 1.0f / sqrtf(wave_sum(s2) * (1.0f / DM) + 1e-5f);
#pragma unroll
            for (int j = 0; j < 4; ++j) *(f32x4*)(zr + 256 * j) = v[j] * rstd * gv[j] + bv[j];
        }
    }
#undef IN
#undef SEAM
}

#undef AIN
#undef x_p
#undef x_s
#undef cak
#undef cav
#undef cbk
#undef cbv
#undef ln_g
#undef ln_b
#undef w_in
#undef w_dn
#undef w_qkva
#undef w_oa
#undef relb
#undef w_qkvb
#undef w_ob
#undef sinks
#undef out
#undef WSP
#undef Win
#undef Wdn
#undef Wqkva
#undef Woa
#undef Wqkvb
#undef Wob
#undef misc
#undef stA
#undef stB
#undef Zb
#undef Ksa
#undef Vtsa
#undef Ksb
#undef Vtsb
#undef Hb
#undef Qb
#undef Kpb
#undef Vtpb
#undef rope
#ifndef N_LAUNCH_MODE
#define N_LAUNCH_MODE 1
#endif
extern "C" void kernel_launch(void* const* d_in, const int* in_sizes, int n_in, void* d_out, int out_size, void* d_ws, size_t ws_size, hipStream_t stream) {
    static int grid = 0;
    if (grid == 0) {
        if (n_in != 16 || ws_size < WS_END || (size_t)out_size != OUT_END) { fprintf(stderr, "kernel_launch: unexpected problem (n_in %d, out %d, ws %zu)\n", n_in, out_size, ws_size); grid = -1; return; }
        int dev = 0, cus = 0, per_cu = 0;
        (void)hipGetDevice(&dev); (void)hipDeviceGetAttribute(&cus, hipDeviceAttributeMultiprocessorCount, dev);
        if (hipFuncSetAttribute((const void*)fwd_kernel, hipFuncAttributeMaxDynamicSharedMemorySize, LDS_BYTES) != hipSuccess) { fprintf(stderr, "kernel_launch: hipFuncSetAttribute failed\n"); grid = -1; return; }
        if (hipOccupancyMaxActiveBlocksPerMultiprocessor(&per_cu, (const void*)fwd_kernel, 512, LDS_BYTES) != hipSuccess || per_cu < 1) { fprintf(stderr, "kernel_launch: occupancy query gave %d\n", per_cu); per_cu = 1; }
        (void)hipGetLastError();
        grid = cus * per_cu;
        fprintf(stderr, "kernel_launch: grid %d (cus %d x %d)\n", grid, cus, per_cu);
    }
    if (grid < 0) return;
    if (hipMemsetAsync(d_ws, 0, 16384, stream) != hipSuccess) { fprintf(stderr, "kernel_launch: memset failed\n"); return; }
    Args a{};
    for (int i = 0; i < 16; ++i) a.in[i] = (const float*)d_in[i];
    a.out = (float*)d_out; a.ws = (unsigned char*)d_ws;
    if (N_LAUNCH_MODE == 1) {
        a.ph_lo = 0; a.ph_hi = N_PHASES;
        void* kargs[] = {&a};
        hipError_t e = hipLaunchCooperativeKernel((const void*)fwd_kernel, dim3(grid), dim3(512), kargs, LDS_BYTES, stream);
        if (e != hipSuccess) fprintf(stderr, "cooperative launch failed: %s (grid %d)\n", hipGetErrorString(e), grid);
    } else {
        for (int p = 0; p < N_PHASES; ++p) { a.ph_lo = p; a.ph_hi = p + 1; hipLaunchKernelGGL(fwd_kernel, dim3(grid), dim3(512), LDS_BYTES, stream, a); }
    }
}
```

```cpp
#include <hip/hip_runtime.h>
#include <hip/hip_cooperative_groups.h>
#include <cstdio>
#include <cstdint>
namespace cg = cooperative_groups;
namespace pg8 {
#define PG8_LAS __attribute__((address_space(3)))
typedef unsigned short bf16_t;
typedef short bf16x8 __attribute__((ext_vector_type(8)));
typedef float f32x4 __attribute__((ext_vector_type(4)));
typedef unsigned u32x4 __attribute__((ext_vector_type(4)));
constexpr int BM = 256, BK = 64, HALF = 128, HTB = HALF * BK * 2  , STAGE_BYTES = 8 * HTB, NXCD = 8, WGM = 8;

__host__ __device__ __forceinline__ int lds_byte(int r, int c) { const int st = (r >> 4) * 2 + (c >> 5), rr = r & 15, cc = c & 31, ob = rr * 64 + cc * 2; return st * 1024 + (ob ^ (((ob >> 9) & 1) << 5)); }
__host__ __device__ __forceinline__ void stage_rc(int b, int& R, int& C) { const int st = b / 1024, sb = b % 1024, swz = sb ^ (((sb >> 9) & 1) << 5); R = (st >> 1) * 16 + swz / 64; C = (st & 1) * 32 + (swz % 64) / 2; }
__host__ __device__ __forceinline__ int perm32(int rho) { const int n = rho >> 4, i = rho & 15; return 8 * (i >> 2) + 4 * n + (i & 3); }

struct Unit { int pm, pn; };
struct Gemm { const bf16_t* A; const bf16_t* Bt; int M, N, K; };

struct StaticOrder {
    int nM, nN, nwg, G, c;
    __host__ __device__ void init(int M, int N, int G_, int c_) { nM = M / BM; nN = N / BM; nwg = nM * nN; G = G_; c = c_; }
    __host__ __device__ bool next(int i, Unit& u) const {
        const long L = (long)i * G + c; if (L >= nwg) return false;
        int wgid = (int)L; { const int q = nwg / NXCD, r = nwg % NXCD, xcd = wgid % NXCD, off = wgid / NXCD; wgid = (xcd < r ? xcd * (q + 1) : r * (q + 1) + (xcd - r) * q) + off; }
        const int nig = WGM * nN, gid = wgid / nig, fm = gid * WGM, gsz = (nM - fm) < WGM ? (nM - fm) : WGM;
        u.pm = fm + ((wgid % nig) % gsz); u.pn = (wgid % nig) / gsz; return true;
    }
    __device__ __forceinline__ void a_ready(const Unit&) const {}
    __device__ __forceinline__ void done(const Unit&) const {}
};

__device__ __forceinline__ unsigned cvt_pk_bf16(float lo, float hi) { unsigned r; asm volatile("v_cvt_pk_bf16_f32 %0, %1, %2" : "=v"(r) : "v"(lo), "v"(hi)); return r; }
template <class Epi, class Sched, bool ALIGN_EPI = false, bool SP2 = false>
__device__ __forceinline__ void gemm_phase(PG8_LAS unsigned char* lds, const Gemm g, const Sched& S, const Epi& E) {
    int tid_o = threadIdx.x; asm volatile("" : "+v"(tid_o));
    const int tid = tid_o, wid = __builtin_amdgcn_readfirstlane(tid >> 6), lane = tid & 63, wr = wid >> 2, wc = wid & 3, fr = lane & 15, fq = lane >> 4;
    const int K = g.K, nt = K / BK;
    unsigned voffA[2], voffB[2];
#pragma unroll
    for (int i = 0; i < 2; ++i) { int R, C; stage_rc(tid * 16 + i * 8192, R, C); const int Rb = Epi::PERM ? ((R & ~31) + perm32(R & 31)) : R;
        voffA[i] = (unsigned)(R * K + C) * 2u; voffB[i] = (unsigned)(Rb * K + C) * 2u; }
    const size_t kstep = (size_t)(BK * 2);
    const size_t hstep = (size_t)HALF * K * 2;
    const size_t tstep = 2 * hstep;
    const unsigned ldsw = (unsigned)wid * 1024u;
    const int aoff = lds_byte(wr * 64 + fr, fq * 8), boff = lds_byte(wc * 32 + fr, fq * 8);
#define PG8_SA(b, h) (((b) * 2 + (h)) * HTB)
#define PG8_SB(b, h) ((4 + (b) * 2 + (h)) * HTB)
#define PG8_STAGE(bufoff, gbase, voff) do { _Pragma("unroll") for (int _i = 0; _i < 2; ++_i) \
        __builtin_amdgcn_global_load_lds((const unsigned*)((const char*)(gbase) + (voff)[_i]), (PG8_LAS unsigned*)(lds + (bufoff) + ldsw + _i * 8192), 16, 0, 0); } while (0)
#define PG8_LDA(dst, b, h) do { _Pragma("unroll") for (int m = 0; m < 4; ++m) _Pragma("unroll") for (int k = 0; k < 2; ++k) dst[m][k] = *(const PG8_LAS bf16x8*)(lds + PG8_SA(b, h) + aoff + m * 2048 + k * 1024); } while (0)
#define PG8_LDB(dst, b, h) do { _Pragma("unroll") for (int n = 0; n < 2; ++n) _Pragma("unroll") for (int k = 0; k < 2; ++k) dst[n][k] = *(const PG8_LAS bf16x8*)(lds + PG8_SB(b, h) + boff + n * 2048 + k * 1024); } while (0)
#define PG8_MMA(ai, bj, At, Bt) do { __builtin_amdgcn_s_setprio(1); _Pragma("unroll") for (int m = 0; m < 4; ++m) _Pragma("unroll") for (int n = 0; n < 2; ++n) _Pragma("unroll") for (int k = 0; k < 2; ++k) \
        acc[ai][bj][m][n] = __builtin_amdgcn_mfma_f32_16x16x32_bf16(Bt[n][k], At[m][k], acc[ai][bj][m][n], 0, 0, 0); __builtin_amdgcn_s_setprio(0); } while (0)
#define PG8_WAIT_V(n) asm volatile("s_waitcnt vmcnt(" #n ")" ::: "memory")
#define PG8_WAIT_L(n) asm volatile("s_waitcnt lgkmcnt(" #n ")" ::: "memory")
#define PG8_BAR __builtin_amdgcn_s_barrier()
#define PG8_SCHED __builtin_amdgcn_sched_barrier(0)
    Unit cur, nxt; int ui = 0;
    if (!S.next(0, cur)) return;
    f32x4 acc[2][2][4][2];
#pragma unroll
    for (int a = 0; a < 2; ++a)
#pragma unroll
        for (int b = 0; b < 2; ++b)
#pragma unroll
            for (int m = 0; m < 4; ++m)
#pragma unroll
                for (int n = 0; n < 2; ++n) acc[a][b][m][n] = (f32x4){0.f, 0.f, 0.f, 0.f};
    bf16x8 At[4][2], B0[2][2], B1[2][2];
    const char* cA = (const char*)g.A + (size_t)cur.pm * tstep; const char* cB = (const char*)g.Bt + (size_t)cur.pn * tstep;
    S.a_ready(cur);
    if constexpr (SP2) {
        PG8_STAGE(PG8_SB(0, 0), cB, voffB); PG8_STAGE(PG8_SB(0, 1), cB + hstep, voffB); PG8_STAGE(PG8_SA(0, 0), cA, voffA); PG8_STAGE(PG8_SA(0, 1), cA + hstep, voffA);
        if (wr == 1) PG8_BAR;
        PG8_WAIT_V(2); PG8_BAR;
        PG8_STAGE(PG8_SB(1, 0), cB + kstep, voffB); PG8_STAGE(PG8_SA(1, 0), cA + kstep, voffA); PG8_STAGE(PG8_SB(1, 1), cB + hstep + kstep, voffB);
        PG8_WAIT_V(6); PG8_BAR;
    } else {
        PG8_STAGE(PG8_SB(0, 0), cB, voffB); PG8_STAGE(PG8_SA(0, 0), cA, voffA); PG8_STAGE(PG8_SB(0, 1), cB + hstep, voffB); PG8_STAGE(PG8_SA(0, 1), cA + hstep, voffA);
        if (wr == 1) PG8_BAR;
        PG8_WAIT_V(4); PG8_BAR;
        PG8_STAGE(PG8_SB(1, 0), cB + kstep, voffB); PG8_STAGE(PG8_SA(1, 0), cA + kstep, voffA); PG8_STAGE(PG8_SB(1, 1), cB + hstep + kstep, voffB);
        PG8_WAIT_V(6); PG8_BAR;
    }
    for (;;) {
        const bool has_next = S.next(ui + 1, nxt);
        const char* nA = has_next ? (const char*)g.A + (size_t)nxt.pm * tstep : cA; const char* nB = has_next ? (const char*)g.Bt + (size_t)nxt.pn * tstep : cB;
        for (int t = 0; t < nt; t += 2) {
            const bool last = (t == nt - 2);
            const char* a1 = cA + (size_t)(t + 1) * kstep;
            const char* a2 = last ? nA : cA + (size_t)(t + 2) * kstep; const char* b2 = last ? nB : cB + (size_t)(t + 2) * kstep;
            const char* a3 = a2 + kstep; const char* b3 = b2 + kstep;
            if (last && has_next) S.a_ready(nxt);
            if constexpr (SP2) {
            PG8_LDB(B0, 0, 0); PG8_LDB(B1, 0, 1); PG8_SCHED; PG8_LDA(At, 0, 0); PG8_STAGE(PG8_SA(1, 1), a1 + hstep, voffA);
            PG8_WAIT_V(8); PG8_WAIT_L(0); PG8_BAR; PG8_MMA(0, 0, At, B0); PG8_MMA(0, 1, At, B1); PG8_BAR; PG8_SCHED;
            PG8_LDA(At, 0, 1); PG8_STAGE(PG8_SB(0, 0), b2, voffB); PG8_STAGE(PG8_SB(0, 1), b2 + hstep, voffB); PG8_STAGE(PG8_SA(0, 0), a2, voffA);
            PG8_WAIT_V(8); PG8_WAIT_L(0); PG8_BAR; PG8_MMA(1, 0, At, B0); PG8_MMA(1, 1, At, B1); PG8_BAR; PG8_SCHED;
            PG8_LDB(B0, 1, 0); PG8_LDB(B1, 1, 1); PG8_SCHED; PG8_LDA(At, 1, 0); PG8_STAGE(PG8_SA(0, 1), a2 + hstep, voffA);
            PG8_WAIT_V(8); PG8_WAIT_L(0); PG8_BAR; PG8_MMA(0, 0, At, B0); PG8_MMA(0, 1, At, B1); PG8_BAR; PG8_SCHED;
            PG8_LDA(At, 1, 1); PG8_STAGE(PG8_SB(1, 0), b3, voffB); PG8_STAGE(PG8_SB(1, 1), b3 + hstep, voffB); PG8_STAGE(PG8_SA(1, 0), a3, voffA);
            PG8_WAIT_V(8); PG8_WAIT_L(0); PG8_BAR; PG8_MMA(1, 0, At, B0); PG8_MMA(1, 1, At, B1); PG8_BAR; PG8_SCHED;
            } else {
            PG8_LDB(B0, 0, 0); PG8_SCHED; PG8_LDA(At, 0, 0); PG8_STAGE(PG8_SA(1, 1), a1 + hstep, voffA);
            PG8_WAIT_L(8); PG8_BAR; PG8_WAIT_L(0); PG8_MMA(0, 0, At, B0); PG8_BAR; PG8_SCHED;
            PG8_LDB(B1, 0, 1); PG8_STAGE(PG8_SB(0, 0), b2, voffB);
            PG8_BAR; PG8_WAIT_L(0); PG8_MMA(0, 1, At, B1); PG8_BAR;
            PG8_LDA(At, 0, 1); PG8_STAGE(PG8_SA(0, 0), a2, voffA);
            PG8_BAR; PG8_WAIT_L(0); PG8_MMA(1, 0, At, B0); PG8_BAR; PG8_SCHED;
            PG8_STAGE(PG8_SB(0, 1), b2 + hstep, voffB);
            PG8_WAIT_V(6); PG8_BAR; PG8_MMA(1, 1, At, B1); PG8_BAR;
            PG8_LDB(B0, 1, 0); PG8_SCHED; PG8_LDA(At, 1, 0); PG8_STAGE(PG8_SA(0, 1), a2 + hstep, voffA);
            PG8_WAIT_L(8); PG8_BAR; PG8_WAIT_L(0); PG8_MMA(0, 0, At, B0); PG8_BAR; PG8_SCHED;
            PG8_LDB(B1, 1, 1); PG8_STAGE(PG8_SB(1, 0), b3, voffB);
            PG8_BAR; PG8_WAIT_L(0); PG8_MMA(0, 1, At, B1); PG8_BAR;
            PG8_LDA(At, 1, 1); PG8_STAGE(PG8_SA(1, 0), a3, voffA);
            PG8_BAR; PG8_WAIT_L(0); PG8_MMA(1, 0, At, B0); PG8_BAR; PG8_SCHED;
            PG8_STAGE(PG8_SB(1, 1), b3 + hstep, voffB);
            PG8_WAIT_V(6); PG8_BAR; PG8_MMA(1, 1, At, B1); PG8_BAR;
            }
        }
        if constexpr (ALIGN_EPI) { if (wr == 0) PG8_BAR; }
        if constexpr (!Epi::AFTER_DRAIN) { E(acc, cur, wr, wc, fr, fq); S.done(cur); }
        if (!has_next) break;
#pragma unroll
        for (int a = 0; a < 2; ++a)
#pragma unroll
            for (int b = 0; b < 2; ++b)
#pragma unroll
                for (int m = 0; m < 4; ++m)
#pragma unroll
                    for (int n = 0; n < 2; ++n) acc[a][b][m][n] = (f32x4){0.f, 0.f, 0.f, 0.f};
        cur = nxt; cA = nA; cB = nB; ++ui;
        if constexpr (ALIGN_EPI) { if (wr == 1) PG8_BAR; }
    }
    PG8_WAIT_V(0);
    if constexpr (!ALIGN_EPI) { if (wr == 0) PG8_BAR; }
    PG8_BAR;
    if constexpr (Epi::AFTER_DRAIN) { E.fused(acc, cur, wr, wc, fr, fq, lds, wid, lane); S.done(cur); }
#undef PG8_SA
#undef PG8_SB
#undef PG8_STAGE
#undef PG8_LDA
#undef PG8_LDB
#undef PG8_MMA
#undef PG8_WAIT_V
#undef PG8_WAIT_L
#undef PG8_BAR
#undef PG8_SCHED
}
}
constexpr int DM = 1024, FF = 2816, MP = 32768, MS = 256, MT = MP + MS, SEQ = 2048;
constexpr float ALPHA = 1.4142135623730951f;
constexpr float LOG2E = 1.4426950408889634f;
typedef pg8::bf16_t bf16_t;
typedef pg8::bf16x8 bf16x8;
typedef pg8::f32x4 f32x4;
typedef pg8::u32x4 u32x4;
typedef float f32x2v __attribute__((ext_vector_type(2)));
typedef float f32x16 __attribute__((ext_vector_type(16)));
typedef unsigned u32x2 __attribute__((ext_vector_type(2)));
#define LAS __attribute__((address_space(3)))

constexpr size_t MiB = 1u << 20;
constexpr size_t WS_WIN = 1 * MiB;
constexpr size_t WS_WDN = 45 * MiB;
constexpr size_t WS_WQKVA = 67 * MiB;
constexpr size_t WS_WOA = 73 * MiB;
constexpr size_t WS_WQKVB = 75 * MiB;
constexpr size_t WS_WOB = 78 * MiB;
constexpr size_t WS_MISC = 80 * MiB;
constexpr size_t WS_STA = 82 * MiB;
constexpr size_t WS_STB = 87 * MiB;
constexpr size_t WS_ZB = 92 * MiB;
constexpr size_t WS_KSA = 157 * MiB;
constexpr size_t WS_VTSA = 174 * MiB;
constexpr size_t WS_KSB = 191 * MiB;
constexpr size_t WS_VTSB = 193 * MiB;
constexpr size_t WS_BIG = 195 * MiB;
constexpr size_t BIG_K = (size_t)MT * DM * 2, BIG_VT = BIG_K + (size_t)MP * DM * 2;
constexpr size_t WS_END = 388 * MiB;
constexpr int MC_WIN = 0;
constexpr int MC_QKVA = 4 * 2 * 5632;
constexpr int MC_QKVB = MC_QKVA + 2 * 3072;
constexpr int MC_ROPE = MC_QKVB + 2 * 1536;
constexpr int LDS_BYTES = 131072 + 64;
struct Args { const float* in[16]; float* out; unsigned char* ws; int ph_lo, ph_hi; };
typedef const __attribute__((address_space(4))) Args* ArgsP;
__device__ __forceinline__ ArgsP get_args() { ArgsP p = (ArgsP)__builtin_amdgcn_kernarg_segment_ptr(); asm volatile("" : "+s"(p)); return p; }
constexpr size_t OUT_YP = 0, OUT_YS = (size_t)MP * DM, OUT_AKP = OUT_YS + (size_t)MS * DM, OUT_AVP = OUT_AKP + (size_t)16 * 512 * 1024, OUT_BKP = OUT_AVP + (size_t)16 * 512 * 1024,
                 OUT_BVP = OUT_BKP + (size_t)16 * 128 * 256, OUT_AKS = OUT_BVP + (size_t)16 * 128 * 256, OUT_AVS = OUT_AKS + (size_t)16 * 16 * 1024, OUT_BKS = OUT_AVS + (size_t)16 * 16 * 1024,
                 OUT_BVS = OUT_BKS + (size_t)16 * 16 * 256, OUT_END = OUT_BVS + (size_t)16 * 16 * 256;


__device__ __forceinline__ unsigned f2bf(float f) { unsigned u = __builtin_bit_cast(unsigned, f); return (u + 0x7fffu + ((u >> 16) & 1u)) >> 16; }
__device__ __forceinline__ unsigned pk2(float lo, float hi) { return f2bf(lo) | (f2bf(hi) << 16); }
__device__ __forceinline__ float bfround(float f) { return __builtin_bit_cast(float, f2bf(f) << 16); }
__device__ __forceinline__ u32x2 pk4(f32x4 v) { u32x2 r; r.x = pg8::cvt_pk_bf16(v[0], v[1]); r.y = pg8::cvt_pk_bf16(v[2], v[3]); return r; }
__device__ __forceinline__ float wave_sum(float v) {
#pragma unroll
    for (int o = 1; o < 64; o <<= 1) v += __shfl_xor(v, o);
    return v;
}

namespace pg8 {
__device__ __forceinline__ void row_mean_rstd(const float* st, int row, int fq, float& mean, float& rstd) {
    const f32x4* p = (const f32x4*)(st + (unsigned)row * 32 + 8 * fq);
    const f32x4 a = p[0], b = p[1];
    float s = (a[0] + a[2]) + (b[0] + b[2]), q = (a[1] + a[3]) + (b[1] + b[3]);
    s += __shfl_xor(s, 16); s += __shfl_xor(s, 32); q += __shfl_xor(q, 16); q += __shfl_xor(q, 32);
    mean = s * (1.0f / 1024.0f);
    const float var = fmaxf(q * (1.0f / 1024.0f) - mean * mean, 0.f);
    rstd = 1.0f / sqrtf(var + 1e-5f);
}

#define PG8_EPI_WALK() \
    __device__ __forceinline__ void operator()(const f32x4 (&acc)[2][2][4][2], const Unit& u, int wr, int wc, int fr, int fq) const { \
        const Ctx cx = ctx(); \
        _Pragma("unroll") for (int ai = 0; ai < 2; ++ai) _Pragma("unroll") for (int m = 0; m < 4; ++m) { \
            const int row = u.pm * 256 + ai * 128 + wr * 64 + m * 16 + fr; \
            const f32x4 v[2][2] = {{acc[ai][0][m][0], acc[ai][0][m][1]}, {acc[ai][1][m][0], acc[ai][1][m][1]}}; \
            row_op(cx, u.pm, u.pn, wc, row, fq, v); } }

struct EpiSwiglu {
    static constexpr bool PERM = false, AFTER_DRAIN = false;
    int w, cnt;
    struct Ctx { bf16_t* H; const float* st; const float* c1; const float* c2; };
    __device__ __forceinline__ Ctx ctx() const {
        unsigned char* wsp = get_args()->ws; Ctx c;
        c.H = (bf16_t*)(wsp + WS_BIG); c.st = cnt == 0 ? nullptr : (const float*)(wsp + ((cnt & 1) ? WS_STA : WS_STB));
        c.c1 = (const float*)(wsp + WS_MISC) + MC_WIN + w * 2 * 5632; c.c2 = c.c1 + 5632; return c; }
    __device__ __forceinline__ void row_op(const Ctx& cx, int pm, int pn, int wc, int row, int fq, const f32x4 (&v)[2][2]) const {
        const int sb0 = pn * 256 + wc * 32 + 4 * fq, ff0 = pn * 128 + wc * 16 + 4 * fq;
        const bool fold = (cx.st != nullptr);
        float mean = 0.f, rstd = 1.f;
        if (fold) row_mean_rstd(cx.st, row, fq, mean, rstd);
#pragma unroll
        for (int bj = 0; bj < 2; ++bj) {
            f32x4 g = v[bj][0], up = v[bj][1];
            if (fold) {
                const f32x4 c1g = *(const f32x4*)(cx.c1 + sb0 + bj * 128), c1u = *(const f32x4*)(cx.c1 + sb0 + bj * 128 + 16);
                const f32x4 c2g = *(const f32x4*)(cx.c2 + sb0 + bj * 128), c2u = *(const f32x4*)(cx.c2 + sb0 + bj * 128 + 16);
                g = (g - mean * c1g) * rstd + c2g; up = (up - mean * c1u) * rstd + c2u;
            }
            f32x4 hv;
#pragma unroll
            for (int j = 0; j < 4; ++j) hv[j] = g[j] * __builtin_amdgcn_rcpf(1.0f + __expf(-g[j])) * up[j];
            *(u32x2*)(cx.H + (unsigned)row * FF + ff0 + bj * 64) = pk4(hv);
        }
    }
    PG8_EPI_WALK()
};

struct EpiResid {
    static constexpr bool PERM = false, AFTER_DRAIN = false;
    int cnt; float cs;
    struct Ctx { float* Z; const float* xp; const float* xs; const float* stp; const float* g; const float* b; float* stn; bf16_t* Zb; };
    __device__ __forceinline__ Ctx ctx() const {
        unsigned char* wsp = get_args()->ws; Ctx c;
        c.Z = get_args()->out; c.xp = get_args()->in[0]; c.xs = get_args()->in[1];
        c.stp = cnt == 0 ? nullptr : (const float*)(wsp + ((cnt & 1) ? WS_STA : WS_STB)); c.stn = (float*)(wsp + ((cnt & 1) ? WS_STB : WS_STA));
        const int lni = cnt > 0 ? cnt - 1 : 0;
        c.g = get_args()->in[6] + lni * DM; c.b = get_args()->in[7] + lni * DM; c.Zb = (bf16_t*)(wsp + WS_ZB); return c; }
    __device__ __forceinline__ void row_op(const Ctx& cx, int pm, int pn, int wc, int row, int fq, const f32x4 (&v)[2][2]) const {
        const int col0 = pn * 256 + wc * 32 + 4 * fq;
        const bool first = (cx.stp == nullptr);
        float mean = 0.f, rstd = 1.f;
        if (!first) row_mean_rstd(cx.stp, row, fq, mean, rstd);
        const float* src = first ? (pm < 128 ? cx.xp + (unsigned)row * DM : cx.xs + (unsigned)(row - MP) * DM) : cx.Z + (unsigned)row * DM;
        float s = 0.f, q = 0.f;
#pragma unroll
        for (int bj = 0; bj < 2; ++bj)
#pragma unroll
            for (int n = 0; n < 2; ++n) {
                const int col = col0 + bj * 128 + n * 16;
                f32x4 x = *(const f32x4*)(src + col);
                if (!first) { const f32x4 gv = *(const f32x4*)(cx.g + col), bv = *(const f32x4*)(cx.b + col); x = (x - mean) * rstd * gv + bv; }
                const f32x4 zn = ALPHA * x + cs * v[bj][n];
                *(f32x4*)(cx.Z + (unsigned)row * DM + col) = zn;
                *(u32x2*)(cx.Zb + (unsigned)row * DM + col) = pk4(zn);
                s += (zn[0] + zn[1]) + (zn[2] + zn[3]);
                q += (zn[0] * zn[0] + zn[1] * zn[1]) + (zn[2] * zn[2] + zn[3] * zn[3]);
            }
        s += __shfl_xor(s, 16); s += __shfl_xor(s, 32); q += __shfl_xor(q, 16); q += __shfl_xor(q, 32);
        if (fq == 0) *(f32x2v*)(cx.stn + (unsigned)row * 32 + (pn * 4 + wc) * 2) = (f32x2v){s, q};
    }
    PG8_EPI_WALK()
};

struct EpiQkvA {
    static constexpr bool PERM = false, AFTER_DRAIN = false;
    int cnt;
    struct Ctx { const float* st; const float* c1; const float* c2; bf16_t* Q; bf16_t* Kp; bf16_t* Vtp; bf16_t* Ks; bf16_t* Vts; float* outp; };
    __device__ __forceinline__ Ctx ctx() const {
        unsigned char* wsp = get_args()->ws; Ctx c; c.outp = get_args()->out;
        c.st = (const float*)(wsp + ((cnt & 1) ? WS_STA : WS_STB)); c.c1 = (const float*)(wsp + WS_MISC) + MC_QKVA; c.c2 = c.c1 + 3072;
        c.Q = (bf16_t*)(wsp + WS_BIG); c.Kp = (bf16_t*)(wsp + WS_BIG + BIG_K); c.Vtp = (bf16_t*)(wsp + WS_BIG + BIG_VT); c.Ks = (bf16_t*)(wsp + WS_KSA); c.Vts = (bf16_t*)(wsp + WS_VTSA); return c; }
    __device__ __forceinline__ void row_op(const Ctx& cx, int pm, int pn, int wc, int row, int fq, const f32x4 (&va)[2][2]) const {
        const int typ = pn >> 2, hc0 = (pn & 3) * 256 + wc * 32 + 4 * fq, ns0 = pn * 256 + wc * 32 + 4 * fq;
        const bool sample = (pm == 128);
        float* okp = cx.outp + OUT_AKP; float* ovp = cx.outp + OUT_AVP; float* oks = cx.outp + OUT_AKS; float* ovs = cx.outp + OUT_AVS;
        float mean, rstd; row_mean_rstd(cx.st, row, fq, mean, rstd);
        int b, pos; if (!sample) { b = row >> 11; pos = row & 2047; } else { const int r = row - MP; b = r >> 4; pos = r & 15; }
#pragma unroll
        for (int bj = 0; bj < 2; ++bj)
#pragma unroll
            for (int n = 0; n < 2; ++n) {
                const int hc = hc0 + bj * 128 + n * 16;
                const f32x4 v = (va[bj][n] - mean * *(const f32x4*)(cx.c1 + ns0 + bj * 128 + n * 16)) * rstd + *(const f32x4*)(cx.c2 + ns0 + bj * 128 + n * 16);
                if (typ == 0) { *(u32x2*)(cx.Q + (unsigned)row * DM + hc) = pk4(v); }
                else if (typ == 1) {
                    if (!sample) { *(u32x2*)(cx.Kp + (unsigned)row * DM + hc) = pk4(v); if (pos >= 1536) *(f32x4*)(okp + ((unsigned)(b * 512 + pos - 1536) * DM + hc)) = v; }
                    else { *(u32x2*)(cx.Ks + ((unsigned)(b * 544 + 512 + pos) * DM + hc)) = pk4(v); *(f32x4*)(oks + ((unsigned)(b * 16 + pos) * DM + hc)) = v; }
                } else {
                    const int h = hc >> 6, d = hc & 63;
                    if (!sample) {
                        bf16_t* vt = cx.Vtp + ((unsigned)((b * 16 + h) * 64 + d) * 2048 + pos);
#pragma unroll
                        for (int j = 0; j < 4; ++j) vt[(unsigned)j * 2048] = (bf16_t)f2bf(v[j]);
                        if (pos >= 1536) *(f32x4*)(ovp + ((unsigned)(b * 512 + pos - 1536) * DM + hc)) = v;
                    } else {
                        bf16_t* vt = cx.Vts + ((unsigned)((b * 16 + h) * 64 + d) * 544 + 512 + pos);
#pragma unroll
                        for (int j = 0; j < 4; ++j) vt[(unsigned)j * 544] = (bf16_t)f2bf(v[j]);
                        *(f32x4*)(ovs + ((unsigned)(b * 16 + pos) * DM + hc)) = v;
                    }
                }
            }
    }
    PG8_EPI_WALK()
};

struct EpiQkvB {
    static constexpr bool PERM = false, AFTER_DRAIN = false;
    int cnt;
    struct Ctx { const float* st; const float* c1; const float* c2; const float* rope; bf16_t* Q; bf16_t* Kp; bf16_t* Vtp; bf16_t* Ks; bf16_t* Vts; float* outp; };
    __device__ __forceinline__ Ctx ctx() const {
        unsigned char* wsp = get_args()->ws; Ctx c; c.outp = get_args()->out;
        c.st = (const float*)(wsp + ((cnt & 1) ? WS_STA : WS_STB)); c.c1 = (const float*)(wsp + WS_MISC) + MC_QKVB; c.c2 = c.c1 + 1536; c.rope = (const float*)(wsp + WS_MISC) + MC_ROPE;
        c.Q = (bf16_t*)(wsp + WS_BIG); c.Kp = (bf16_t*)(wsp + WS_BIG + BIG_K); c.Vtp = (bf16_t*)(wsp + WS_BIG + BIG_VT); c.Ks = (bf16_t*)(wsp + WS_KSB); c.Vts = (bf16_t*)(wsp + WS_VTSB); return c; }
    __device__ __forceinline__ void row_op(const Ctx& cx, int pm, int pn, int wc, int row, int fq, const f32x4 (&va)[2][2]) const {
        const int ns0 = pn * 256 + wc * 32 + 4 * fq;
        const bool sample = (pm == 128);
        float* okp = cx.outp + OUT_BKP; float* ovp = cx.outp + OUT_BVP; float* oks = cx.outp + OUT_BKS; float* ovs = cx.outp + OUT_BVS;
        const int dlo = 16 * (wc & 1) + 4 * fq;
        float mean, rstd; row_mean_rstd(cx.st, row, fq, mean, rstd);
        int b, pos; if (!sample) { b = row >> 11; pos = row & 2047; } else { const int r = row - MP; b = r >> 4; pos = r & 15; }
        if (pn < 5) {
            const int rp = sample ? 2048 + pos : pos;
            const f32x4 cs0 = *(const f32x4*)(cx.rope + ((unsigned)rp * 32 + dlo) * 2), cs1 = *(const f32x4*)(cx.rope + ((unsigned)rp * 32 + dlo) * 2 + 4);
            const f32x4 cc = (f32x4){cs0[0], cs0[2], cs1[0], cs1[2]}, ss = (f32x4){cs0[1], cs0[3], cs1[1], cs1[3]};
#pragma unroll
            for (int bj = 0; bj < 2; ++bj) {
                const f32x4 x1 = (va[bj][0] - mean * *(const f32x4*)(cx.c1 + ns0 + bj * 128)) * rstd + *(const f32x4*)(cx.c2 + ns0 + bj * 128);
                const f32x4 x2 = (va[bj][1] - mean * *(const f32x4*)(cx.c1 + ns0 + bj * 128 + 16)) * rstd + *(const f32x4*)(cx.c2 + ns0 + bj * 128 + 16);
                const f32x4 lo = x1 * cc - x2 * ss, hi = x2 * cc + x1 * ss;
                const int hit = bj * 2 + (wc >> 1);
                if (pn < 4) {
                    const int hc = (pn * 4 + hit) * 64 + dlo;
                    *(u32x2*)(cx.Q + (unsigned)row * DM + hc) = pk4(lo); *(u32x2*)(cx.Q + (unsigned)row * DM + hc + 32) = pk4(hi);
                } else {
                    const int kc = hit * 64 + dlo;
                    if (!sample) {
                        *(u32x2*)(cx.Kp + (unsigned)row * 256 + kc) = pk4(lo); *(u32x2*)(cx.Kp + (unsigned)row * 256 + kc + 32) = pk4(hi);
                        if (pos >= 1920) { float* o = okp + ((unsigned)(b * 128 + pos - 1920) * 256 + kc); *(f32x4*)o = lo; *(f32x4*)(o + 32) = hi; }
                    } else {
                        bf16_t* kd = cx.Ks + ((unsigned)(b * 160 + 128 + pos) * 256 + kc); *(u32x2*)kd = pk4(lo); *(u32x2*)(kd + 32) = pk4(hi);
                        float* o = oks + ((unsigned)(b * 16 + pos) * 256 + kc); *(f32x4*)o = lo; *(f32x4*)(o + 32) = hi;
                    }
                }
            }
        } else {
#pragma unroll
            for (int bj = 0; bj < 2; ++bj)
#pragma unroll
                for (int n = 0; n < 2; ++n) {
                    const int hc = bj * 128 + wc * 32 + n * 16 + 4 * fq, kvh = hc >> 6, d = hc & 63;
                    const f32x4 v = (va[bj][n] - mean * *(const f32x4*)(cx.c1 + ns0 + bj * 128 + n * 16)) * rstd + *(const f32x4*)(cx.c2 + ns0 + bj * 128 + n * 16);
                    if (!sample) {
                        bf16_t* vt = cx.Vtp + ((unsigned)((b * 4 + kvh) * 64 + d) * 2048 + pos);
#pragma unroll
                        for (int j = 0; j < 4; ++j) vt[(unsigned)j * 2048] = (bf16_t)f2bf(v[j]);
                        if (pos >= 1920) *(f32x4*)(ovp + ((unsigned)(b * 128 + pos - 1920) * 256 + hc)) = v;
                    } else {
                        bf16_t* vt = cx.Vts + ((unsigned)((b * 4 + kvh) * 64 + d) * 160 + 128 + pos);
#pragma unroll
                        for (int j = 0; j < 4; ++j) vt[(unsigned)j * 160] = (bf16_t)f2bf(v[j]);
                        *(f32x4*)(ovs + ((unsigned)(b * 16 + pos) * 256 + hc)) = v;
                    }
                }
        }
    }
    PG8_EPI_WALK()
};

template <class Epi>
__device__ __forceinline__ void small_gemm(PG8_LAS unsigned char* lds, const bf16_t* A, const bf16_t* Bt, int N, int K, const Epi& E) {
    typedef float f32x16 __attribute__((ext_vector_type(16)));
    int tid_o = threadIdx.x; asm volatile("" : "+v"(tid_o));
    const int tid = tid_o, wid = __builtin_amdgcn_readfirstlane(tid >> 6), lane = tid & 63, r = lane & 31, h = lane >> 5;
    const int ntiles = 8 * (N / 64), ks = K / 8;
    PG8_LAS float* part = (PG8_LAS float*)lds;
    const typename Epi::Ctx cx = E.ctx();
    for (int tile = blockIdx.x; tile < ntiles; tile += gridDim.x) {
        const int tm = tile & 7, tn = tile >> 3, pn = tn >> 2, wc = tn & 3;
        const bf16_t* ap = A + (size_t)(MP + tm * 32 + r) * K + wid * ks + 8 * h;
        const bf16_t* bp0 = Bt + (size_t)(pn * 256 + wc * 32 + r) * K + wid * ks + 8 * h;
        const bf16_t* bp1 = bp0 + (size_t)128 * K;
        f32x16 acc0, acc1;
#pragma unroll
        for (int i = 0; i < 16; ++i) { acc0[i] = 0.f; acc1[i] = 0.f; }
#pragma unroll 2
        for (int k0 = 0; k0 < ks; k0 += 16) {
            const bf16x8 a = *(const bf16x8*)(ap + k0), b0 = *(const bf16x8*)(bp0 + k0), b1 = *(const bf16x8*)(bp1 + k0);
            acc0 = __builtin_amdgcn_mfma_f32_32x32x16_bf16(b0, a, acc0, 0, 0, 0);
            acc1 = __builtin_amdgcn_mfma_f32_32x32x16_bf16(b1, a, acc1, 0, 0, 0);
        }
#pragma unroll
        for (int g = 0; g < 4; ++g) {
            *(PG8_LAS f32x4*)(part + ((wid * 2 + 0) * 32 + r) * 36 + 8 * g + 4 * h) = (f32x4){acc0[4 * g], acc0[4 * g + 1], acc0[4 * g + 2], acc0[4 * g + 3]};
            *(PG8_LAS f32x4*)(part + ((wid * 2 + 1) * 32 + r) * 36 + 8 * g + 4 * h) = (f32x4){acc1[4 * g], acc1[4 * g + 1], acc1[4 * g + 2], acc1[4 * g + 3]};
        }
        __syncthreads();
        if (wid < 2) {
            const int fr = lane & 15, fq = lane >> 4, rr = wid * 16 + fr;
            f32x4 v[2][2];
#pragma unroll
            for (int bj = 0; bj < 2; ++bj)
#pragma unroll
                for (int n = 0; n < 2; ++n) {
                    f32x4 s = *(const PG8_LAS f32x4*)(part + ((0 * 2 + bj) * 32 + rr) * 36 + 16 * n + 4 * fq);
#pragma unroll
                    for (int w = 1; w < 8; ++w) s += *(const PG8_LAS f32x4*)(part + ((w * 2 + bj) * 32 + rr) * 36 + 16 * n + 4 * fq);
                    v[bj][n] = s;
                }
            E.row_op(cx, 128, pn, wc, MP + tm * 32 + rr, fq, v);
        }
        __syncthreads();
    }
}
}
template <bool MODE_A>
__device__ __forceinline__ void attn_wave(const bf16_t* Qrow0, int ldq, int nq, const bf16_t* Kb, int ldk, const bf16_t* Vt, int ldv,
                                          int kt0, int kt1, int nvalid, int qpos0, const float* tabg, LAS float* tab, float sink, bf16_t* Orow0, int ldo, int lane) {
    const int r = lane & 31, h = lane >> 5;
    const int qr = r < nq ? r : nq - 1;
    if (MODE_A) {
#pragma unroll
        for (int i = 0; i < 5; ++i) { const int idx = lane + 64 * i; if (idx < 257) tab[idx] = tabg[idx] * LOG2E; }
        asm volatile("s_waitcnt vmcnt(0) lgkmcnt(0)" ::: "memory");
    }
    bf16x8 qf[4];
#pragma unroll
    for (int s = 0; s < 4; ++s) qf[s] = *(const bf16x8*)(Qrow0 + (size_t)qr * ldq + 16 * s + 8 * h);
    const int pr = (r & ~12) | ((r & 4) << 1) | ((r & 8) >> 1);
    f32x16 O0, O1;
#pragma unroll
    for (int i = 0; i < 16; ++i) { O0[i] = 0.f; O1[i] = 0.f; }
    float mrun = MODE_A ? -1e30f : sink * LOG2E;
    float l = MODE_A ? 0.f : (h == 0 ? 1.f : 0.f);
    const float SC = 0.125f * LOG2E;
    const float tconst = MODE_A ? tab[256] : 0.f;
    const bf16_t* kbase = Kb + (size_t)pr * ldk + 8 * h;
    const bf16_t* vbase = Vt + (size_t)r * ldv + 8 * h;
#define ATT_LOAD(kt_, kf_, vf_) do { const int k0_ = (kt_) * 32; const bf16_t* kp_ = kbase + (size_t)k0_ * ldk; \
        _Pragma("unroll") for (int s = 0; s < 4; ++s) kf_[s] = *(const bf16x8*)(kp_ + 16 * s); \
        _Pragma("unroll") for (int dt = 0; dt < 2; ++dt) _Pragma("unroll") for (int s = 0; s < 2; ++s) vf_[dt][s] = *(const bf16x8*)(vbase + (size_t)(dt * 32) * ldv + k0_ + 16 * s); } while (0)
#define ATT_COMPUTE(kt_, kf_, vf_) do { const int k0 = (kt_) * 32; \
        f32x16 S; _Pragma("unroll") for (int i = 0; i < 16; ++i) S[i] = 0.f; \
        _Pragma("unroll") for (int s = 0; s < 4; ++s) S = __builtin_amdgcn_mfma_f32_32x32x16_bf16(kf_[s], qf[s], S, 0, 0, 0); \
        float t[16]; const int qp = qpos0 + r; \
        const bool farblk = MODE_A && (qpos0 - (k0 + 31) >= 128); \
        float mx = -1e30f; \
        _Pragma("unroll") for (int i = 0; i < 16; ++i) { \
            const int key = k0 + 16 * (i >> 3) + 8 * h + (i & 7); float bias = 0.f; \
            if (MODE_A) { if (farblk) bias = tconst; else { int rel = qp - key; rel = rel < -128 ? -128 : (rel > 128 ? 128 : rel); bias = tab[rel + 128]; } } \
            float v = S[i] * SC + bias; if (key >= nvalid) v = -1e30f; t[i] = v; mx = fmaxf(mx, v); } \
        mx = fmaxf(mx, __shfl_xor(mx, 32)); \
        const float mnew = fmaxf(mrun, mx); const float alpha = __builtin_amdgcn_exp2f(mrun - mnew); mrun = mnew; \
        float ps = 0.f; \
        _Pragma("unroll") for (int i = 0; i < 16; ++i) { t[i] = __builtin_amdgcn_exp2f(t[i] - mnew); ps += t[i]; } \
        l = l * alpha + ps; \
        _Pragma("unroll") for (int i = 0; i < 16; ++i) { O0[i] *= alpha; O1[i] *= alpha; } \
        bf16x8 pf[2]; \
        _Pragma("unroll") for (int s = 0; s < 2; ++s) { u32x4 w; w.x = pg8::cvt_pk_bf16(t[8 * s + 0], t[8 * s + 1]); w.y = pg8::cvt_pk_bf16(t[8 * s + 2], t[8 * s + 3]); \
            w.z = pg8::cvt_pk_bf16(t[8 * s + 4], t[8 * s + 5]); w.w = pg8::cvt_pk_bf16(t[8 * s + 6], t[8 * s + 7]); pf[s] = __builtin_bit_cast(bf16x8, w); } \
        O0 = __builtin_amdgcn_mfma_f32_32x32x16_bf16(vf_[0][0], pf[0], O0, 0, 0, 0); O0 = __builtin_amdgcn_mfma_f32_32x32x16_bf16(vf_[0][1], pf[1], O0, 0, 0, 0); \
        O1 = __builtin_amdgcn_mfma_f32_32x32x16_bf16(vf_[1][0], pf[0], O1, 0, 0, 0); O1 = __builtin_amdgcn_mfma_f32_32x32x16_bf16(vf_[1][1], pf[1], O1, 0, 0, 0); } while (0)
    bf16x8 kfa[4], vfa[2][2], kfb[4], vfb[2][2];
    ATT_LOAD(kt0, kfa, vfa);
    for (int kt = kt0; kt < kt1; kt += 2) {
        const int kn1 = kt + 1 < kt1 ? kt + 1 : kt;
        ATT_LOAD(kn1, kfb, vfb);
        ATT_COMPUTE(kt, kfa, vfa);
        if (kt + 1 < kt1) {
            const int kn2 = kt + 2 < kt1 ? kt + 2 : kt + 1;
            ATT_LOAD(kn2, kfa, vfa);
            ATT_COMPUTE(kt + 1, kfb, vfb);
        }
    }
#undef ATT_LOAD
#undef ATT_COMPUTE
    l += __shfl_xor(l, 32);
    const float inv = 1.0f / l;
    if (r < nq) {
        bf16_t* op = Orow0 + (size_t)r * ldo + 4 * h;
#pragma unroll
        for (int g = 0; g < 4; ++g) {
            f32x4 a = (f32x4){O0[4 * g], O0[4 * g + 1], O0[4 * g + 2], O0[4 * g + 3]} * inv;
            f32x4 b = (f32x4){O1[4 * g], O1[4 * g + 1], O1[4 * g + 2], O1[4 * g + 3]} * inv;
            *(u32x2*)(op + 8 * g) = pk4(a);
            *(u32x2*)(op + 32 + 8 * g) = pk4(b);
        }
    }
}

__device__ __forceinline__ void prep_weight_item(const float* W, int K, int N, int cb0, int cb1, const float* g, const float* b, bf16_t* Bt, int row0, float* c1, float* c2,
                                                 LAS float* scr, int lane, int kbeg, int kend) {
    const int c = lane & 31, col = c < 16 ? cb0 + c : cb1 + c - 16;
    float a1 = 0.f, a2 = 0.f;
    for (int k0 = kbeg; k0 < kend; k0 += 64) {
#pragma unroll 8
        for (int i = 0; i < 32; ++i) {
            const int kk = 2 * i + (lane >> 5);
            const float w = W[(size_t)(k0 + kk) * N + col];
            float v = w;
            if (g) { v = w * g[k0 + kk]; a2 += w * b[k0 + kk]; }
            v = bfround(v); a1 += v;
            scr[kk * 33 + c] = v;
        }
        asm volatile("s_waitcnt lgkmcnt(0)" ::: "memory");
        const int c8 = lane & 7;
#pragma unroll
        for (int j = 0; j < 4; ++j) {
            const int n = (lane >> 3) + 8 * j; const LAS float* s = scr + (8 * c8) * 33 + n;
            u32x4 o;
            o.x = (__builtin_bit_cast(unsigned, s[0 * 33]) >> 16) | (__builtin_bit_cast(unsigned, s[1 * 33]) & 0xffff0000u);
            o.y = (__builtin_bit_cast(unsigned, s[2 * 33]) >> 16) | (__builtin_bit_cast(unsigned, s[3 * 33]) & 0xffff0000u);
            o.z = (__builtin_bit_cast(unsigned, s[4 * 33]) >> 16) | (__builtin_bit_cast(unsigned, s[5 * 33]) & 0xffff0000u);
            o.w = (__builtin_bit_cast(unsigned, s[6 * 33]) >> 16) | (__builtin_bit_cast(unsigned, s[7 * 33]) & 0xffff0000u);
            *(u32x4*)(Bt + (size_t)(row0 + n) * K + k0 + 8 * c8) = o;
        }
        asm volatile("s_waitcnt lgkmcnt(0)" ::: "memory");
    }
    a1 += __shfl_xor(a1, 32); a2 += __shfl_xor(a2, 32);
    if (c1 && lane < 32) { atomicAdd(c1 + row0 + c, a1); atomicAdd(c2 + row0 + c, a2); }
}
constexpr int N_PHASES = 16;
#include <cstdint>
#include <cstdlib>
#include <vector>

#include <cstdint>
#include <cstdlib>
#include <vector>

#define XB_TMO      128
#define XB_XCNT(j)  (256  + 64 * (j))
#define XB_XSUB(j)  (1280 + 64 * (j))
#define XB_XGEN(j)  (2304 + 64 * (j))
#define XB_TOP      3328
#define XB_TOPGEN   3392
#define XCD_BAR_WORDS 3456
#define XB_SPIN_CAP (1u << 18)

__device__ __forceinline__ unsigned xb_ld(unsigned* p)              { return __hip_atomic_load(p, __ATOMIC_RELAXED, __HIP_MEMORY_SCOPE_AGENT); }
__device__ __forceinline__ unsigned xb_add(unsigned* p, unsigned v) { return __hip_atomic_fetch_add(p, v, __ATOMIC_RELAXED, __HIP_MEMORY_SCOPE_AGENT); }
__device__ __forceinline__ unsigned xb_xcc_id() { return (unsigned)__builtin_amdgcn_s_getreg((3 << 11) | 20) & 0xFu; }
#define XB_SPIN(cond, bar) do { unsigned _sp = 0; while (cond) { __builtin_amdgcn_s_sleep(1); \
    if ((++_sp & 255u) == 0u) { if (xb_ld(&(bar)[XB_TMO])) break; if (_sp > XB_SPIN_CAP) { atomicAdd(&(bar)[XB_TMO], 1u); break; } } } } while (0)

struct XcdBarrier {
    unsigned* bar; unsigned x;
    volatile LAS unsigned* st;
};

__device__ __forceinline__ XcdBarrier xcd_barrier_post(unsigned* bar, volatile LAS unsigned* st) {
    XcdBarrier b; b.bar = bar; b.x = xb_xcc_id(); b.st = st;
    if (threadIdx.x == 0) (void)xb_add(&bar[XB_XCNT(b.x)], 1u);
    return b;
}
__device__ __forceinline__ void xcd_barrier_complete(unsigned* bar, unsigned x, unsigned& nloc, unsigned& nx) {
    const unsigned G = gridDim.x * gridDim.y * gridDim.z;
    unsigned sum, cnt, mine, sp = 0u;
    for (;;) {
        sum = 0u; cnt = 0u; mine = 0u;
#pragma unroll
        for (unsigned j = 0; j < 16; ++j) { const unsigned c = xb_ld(&bar[XB_XCNT(j)]); sum += c; cnt += (c > 0u) ? 1u : 0u; mine = (j == x) ? c : mine; }
        if (sum == G) break;
        __builtin_amdgcn_s_sleep(1);
        if ((++sp & 255u) == 0u) { if (xb_ld(&bar[XB_TMO])) break; if (sp > XB_SPIN_CAP) { atomicAdd(&bar[XB_TMO], 1u); break; } }
    }
    nloc = mine > 0u ? mine : 1u; nx = cnt > 0u ? cnt : 1u;
}

__device__ __forceinline__ void xcd_barrier(const XcdBarrier& b) {
    asm volatile("s_waitcnt vmcnt(0)" ::: "memory");
    __syncthreads();
    if (threadIdx.x == 0) {
        unsigned* bar = b.bar;
        __builtin_amdgcn_s_waitcnt(0);
        unsigned nloc = b.st[0], nx = b.st[1];
        if (nloc == 0u) { xcd_barrier_complete(bar, b.x, nloc, nx); b.st[0] = nloc; b.st[1] = nx; }
        const unsigned old = xb_add(&bar[XB_XSUB(b.x)], 1u);
        const unsigned gen = old / nloc;
        if (old + 1u == (gen + 1u) * nloc) {
            __builtin_amdgcn_fence(__ATOMIC_RELEASE, "agent");
            asm volatile("s_waitcnt vmcnt(0)" ::: "memory");
            const unsigned og = xb_add(&bar[XB_TOP], 1u);
            const unsigned tg = og / nx;
            if (og + 1u == (tg + 1u) * nx) xb_add(&bar[XB_TOPGEN], 1u);
            else XB_SPIN(xb_ld(&bar[XB_TOPGEN]) == tg, bar);
            __builtin_amdgcn_fence(__ATOMIC_ACQUIRE, "agent");
            xb_add(&bar[XB_XGEN(b.x)], 1u);
            asm volatile("s_waitcnt vmcnt(0)" ::: "memory");
        } else {
            XB_SPIN(xb_ld(&bar[XB_XGEN(b.x)]) == gen, bar);
            __builtin_amdgcn_fence(__ATOMIC_ACQUIRE, "agent");
            asm volatile("s_waitcnt vmcnt(0)" ::: "memory");
        }
    }
    __syncthreads();
}


__device__ const double ROPE_INV[32] = {1.0, 0.7498942093324559, 0.5623413251903491, 0.4216965034285822, 0.31622776601683794, 0.23713737056616552, 0.1778279410038923, 0.1333521432163324, 0.1,
    0.07498942093324558, 0.05623413251903491, 0.042169650342858224, 0.03162277660168379, 0.023713737056616554, 0.01778279410038923, 0.01333521432163324, 0.01, 0.007498942093324558,
    0.005623413251903491, 0.004216965034285823, 0.0031622776601683794, 0.0023713737056616554, 0.0017782794100389228, 0.001333521432163324, 0.001, 0.0007498942093324559, 0.0005623413251903491,
    0.00042169650342858224, 0.00031622776601683794, 0.00023713737056616554, 0.00017782794100389227, 0.0001333521432163324};


#define AIN(i) ((const float*)get_args()->in[i])
#define x_p AIN(0)
#define x_s AIN(1)
#define cak AIN(2)
#define cav AIN(3)
#define cbk AIN(4)
#define cbv AIN(5)
#define ln_g AIN(6)
#define ln_b AIN(7)
#define w_in AIN(8)
#define w_dn AIN(9)
#define w_qkva AIN(10)
#define w_oa AIN(11)
#define relb AIN(12)
#define w_qkvb AIN(13)
#define w_ob AIN(14)
#define sinks AIN(15)
#define out ((float*)get_args()->out)
#define WSP ((unsigned char*)get_args()->ws)
#define Win ((bf16_t*)(WSP + WS_WIN))
#define Wdn ((bf16_t*)(WSP + WS_WDN))
#define Wqkva ((bf16_t*)(WSP + WS_WQKVA))
#define Woa ((bf16_t*)(WSP + WS_WOA))
#define Wqkvb ((bf16_t*)(WSP + WS_WQKVB))
#define Wob ((bf16_t*)(WSP + WS_WOB))
#define misc ((float*)(WSP + WS_MISC))
#define stA ((float*)(WSP + WS_STA))
#define stB ((float*)(WSP + WS_STB))
#define Zb ((bf16_t*)(WSP + WS_ZB))
#define Ksa ((bf16_t*)(WSP + WS_KSA))
#define Vtsa ((bf16_t*)(WSP + WS_VTSA))
#define Ksb ((bf16_t*)(WSP + WS_KSB))
#define Vtsb ((bf16_t*)(WSP + WS_VTSB))
#define Hb ((bf16_t*)(WSP + WS_BIG))
#define Qb ((bf16_t*)(WSP + WS_BIG))
#define Kpb ((bf16_t*)(WSP + WS_BIG + BIG_K))
#define Vtpb ((bf16_t*)(WSP + WS_BIG + BIG_VT))
#define rope (misc + MC_ROPE)
__global__ void __launch_bounds__(512, 2) fwd_kernel(Args args) {
    extern __shared__ __attribute__((aligned(16))) unsigned char lds_raw[];
    LAS unsigned char* lds = (LAS unsigned char*)lds_raw;
    cg::grid_group grid = cg::this_grid();
    const int tid = threadIdx.x, lane = tid & 63, wave = __builtin_amdgcn_readfirstlane(tid >> 6);
    const int G = gridDim.x, bid = blockIdx.x;
    if (tid < 4) ((LAS unsigned*)(lds + 131072))[tid] = 0u;
    __syncthreads();
    const XcdBarrier xbar = xcd_barrier_post((unsigned*)WSP, (volatile LAS unsigned*)(lds + 131072));
    const int lo = args.ph_lo, hi = args.ph_hi;
#define IN(k) (lo <= (k) && (k) < hi)
#ifndef PROBE_DUP
#define PROBE_DUP 0
#endif
#define SEAM(k) do { if (IN(k) && IN((k) + 1)) { if ((k) == 0) grid.sync(); else { xcd_barrier(xbar); if (PROBE_DUP & 1) xcd_barrier(xbar); } } } while (0)

    if (IN(0))
#pragma unroll 1
    for (int rep = 0; rep < ((PROBE_DUP & 8) ? 2 : 1); ++rep) {
        const int gw = bid * 8 + wave, NGW = G * 8;
        const long gt = (long)bid * 512 + tid, NGT = (long)G * 512;
        LAS float* scr = (LAS float*)(lds + wave * 16384);
        for (int it = gw; it < 5056; it += NGW) {
            int r = it;
            if (r < 2816) { const int w = r / 704, grp = (r % 704) >> 2, kc = r & 3;
                const int lnidx = (w == 1) ? 1 : (w == 2) ? 2 : 4;
                const float* g = (w == 0) ? nullptr : ln_g + lnidx * DM; const float* b = (w == 0) ? nullptr : ln_b + lnidx * DM;
                float* c1 = (w == 0) ? nullptr : misc + MC_WIN + w * 2 * 5632;
                prep_weight_item(w_in + (size_t)w * DM * 2 * FF, DM, 2 * FF, grp * 16, FF + grp * 16, g, b, Win + (size_t)w * 2 * FF * DM, grp * 32, c1, c1 + 5632, scr, lane, kc * 256, kc * 256 + 256);
                continue; }
            r -= 2816;
            if (r < 1408) { const int w = r / 352, grp = (r % 352) / 11, kc = r % 11;
                prep_weight_item(w_dn + (size_t)w * FF * DM, FF, DM, grp * 32, grp * 32 + 16, nullptr, nullptr, Wdn + (size_t)w * DM * FF, grp * 32, nullptr, nullptr, scr, lane, kc * 256, kc * 256 + 256);
                continue; }
            r -= 1408;
            const int kc = r & 3; r >>= 2;
            if (r < 96) { prep_weight_item(w_qkva, DM, 3072, r * 32, r * 32 + 16, ln_g + 0 * DM, ln_b + 0 * DM, Wqkva, r * 32, misc + MC_QKVA, misc + MC_QKVA + 3072, scr, lane, kc * 256, kc * 256 + 256); continue; }
            r -= 96;
            if (r < 32) { prep_weight_item(w_oa, DM, DM, r * 32, r * 32 + 16, nullptr, nullptr, Woa, r * 32, nullptr, nullptr, scr, lane, kc * 256, kc * 256 + 256); continue; }
            r -= 32;
            if (r < 48) { int cb0, cb1; if (r < 40) { cb0 = (r >> 1) * 64 + 16 * (r & 1); cb1 = cb0 + 32; } else { cb0 = r * 32; cb1 = cb0 + 16; }
                prep_weight_item(w_qkvb, DM, 1536, cb0, cb1, ln_g + 3 * DM, ln_b + 3 * DM, Wqkvb, r * 32, misc + MC_QKVB, misc + MC_QKVB + 1536, scr, lane, kc * 256, kc * 256 + 256); continue; }
            r -= 48;
            prep_weight_item(w_ob, DM, DM, r * 32, r * 32 + 16, nullptr, nullptr, Wob, r * 32, nullptr, nullptr, scr, lane, kc * 256, kc * 256 + 256);
        }
        for (long i = gt; i < (long)MT * 128; i += NGT) {
            const int row = (int)(i >> 7), c8 = (int)(i & 127);
            const float* src = (row < MP ? x_p + (size_t)row * DM : x_s + (size_t)(row - MP) * DM) + c8 * 8;
            const f32x4 a = *(const f32x4*)src, b = *(const f32x4*)(src + 4);
            u32x4 o; o.x = pk2(a[0], a[1]); o.y = pk2(a[2], a[3]); o.z = pk2(b[0], b[1]); o.w = pk2(b[2], b[3]);
            *(u32x4*)(Zb + (size_t)row * DM + c8 * 8) = o;
        }
        for (long i = gt; i < 2064 * 32; i += NGT) {
            const int pos = (int)(i >> 5), fi = (int)(i & 31);
            const double a = (double)pos * ROPE_INV[fi];
            const double n = __builtin_floor(a * 0.15915494309189535);
            const float rr = (float)__builtin_fma(-n, 6.283185307179586, a);
            rope[2 * i] = cosf(rr); rope[2 * i + 1] = sinf(rr);
        }
        for (long i = gt; i < 16L * 544 * 128; i += NGT) {
            const int c8 = (int)(i & 127); const int bp = (int)(i >> 7); const int b = bp / 544, pos = bp % 544;
            u32x4 o = (u32x4){0u, 0u, 0u, 0u};
            if (pos < 512) { const float* src = cak + ((size_t)(b * 512 + pos) * DM + c8 * 8); const f32x4 a = *(const f32x4*)src, c = *(const f32x4*)(src + 4);
                o.x = pk2(a[0], a[1]); o.y = pk2(a[2], a[3]); o.z = pk2(c[0], c[1]); o.w = pk2(c[2], c[3]); }
            if (pos < 512 || pos >= 528) *(u32x4*)(Ksa + (size_t)bp * DM + c8 * 8) = o;
        }
        for (long i = gt; i < 16L * 16 * 68 * 64; i += NGT) {
            const int d = (int)(i & 63); long t = i >> 6; const int p8 = (int)(t % 68); t /= 68; const int h = (int)(t & 15), b = (int)(t >> 4);
            u32x4 o = (u32x4){0u, 0u, 0u, 0u};
            if (p8 < 64) { float v[8];
#pragma unroll
                for (int e = 0; e < 8; ++e) v[e] = cav[((size_t)(b * 512 + p8 * 8 + e) * 16 + h) * 64 + d];
                o.x = pk2(v[0], v[1]); o.y = pk2(v[2], v[3]); o.z = pk2(v[4], v[5]); o.w = pk2(v[6], v[7]); }
            if (p8 < 64 || p8 >= 66) *(u32x4*)(Vtsa + ((size_t)((b * 16 + h) * 64 + d) * 544 + p8 * 8)) = o;
        }
        for (long i = gt; i < 16L * 160 * 32; i += NGT) {
            const int c8 = (int)(i & 31); const int bp = (int)(i >> 5); const int b = bp / 160, pos = bp % 160;
            u32x4 o = (u32x4){0u, 0u, 0u, 0u};
            if (pos < 128) { const float* src = cbk + ((size_t)(b * 128 + pos) * 256 + c8 * 8); const f32x4 a = *(const f32x4*)src, c = *(const f32x4*)(src + 4);
                o.x = pk2(a[0], a[1]); o.y = pk2(a[2], a[3]); o.z = pk2(c[0], c[1]); o.w = pk2(c[2], c[3]); }
            if (pos < 128 || pos >= 144) *(u32x4*)(Ksb + (size_t)bp * 256 + c8 * 8) = o;
        }
        for (long i = gt; i < 16L * 4 * 20 * 64; i += NGT) {
            const int d = (int)(i & 63); long t = i >> 6; const int p8 = (int)(t % 20); t /= 20; const int h = (int)(t & 3), b = (int)(t >> 2);
            u32x4 o = (u32x4){0u, 0u, 0u, 0u};
            if (p8 < 16) { float v[8];
#pragma unroll
                for (int e = 0; e < 8; ++e) v[e] = cbv[((size_t)(b * 128 + p8 * 8 + e) * 4 + h) * 64 + d];
                o.x = pk2(v[0], v[1]); o.y = pk2(v[2], v[3]); o.z = pk2(v[4], v[5]); o.w = pk2(v[6], v[7]); }
            if (p8 < 16 || p8 >= 18) *(u32x4*)(Vtsb + ((size_t)((b * 4 + h) * 64 + d) * 160 + p8 * 8)) = o;
        }
    }
    SEAM(0);

#pragma unroll 1
    for (int s = 0; s < 14; ++s) {
        if (IN(s + 1)) {
            const int L = s / 7, k = s % 7;
            const int c = 3 * L + (k > 1) + (k > 4);
            if (false) {}
#ifndef NO_SW
            else if (k == 0 || k == 5)
#pragma unroll 1
            for (int rep = 0; rep < ((PROBE_DUP & 2) ? 2 : 1); ++rep) {
                const int w = 2 * L + (k == 5);
                pg8::Gemm g{Zb, Win + (size_t)w * 2 * FF * DM, MP, 2 * FF, DM}; pg8::StaticOrder S; S.init(MP, 2 * FF, G, bid);
                pg8::EpiSwiglu E{w, c};
                pg8::small_gemm<pg8::EpiSwiglu>(lds, g.A, g.Bt, g.N, g.K, E);
                pg8::gemm_phase<pg8::EpiSwiglu, pg8::StaticOrder, true, true>(lds, g, S, E);
            }
#endif
#ifndef NO_RES
            else if (k == 1 || k == 6 || k == 4) {
                const bool wo = (k == 4);
                const bf16_t* Bt = wo ? (L == 0 ? Woa : Wob) : Wdn + (size_t)(2 * L + (k == 6)) * DM * FF;
                pg8::Gemm g{wo ? Qb : Hb, Bt, MP, DM, wo ? DM : FF}; pg8::StaticOrder S; S.init(MP, DM, G, bid);
                pg8::EpiResid E{c, wo ? 1.0f : 0.5f};
                pg8::small_gemm<pg8::EpiResid>(lds, g.A, g.Bt, g.N, g.K, E);
                pg8::gemm_phase<pg8::EpiResid, pg8::StaticOrder, true, true>(lds, g, S, E);
            }
#endif
#ifndef NO_QKV
            else if (k == 2)
#pragma unroll 1
            for (int rep = 0; rep < ((PROBE_DUP & 8) ? 2 : 1); ++rep) {
                if (L == 0) {
                    pg8::Gemm g{Zb, Wqkva, MP, 3072, DM}; pg8::StaticOrder S; S.init(MP, 3072, G, bid);
                    pg8::EpiQkvA E{c};
                    pg8::small_gemm<pg8::EpiQkvA>(lds, g.A, g.Bt, g.N, g.K, E);
                    pg8::gemm_phase<pg8::EpiQkvA, pg8::StaticOrder, true, true>(lds, g, S, E);
                } else {
                    pg8::Gemm g{Zb, Wqkvb, MP, 1536, DM}; pg8::StaticOrder S; S.init(MP, 1536, G, bid);
                    pg8::EpiQkvB E{c};
                    pg8::small_gemm<pg8::EpiQkvB>(lds, g.A, g.Bt, g.N, g.K, E);
                    pg8::gemm_phase<pg8::EpiQkvB, pg8::StaticOrder, true, true>(lds, g, S, E);
                }
            }
#endif
#ifndef NO_ATT
            else
#pragma unroll 1
            for (int rep = 0; rep < ((PROBE_DUP & 4) ? 2 : 1); ++rep) {
                bf16_t* Ob = ((PROBE_DUP & 4) && rep == 0) ? (bf16_t*)(WSP + 400 * MiB) : Qb;
                int lane_o = threadIdx.x & 63; asm volatile("" : "+v"(lane_o)); const int lane = lane_o;
                for (int bu = bid; bu < 2048 + 32; bu += G) {
                    if (L == 0) {
                        if (bu < 2048) { const int b = bu >> 7, h = (bu >> 3) & 15, chunk = (bu & 7) * 4 + (wave >> 1), half = wave & 1;
                            const size_t row0 = (size_t)b * 2048 + chunk * 64 + half * 32;
                            attn_wave<true>(Qb + row0 * DM + h * 64, DM, 32, Kpb + (size_t)b * 2048 * DM + h * 64, DM, Vtpb + (size_t)((b * 16 + h) * 64) * 2048, 2048,
                                            (chunk > 8 ? chunk - 8 : 0) * 2, (chunk + 1) * 2, 1 << 30, chunk * 64 + half * 32, relb + h * 257, (LAS float*)(lds + wave * 2048), 0.f, Ob + row0 * DM + h * 64, DM, lane);
                        } else { const int wu = (bu - 2048) * 8 + wave, b = wu >> 4, h = wu & 15; const size_t row0 = (size_t)MP + b * 16;
                            attn_wave<true>(Qb + row0 * DM + h * 64, DM, 16, Ksa + (size_t)b * 544 * DM + h * 64, DM, Vtsa + (size_t)((b * 16 + h) * 64) * 544, 544,
                                            0, 17, 528, 512, relb + h * 257, (LAS float*)(lds + wave * 2048), 0.f, Ob + row0 * DM + h * 64, DM, lane);
                        }
                    } else {
                        if (bu < 2048) { const int b = bu >> 7, kvh = (bu >> 5) & 3, chunk = bu & 31, qh = kvh * 4 + (wave >> 1), half = wave & 1;
                            const size_t row0 = (size_t)b * 2048 + chunk * 64 + half * 32;
                            attn_wave<false>(Qb + row0 * DM + qh * 64, DM, 32, Kpb + (size_t)b * 2048 * 256 + kvh * 64, 256, Vtpb + (size_t)((b * 4 + kvh) * 64) * 2048, 2048,
                                             (chunk > 2 ? chunk - 2 : 0) * 2, (chunk + 1) * 2, 1 << 30, 0, nullptr, nullptr, sinks[qh], Ob + row0 * DM + qh * 64, DM, lane);
                        } else { const int wu = (bu - 2048) * 8 + wave, b = wu >> 4, qh = wu & 15, kvh = qh >> 2; const size_t row0 = (size_t)MP + b * 16;
                            attn_wave<false>(Qb + row0 * DM + qh * 64, DM, 16, Ksb + (size_t)b * 160 * 256 + kvh * 64, 256, Vtsb + (size_t)((b * 4 + kvh) * 64) * 160, 160,
                                             0, 5, 144, 0, nullptr, nullptr, sinks[qh], Ob + row0 * DM + qh * 64, DM, lane);
                        }
                    }
                }
            }
#endif
        }
        SEAM(s + 1);
    }
    if (IN(15)) {
        const int gw = bid * 8 + wave, NGW = G * 8;
        const float* g = ln_g + 5 * DM; const float* b = ln_b + 5 * DM;
        f32x4 gv[4], bv[4];
#pragma unroll
        for (int j = 0; j < 4; ++j) { gv[j] = *(const f32x4*)(g + 4 * lane + 256 * j); bv[j] = *(const f32x4*)(b + 4 * lane + 256 * j); }
        for (int row = gw; row < MT; row += NGW) {
            float* zr = out + (size_t)row * DM + 4 * lane;
            f32x4 v[4]; float s = 0.f;
#pragma unroll
            for (int j = 0; j < 4; ++j) { v[j] = *(const f32x4*)(zr + 256 * j); s += (v[j][0] + v[j][1]) + (v[j][2] + v[j][3]); }
            const float mean = wave_sum(s) * (1.0f / DM); float s2 = 0.f;
#pragma unroll
            for (int j = 0; j < 4; ++j) { v[j] = v[j] - mean; s2 += (v[j][0] * v[j][0] + v[j][1] * v[j][1]) + (v[j][2] * v[j][2] + v[j][3] * v[j][3]); }
            const float rstd = 1.0f / sqrtf(wave_sum(s2) * (1.0f / DM) + 1e-5f);
#pragma unroll
            for (int j = 0; j < 4; ++j) *(f32x4*)(zr + 256 * j) = v[j] * rstd * gv[j] + bv[j];
        }
    }
#undef IN
#undef SEAM
}

#undef AIN
#undef x_p
#undef x_s
#undef cak
#undef cav
#undef cbk
#undef cbv
#undef ln_g
#undef ln_b
#undef w_in
#undef w_dn
#undef w_qkva
#undef w_oa
#undef relb
#undef w_qkvb
#undef w_ob
#undef sinks
#undef out
#undef WSP
#undef Win
#undef Wdn
#undef Wqkva
#undef Woa
#undef Wqkvb
#undef Wob
#undef misc
#undef stA
#undef stB
#undef Zb
#undef Ksa
#undef Vtsa
#undef Ksb
#undef Vtsb
#undef Hb
#undef Qb
#undef Kpb
#undef Vtpb
#undef rope
#ifndef N_LAUNCH_MODE
#define N_LAUNCH_MODE 1
#endif
extern "C" void kernel_launch(void* const* d_in, const int* in_sizes, int n_in, void* d_out, int out_size, void* d_ws, size_t ws_size, hipStream_t stream) {
    static int grid = 0;
    if (grid == 0) {
        if (n_in != 16 || ws_size < WS_END || (size_t)out_size != OUT_END) { fprintf(stderr, "kernel_launch: unexpected problem (n_in %d, out %d, ws %zu)\n", n_in, out_size, ws_size); grid = -1; return; }
        int dev = 0, cus = 0, per_cu = 0;
        (void)hipGetDevice(&dev); (void)hipDeviceGetAttribute(&cus, hipDeviceAttributeMultiprocessorCount, dev);
        if (hipFuncSetAttribute((const void*)fwd_kernel, hipFuncAttributeMaxDynamicSharedMemorySize, LDS_BYTES) != hipSuccess) { fprintf(stderr, "kernel_launch: hipFuncSetAttribute failed\n"); grid = -1; return; }
        if (hipOccupancyMaxActiveBlocksPerMultiprocessor(&per_cu, (const void*)fwd_kernel, 512, LDS_BYTES) != hipSuccess || per_cu < 1) { fprintf(stderr, "kernel_launch: occupancy query gave %d\n", per_cu); per_cu = 1; }
        (void)hipGetLastError();
        grid = cus * per_cu;
        fprintf(stderr, "kernel_launch: grid %d (cus %d x %d)\n", grid, cus, per_cu);
    }
    if (grid < 0) return;
    if (hipMemsetAsync(d_ws, 0, 16384, stream) != hipSuccess) { fprintf(stderr, "kernel_launch: memset failed\n"); return; }
    if (hipMemsetAsync((char*)d_ws + WS_MISC, 0, (size_t)MC_ROPE * 4, stream) != hipSuccess) { fprintf(stderr, "kernel_launch: memset failed\n"); return; }
    Args a{};
    for (int i = 0; i < 16; ++i) a.in[i] = (const float*)d_in[i];
    a.out = (float*)d_out; a.ws = (unsigned char*)d_ws;
    if (N_LAUNCH_MODE == 1) {
        a.ph_lo = 0; a.ph_hi = N_PHASES;
        void* kargs[] = {&a};
        hipError_t e = hipLaunchCooperativeKernel((const void*)fwd_kernel, dim3(grid), dim3(512), kargs, LDS_BYTES, stream);
        if (e != hipSuccess) fprintf(stderr, "cooperative launch failed: %s (grid %d)\n", hipGetErrorString(e), grid);
    } else {
        for (int p = 0; p < N_PHASES; ++p) { a.ph_lo = p; a.ph_hi = p + 1; hipLaunchKernelGGL(fwd_kernel, dim3(grid), dim3(512), LDS_BYTES, stream, a); }
    }
}
```

```cpp
#include <hip/hip_runtime.h>
#include <hip/hip_cooperative_groups.h>
#include <cstdio>
#include <cstdint>
namespace cg = cooperative_groups;
namespace pg8 {
#define PG8_LAS __attribute__((address_space(3)))
typedef unsigned short bf16_t;
typedef short bf16x8 __attribute__((ext_vector_type(8)));
typedef float f32x4 __attribute__((ext_vector_type(4)));
typedef unsigned u32x4 __attribute__((ext_vector_type(4)));
constexpr int BM = 256, BK = 64, HALF = 128, HTB = HALF * BK * 2  , STAGE_BYTES = 8 * HTB, NXCD = 8, WGM = 8;

__host__ __device__ __forceinline__ int lds_byte(int r, int c) { const int st = (r >> 4) * 2 + (c >> 5), rr = r & 15, cc = c & 31, ob = rr * 64 + cc * 2; return st * 1024 + (ob ^ (((ob >> 9) & 1) << 5)); }
__host__ __device__ __forceinline__ void stage_rc(int b, int& R, int& C) { const int st = b / 1024, sb = b % 1024, swz = sb ^ (((sb >> 9) & 1) << 5); R = (st >> 1) * 16 + swz / 64; C = (st & 1) * 32 + (swz % 64) / 2; }
__host__ __device__ __forceinline__ int perm32(int rho) { const int n = rho >> 4, i = rho & 15; return 8 * (i >> 2) + 4 * n + (i & 3); }

struct Unit { int pm, pn; };
struct Gemm { const bf16_t* A; const bf16_t* Bt; int M, N, K; };

struct StaticOrder {
    int nM, nN, nwg, G, c;
    __host__ __device__ void init(int M, int N, int G_, int c_) { nM = M / BM; nN = N / BM; nwg = nM * nN; G = G_; c = c_; }
    __host__ __device__ bool next(int i, Unit& u) const {
        const long L = (long)i * G + c; if (L >= nwg) return false;
        int wgid = (int)L; { const int q = nwg / NXCD, r = nwg % NXCD, xcd = wgid % NXCD, off = wgid / NXCD; wgid = (xcd < r ? xcd * (q + 1) : r * (q + 1) + (xcd - r) * q) + off; }
        const int nig = WGM * nN, gid = wgid / nig, fm = gid * WGM, gsz = (nM - fm) < WGM ? (nM - fm) : WGM;
        u.pm = fm + ((wgid % nig) % gsz); u.pn = (wgid % nig) / gsz; return true;
    }
    __device__ __forceinline__ void a_ready(const Unit&) const {}
    __device__ __forceinline__ void done(const Unit&) const {}
};

__device__ __forceinline__ unsigned cvt_pk_bf16(float lo, float hi) { unsigned r; asm volatile("v_cvt_pk_bf16_f32 %0, %1, %2" : "=v"(r) : "v"(lo), "v"(hi)); return r; }
template <class Epi, class Sched, bool ALIGN_EPI = false, bool SP2 = false>
__device__ __forceinline__ void gemm_phase(PG8_LAS unsigned char* lds, const Gemm g, const Sched& S, const Epi& E) {
    int tid_o = threadIdx.x; asm volatile("" : "+v"(tid_o));
    const int tid = tid_o, wid = __builtin_amdgcn_readfirstlane(tid >> 6), lane = tid & 63, wr = wid >> 2, wc = wid & 3, fr = lane & 15, fq = lane >> 4;
    const int K = g.K, nt = K / BK;
    unsigned voffA[2], voffB[2];
#pragma unroll
    for (int i = 0; i < 2; ++i) { int R, C; stage_rc(tid * 16 + i * 8192, R, C); const int Rb = Epi::PERM ? ((R & ~31) + perm32(R & 31)) : R;
        voffA[i] = (unsigned)(R * K + C) * 2u; voffB[i] = (unsigned)(Rb * K + C) * 2u; }
    const size_t kstep = (size_t)(BK * 2);
    const size_t hstep = (size_t)HALF * K * 2;
    const size_t tstep = 2 * hstep;
    const unsigned ldsw = (unsigned)wid * 1024u;
    const int aoff = lds_byte(wr * 64 + fr, fq * 8), boff = lds_byte(wc * 32 + fr, fq * 8);
#define PG8_SA(b, h) (((b) * 2 + (h)) * HTB)
#define PG8_SB(b, h) ((4 + (b) * 2 + (h)) * HTB)
#define PG8_STAGE(bufoff, gbase, voff) do { _Pragma("unroll") for (int _i = 0; _i < 2; ++_i) \
        __builtin_amdgcn_global_load_lds((const unsigned*)((const char*)(gbase) + (voff)[_i]), (PG8_LAS unsigned*)(lds + (bufoff) + ldsw + _i * 8192), 16, 0, 0); } while (0)
#define PG8_LDA(dst, b, h) do { _Pragma("unroll") for (int m = 0; m < 4; ++m) _Pragma("unroll") for (int k = 0; k < 2; ++k) dst[m][k] = *(const PG8_LAS bf16x8*)(lds + PG8_SA(b, h) + aoff + m * 2048 + k * 1024); } while (0)
#define PG8_LDB(dst, b, h) do { _Pragma("unroll") for (int n = 0; n < 2; ++n) _Pragma("unroll") for (int k = 0; k < 2; ++k) dst[n][k] = *(const PG8_LAS bf16x8*)(lds + PG8_SB(b, h) + boff + n * 2048 + k * 1024); } while (0)
#define PG8_MMA(ai, bj, At, Bt) do { __builtin_amdgcn_s_setprio(1); _Pragma("unroll") for (int m = 0; m < 4; ++m) _Pragma("unroll") for (int n = 0; n < 2; ++n) _Pragma("unroll") for (int k = 0; k < 2; ++k) \
        acc[ai][bj][m][n] = __builtin_amdgcn_mfma_f32_16x16x32_bf16(Bt[n][k], At[m][k], acc[ai][bj][m][n], 0, 0, 0); __builtin_amdgcn_s_setprio(0); } while (0)
#define PG8_WAIT_V(n) asm volatile("s_waitcnt vmcnt(" #n ")" ::: "memory")
#define PG8_WAIT_L(n) asm volatile("s_waitcnt lgkmcnt(" #n ")" ::: "memory")
#define PG8_BAR __builtin_amdgcn_s_barrier()
#define PG8_SCHED __builtin_amdgcn_sched_barrier(0)
    Unit cur, nxt; int ui = 0;
    if (!S.next(0, cur)) return;
    f32x4 acc[2][2][4][2];
#pragma unroll
    for (int a = 0; a < 2; ++a)
#pragma unroll
        for (int b = 0; b < 2; ++b)
#pragma unroll
            for (int m = 0; m < 4; ++m)
#pragma unroll
                for (int n = 0; n < 2; ++n) acc[a][b][m][n] = (f32x4){0.f, 0.f, 0.f, 0.f};
    bf16x8 At[4][2], B0[2][2], B1[2][2];
    const char* cA = (const char*)g.A + (size_t)cur.pm * tstep; const char* cB = (const char*)g.Bt + (size_t)cur.pn * tstep;
    S.a_ready(cur);
    if constexpr (SP2) {
        PG8_STAGE(PG8_SB(0, 0), cB, voffB); PG8_STAGE(PG8_SB(0, 1), cB + hstep, voffB); PG8_STAGE(PG8_SA(0, 0), cA, voffA); PG8_STAGE(PG8_SA(0, 1), cA + hstep, voffA);
        if (wr == 1) PG8_BAR;
        PG8_WAIT_V(2); PG8_BAR;
        PG8_STAGE(PG8_SB(1, 0), cB + kstep, voffB); PG8_STAGE(PG8_SA(1, 0), cA + kstep, voffA); PG8_STAGE(PG8_SB(1, 1), cB + hstep + kstep, voffB);
        PG8_WAIT_V(6); PG8_BAR;
    } else {
        PG8_STAGE(PG8_SB(0, 0), cB, voffB); PG8_STAGE(PG8_SA(0, 0), cA, voffA); PG8_STAGE(PG8_SB(0, 1), cB + hstep, voffB); PG8_STAGE(PG8_SA(0, 1), cA + hstep, voffA);
        if (wr == 1) PG8_BAR;
        PG8_WAIT_V(4); PG8_BAR;
        PG8_STAGE(PG8_SB(1, 0), cB + kstep, voffB); PG8_STAGE(PG8_SA(1, 0), cA + kstep, voffA); PG8_STAGE(PG8_SB(1, 1), cB + hstep + kstep, voffB);
        PG8_WAIT_V(6); PG8_BAR;
    }
    for (;;) {
        const bool has_next = S.next(ui + 1, nxt);
        const char* nA = has_next ? (const char*)g.A + (size_t)nxt.pm * tstep : cA; const char* nB = has_next ? (const char*)g.Bt + (size_t)nxt.pn * tstep : cB;
        for (int t = 0; t < nt; t += 2) {
            const bool last = (t == nt - 2);
            const char* a1 = cA + (size_t)(t + 1) * kstep;
            const char* a2 = last ? nA : cA + (size_t)(t + 2) * kstep; const char* b2 = last ? nB : cB + (size_t)(t + 2) * kstep;
            const char* a3 = a2 + kstep; const char* b3 = b2 + kstep;
            if (last && has_next) S.a_ready(nxt);
            if constexpr (SP2) {
            PG8_LDB(B0, 0, 0); PG8_LDB(B1, 0, 1); PG8_SCHED; PG8_LDA(At, 0, 0); PG8_STAGE(PG8_SA(1, 1), a1 + hstep, voffA);
            PG8_WAIT_V(8); PG8_WAIT_L(0); PG8_BAR; PG8_MMA(0, 0, At, B0); PG8_MMA(0, 1, At, B1); PG8_BAR; PG8_SCHED;
            PG8_LDA(At, 0, 1); PG8_STAGE(PG8_SB(0, 0), b2, voffB); PG8_STAGE(PG8_SB(0, 1), b2 + hstep, voffB); PG8_STAGE(PG8_SA(0, 0), a2, voffA);
            PG8_WAIT_V(8); PG8_WAIT_L(0); PG8_BAR; PG8_MMA(1, 0, At, B0); PG8_MMA(1, 1, At, B1); PG8_BAR; PG8_SCHED;
            PG8_LDB(B0, 1, 0); PG8_LDB(B1, 1, 1); PG8_SCHED; PG8_LDA(At, 1, 0); PG8_STAGE(PG8_SA(0, 1), a2 + hstep, voffA);
            PG8_WAIT_V(8); PG8_WAIT_L(0); PG8_BAR; PG8_MMA(0, 0, At, B0); PG8_MMA(0, 1, At, B1); PG8_BAR; PG8_SCHED;
            PG8_LDA(At, 1, 1); PG8_STAGE(PG8_SB(1, 0), b3, voffB); PG8_STAGE(PG8_SB(1, 1), b3 + hstep, voffB); PG8_STAGE(PG8_SA(1, 0), a3, voffA);
            PG8_WAIT_V(8); PG8_WAIT_L(0); PG8_BAR; PG8_MMA(1, 0, At, B0); PG8_MMA(1, 1, At, B1); PG8_BAR; PG8_SCHED;
            } else {
            PG8_LDB(B0, 0, 0); PG8_SCHED; PG8_LDA(At, 0, 0); PG8_STAGE(PG8_SA(1, 1), a1 + hstep, voffA);
            PG8_WAIT_L(8); PG8_BAR; PG8_WAIT_L(0); PG8_MMA(0, 0, At, B0); PG8_BAR; PG8_SCHED;
            PG8_LDB(B1, 0, 1); PG8_STAGE(PG8_SB(0, 0), b2, voffB);
            PG8_BAR; PG8_WAIT_L(0); PG8_MMA(0, 1, At, B1); PG8_BAR;
            PG8_LDA(At, 0, 1); PG8_STAGE(PG8_SA(0, 0), a2, voffA);
            PG8_BAR; PG8_WAIT_L(0); PG8_MMA(1, 0, At, B0); PG8_BAR; PG8_SCHED;
            PG8_STAGE(PG8_SB(0, 1), b2 + hstep, voffB);
            PG8_WAIT_V(6); PG8_BAR; PG8_MMA(1, 1, At, B1); PG8_BAR;
            PG8_LDB(B0, 1, 0); PG8_SCHED; PG8_LDA(At, 1, 0); PG8_STAGE(PG8_SA(0, 1), a2 + hstep, voffA);
            PG8_WAIT_L(8); PG8_BAR; PG8_WAIT_L(0); PG8_MMA(0, 0, At, B0); PG8_BAR; PG8_SCHED;
            PG8_LDB(B1, 1, 1); PG8_STAGE(PG8_SB(1, 0), b3, voffB);
            PG8_BAR; PG8_WAIT_L(0); PG8_MMA(0, 1, At, B1); PG8_BAR;
            PG8_LDA(At, 1, 1); PG8_STAGE(PG8_SA(1, 0), a3, voffA);
            PG8_BAR; PG8_WAIT_L(0); PG8_MMA(1, 0, At, B0); PG8_BAR; PG8_SCHED;
            PG8_STAGE(PG8_SB(1, 1), b3 + hstep, voffB);
            PG8_WAIT_V(6); PG8_BAR; PG8_MMA(1, 1, At, B1); PG8_BAR;
            }
        }
        if constexpr (ALIGN_EPI) { if (wr == 0) PG8_BAR; }
        if constexpr (!Epi::AFTER_DRAIN) { E(acc, cur, wr, wc, fr, fq); S.done(cur); }
        if (!has_next) break;
#pragma unroll
        for (int a = 0; a < 2; ++a)
#pragma unroll
            for (int b = 0; b < 2; ++b)
#pragma unroll
                for (int m = 0; m < 4; ++m)
#pragma unroll
                    for (int n = 0; n < 2; ++n) acc[a][b][m][n] = (f32x4){0.f, 0.f, 0.f, 0.f};
        cur = nxt; cA = nA; cB = nB; ++ui;
        if constexpr (ALIGN_EPI) { if (wr == 1) PG8_BAR; }
    }
    PG8_WAIT_V(0);
    if constexpr (!ALIGN_EPI) { if (wr == 0) PG8_BAR; }
    PG8_BAR;
    if constexpr (Epi::AFTER_DRAIN) { E.fused(acc, cur, wr, wc, fr, fq, lds, wid, lane); S.done(cur); }
#undef PG8_SA
#undef PG8_SB
#undef PG8_STAGE
#undef PG8_LDA
#undef PG8_LDB
#undef PG8_MMA
#undef PG8_WAIT_V
#undef PG8_WAIT_L
#undef PG8_BAR
#undef PG8_SCHED
}
}
constexpr int DM = 1024, FF = 2816, MP = 32768, MS = 256, MT = MP + MS, SEQ = 2048;
constexpr float ALPHA = 1.4142135623730951f;
constexpr float LOG2E = 1.4426950408889634f;
typedef pg8::bf16_t bf16_t;
typedef pg8::bf16x8 bf16x8;
typedef pg8::f32x4 f32x4;
typedef pg8::u32x4 u32x4;
typedef float f32x2v __attribute__((ext_vector_type(2)));
typedef float f32x16 __attribute__((ext_vector_type(16)));
typedef unsigned u32x2 __attribute__((ext_vector_type(2)));
#define LAS __attribute__((address_space(3)))

constexpr size_t MiB = 1u << 20;
constexpr size_t WS_WIN = 1 * MiB;
constexpr size_t WS_WDN = 45 * MiB;
constexpr size_t WS_WQKVA = 67 * MiB;
constexpr size_t WS_WOA = 73 * MiB;
constexpr size_t WS_WQKVB = 75 * MiB;
constexpr size_t WS_WOB = 78 * MiB;
constexpr size_t WS_MISC = 80 * MiB;
constexpr size_t WS_STA = 82 * MiB;
constexpr size_t WS_STB = 87 * MiB;
constexpr size_t WS_ZB = 92 * MiB;
constexpr size_t WS_KSA = 157 * MiB;
constexpr size_t WS_VTSA = 174 * MiB;
constexpr size_t WS_KSB = 191 * MiB;
constexpr size_t WS_VTSB = 193 * MiB;
constexpr size_t WS_BIG = 195 * MiB;
constexpr size_t BIG_K = (size_t)MT * DM * 2, BIG_VT = BIG_K + (size_t)MP * DM * 2;
constexpr size_t WS_END = 388 * MiB;
constexpr int MC_WIN = 0;
constexpr int MC_QKVA = 4 * 2 * 5632;
constexpr int MC_QKVB = MC_QKVA + 2 * 3072;
constexpr int MC_ROPE = MC_QKVB + 2 * 1536;
constexpr int LDS_BYTES = 131072 + 64;
struct Args { const float* in[16]; float* out; unsigned char* ws; int ph_lo, ph_hi; };
typedef const __attribute__((address_space(4))) Args* ArgsP;
__device__ __forceinline__ ArgsP get_args() { ArgsP p = (ArgsP)__builtin_amdgcn_kernarg_segment_ptr(); asm volatile("" : "+s"(p)); return p; }
constexpr size_t OUT_YP = 0, OUT_YS = (size_t)MP * DM, OUT_AKP = OUT_YS + (size_t)MS * DM, OUT_AVP = OUT_AKP + (size_t)16 * 512 * 1024, OUT_BKP = OUT_AVP + (size_t)16 * 512 * 1024,
                 OUT_BVP = OUT_BKP + (size_t)16 * 128 * 256, OUT_AKS = OUT_BVP + (size_t)16 * 128 * 256, OUT_AVS = OUT_AKS + (size_t)16 * 16 * 1024, OUT_BKS = OUT_AVS + (size_t)16 * 16 * 1024,
                 OUT_BVS = OUT_BKS + (size_t)16 * 16 * 256, OUT_END = OUT_BVS + (size_t)16 * 16 * 256;


__device__ __forceinline__ unsigned f2bf(float f) { unsigned u = __builtin_bit_cast(unsigned, f); return (u + 0x7fffu + ((u >> 16) & 1u)) >> 16; }
__device__ __forceinline__ unsigned pk2(float lo, float hi) { return f2bf(lo) | (f2bf(hi) << 16); }
__device__ __forceinline__ float bfround(float f) { return __builtin_bit_cast(float, f2bf(f) << 16); }
__device__ __forceinline__ u32x2 pk4(f32x4 v) { u32x2 r; r.x = pg8::cvt_pk_bf16(v[0], v[1]); r.y = pg8::cvt_pk_bf16(v[2], v[3]); return r; }
__device__ __forceinline__ float wave_sum(float v) {
#pragma unroll
    for (int o = 1; o < 64; o <<= 1) v += __shfl_xor(v, o);
    return v;
}

namespace pg8 {
__device__ __forceinline__ void row_mean_rstd(const float* st, int row, int fq, float& mean, float& rstd) {
    const f32x4* p = (const f32x4*)(st + (unsigned)row * 32 + 8 * fq);
    const f32x4 a = p[0], b = p[1];
    float s = (a[0] + a[2]) + (b[0] + b[2]), q = (a[1] + a[3]) + (b[1] + b[3]);
    s += __shfl_xor(s, 16); s += __shfl_xor(s, 32); q += __shfl_xor(q, 16); q += __shfl_xor(q, 32);
    mean = s * (1.0f / 1024.0f);
    const float var = fmaxf(q * (1.0f / 1024.0f) - mean * mean, 0.f);
    rstd = 1.0f / sqrtf(var + 1e-5f);
}

#define PG8_EPI_WALK() \
    __device__ __forceinline__ void operator()(const f32x4 (&acc)[2][2][4][2], const Unit& u, int wr, int wc, int fr, int fq) const { \
        const Ctx cx = ctx(); \
        _Pragma("unroll") for (int ai = 0; ai < 2; ++ai) _Pragma("unroll") for (int m = 0; m < 4; ++m) { \
            const int row = u.pm * 256 + ai * 128 + wr * 64 + m * 16 + fr; \
            const f32x4 v[2][2] = {{acc[ai][0][m][0], acc[ai][0][m][1]}, {acc[ai][1][m][0], acc[ai][1][m][1]}}; \
            row_op(cx, u.pm, u.pn, wc, row, fq, v); } }

struct EpiSwiglu {
    static constexpr bool PERM = false, AFTER_DRAIN = false;
    int w, cnt;
    struct Ctx { bf16_t* H; const float* st; const float* c1; const float* c2; };
    __device__ __forceinline__ Ctx ctx() const {
        unsigned char* wsp = get_args()->ws; Ctx c;
        c.H = (bf16_t*)(wsp + WS_BIG); c.st = cnt == 0 ? nullptr : (const float*)(wsp + ((cnt & 1) ? WS_STA : WS_STB));
        c.c1 = (const float*)(wsp + WS_MISC) + MC_WIN + w * 2 * 5632; c.c2 = c.c1 + 5632; return c; }
    __device__ __forceinline__ void row_op(const Ctx& cx, int pm, int pn, int wc, int row, int fq, const f32x4 (&v)[2][2]) const {
        const int sb0 = pn * 256 + wc * 32 + 4 * fq, ff0 = pn * 128 + wc * 16 + 4 * fq;
        const bool fold = (cx.st != nullptr);
        float mean = 0.f, rstd = 1.f;
        if (fold) row_mean_rstd(cx.st, row, fq, mean, rstd);
#pragma unroll
        for (int bj = 0; bj < 2; ++bj) {
            f32x4 g = v[bj][0], up = v[bj][1];
            if (fold) {
                const f32x4 c1g = *(const f32x4*)(cx.c1 + sb0 + bj * 128), c1u = *(const f32x4*)(cx.c1 + sb0 + bj * 128 + 16);
                const f32x4 c2g = *(const f32x4*)(cx.c2 + sb0 + bj * 128), c2u = *(const f32x4*)(cx.c2 + sb0 + bj * 128 + 16);
                g = (g - mean * c1g) * rstd + c2g; up = (up - mean * c1u) * rstd + c2u;
            }
            f32x4 hv;
#pragma unroll
            for (int j = 0; j < 4; ++j) hv[j] = g[j] * __builtin_amdgcn_rcpf(1.0f + __expf(-g[j])) * up[j];
            *(u32x2*)(cx.H + (unsigned)row * FF + ff0 + bj * 64) = pk4(hv);
        }
    }
    PG8_EPI_WALK()
};

struct EpiResid {
    static constexpr bool PERM = false, AFTER_DRAIN = false;
    int cnt; float cs;
    struct Ctx { float* Z; const float* xp; const float* xs; const float* stp; const float* g; const float* b; float* stn; bf16_t* Zb; };
    __device__ __forceinline__ Ctx ctx() const {
        unsigned char* wsp = get_args()->ws; Ctx c;
        c.Z = get_args()->out; c.xp = get_args()->in[0]; c.xs = get_args()->in[1];
        c.stp = cnt == 0 ? nullptr : (const float*)(wsp + ((cnt & 1) ? WS_STA : WS_STB)); c.stn = (float*)(wsp + ((cnt & 1) ? WS_STB : WS_STA));
        const int lni = cnt > 0 ? cnt - 1 : 0;
        c.g = get_args()->in[6] + lni * DM; c.b = get_args()->in[7] + lni * DM; c.Zb = (bf16_t*)(wsp + WS_ZB); return c; }
    __device__ __forceinline__ void row_op(const Ctx& cx, int pm, int pn, int wc, int row, int fq, const f32x4 (&v)[2][2]) const {
        const int col0 = pn * 256 + wc * 32 + 4 * fq;
        const bool first = (cx.stp == nullptr);
        float mean = 0.f, rstd = 1.f;
        if (!first) row_mean_rstd(cx.stp, row, fq, mean, rstd);
        const float* src = first ? (pm < 128 ? cx.xp + (unsigned)row * DM : cx.xs + (unsigned)(row - MP) * DM) : cx.Z + (unsigned)row * DM;
        float s = 0.f, q = 0.f;
#pragma unroll
        for (int bj = 0; bj < 2; ++bj)
#pragma unroll
            for (int n = 0; n < 2; ++n) {
                const int col = col0 + bj * 128 + n * 16;
                f32x4 x = *(const f32x4*)(src + col);
                if (!first) { const f32x4 gv = *(const f32x4*)(cx.g + col), bv = *(const f32x4*)(cx.b + col); x = (x - mean) * rstd * gv + bv; }
                const f32x4 zn = ALPHA * x + cs * v[bj][n];
                *(f32x4*)(cx.Z + (unsigned)row * DM + col) = zn;
                *(u32x2*)(cx.Zb + (unsigned)row * DM + col) = pk4(zn);
                s += (zn[0] + zn[1]) + (zn[2] + zn[3]);
                q += (zn[0] * zn[0] + zn[1] * zn[1]) + (zn[2] * zn[2] + zn[3] * zn[3]);
            }
        s += __shfl_xor(s, 16); s += __shfl_xor(s, 32); q += __shfl_xor(q, 16); q += __shfl_xor(q, 32);
        if (fq == 0) *(f32x2v*)(cx.stn + (unsigned)row * 32 + (pn * 4 + wc) * 2) = (f32x2v){s, q};
    }
    PG8_EPI_WALK()
};

struct EpiQkvA {
    static constexpr bool PERM = false, AFTER_DRAIN = false;
    int cnt;
    struct Ctx { const float* st; const float* c1; const float* c2; bf16_t* Q; bf16_t* Kp; bf16_t* Vtp; bf16_t* Ks; bf16_t* Vts; float* outp; };
    __device__ __forceinline__ Ctx ctx() const {
        unsigned char* wsp = get_args()->ws; Ctx c; c.outp = get_args()->out;
        c.st = (const float*)(wsp + ((cnt & 1) ? WS_STA : WS_STB)); c.c1 = (const float*)(wsp + WS_MISC) + MC_QKVA; c.c2 = c.c1 + 3072;
        c.Q = (bf16_t*)(wsp + WS_BIG); c.Kp = (bf16_t*)(wsp + WS_BIG + BIG_K); c.Vtp = (bf16_t*)(wsp + WS_BIG + BIG_VT); c.Ks = (bf16_t*)(wsp + WS_KSA); c.Vts = (bf16_t*)(wsp + WS_VTSA); return c; }
    __device__ __forceinline__ void row_op(const Ctx& cx, int pm, int pn, int wc, int row, int fq, const f32x4 (&va)[2][2]) const {
        const int typ = pn >> 2, hc0 = (pn & 3) * 256 + wc * 32 + 4 * fq, ns0 = pn * 256 + wc * 32 + 4 * fq;
        const bool sample = (pm == 128);
        float* okp = cx.outp + OUT_AKP; float* ovp = cx.outp + OUT_AVP; float* oks = cx.outp + OUT_AKS; float* ovs = cx.outp + OUT_AVS;
        float mean, rstd; row_mean_rstd(cx.st, row, fq, mean, rstd);
        int b, pos; if (!sample) { b = row >> 11; pos = row & 2047; } else { const int r = row - MP; b = r >> 4; pos = r & 15; }
#pragma unroll
        for (int bj = 0; bj < 2; ++bj)
#pragma unroll
            for (int n = 0; n < 2; ++n) {
                const int hc = hc0 + bj * 128 + n * 16;
                const f32x4 v = (va[bj][n] - mean * *(const f32x4*)(cx.c1 + ns0 + bj * 128 + n * 16)) * rstd + *(const f32x4*)(cx.c2 + ns0 + bj * 128 + n * 16);
                if (typ == 0) { *(u32x2*)(cx.Q + (unsigned)row * DM + hc) = pk4(v); }
                else if (typ == 1) {
                    if (!sample) { *(u32x2*)(cx.Kp + (unsigned)row * DM + hc) = pk4(v); if (pos >= 1536) *(f32x4*)(okp + ((unsigned)(b * 512 + pos - 1536) * DM + hc)) = v; }
                    else { *(u32x2*)(cx.Ks + ((unsigned)(b * 544 + 512 + pos) * DM + hc)) = pk4(v); *(f32x4*)(oks + ((unsigned)(b * 16 + pos) * DM + hc)) = v; }
                } else {
                    const int h = hc >> 6, d = hc & 63;
                    if (!sample) {
                        *(u32x2*)(cx.Vtp + (unsigned)row * DM + hc) = pk4(v);
                        if (pos >= 1536) *(f32x4*)(ovp + ((unsigned)(b * 512 + pos - 1536) * DM + hc)) = v;
                    } else {
                        bf16_t* vt = cx.Vts + ((unsigned)((b * 16 + h) * 64 + d) * 544 + 512 + pos);
#pragma unroll
                        for (int j = 0; j < 4; ++j) vt[(unsigned)j * 544] = (bf16_t)f2bf(v[j]);
                        *(f32x4*)(ovs + ((unsigned)(b * 16 + pos) * DM + hc)) = v;
                    }
                }
            }
    }
    PG8_EPI_WALK()
};

struct EpiQkvB {
    static constexpr bool PERM = false, AFTER_DRAIN = false;
    int cnt;
    struct Ctx { const float* st; const float* c1; const float* c2; const float* rope; bf16_t* Q; bf16_t* Kp; bf16_t* Vtp; bf16_t* Ks; bf16_t* Vts; float* outp; };
    __device__ __forceinline__ Ctx ctx() const {
        unsigned char* wsp = get_args()->ws; Ctx c; c.outp = get_args()->out;
        c.st = (const float*)(wsp + ((cnt & 1) ? WS_STA : WS_STB)); c.c1 = (const float*)(wsp + WS_MISC) + MC_QKVB; c.c2 = c.c1 + 1536; c.rope = (const float*)(wsp + WS_MISC) + MC_ROPE;
        c.Q = (bf16_t*)(wsp + WS_BIG); c.Kp = (bf16_t*)(wsp + WS_BIG + BIG_K); c.Vtp = (bf16_t*)(wsp + WS_BIG + BIG_VT); c.Ks = (bf16_t*)(wsp + WS_KSB); c.Vts = (bf16_t*)(wsp + WS_VTSB); return c; }
    __device__ __forceinline__ void row_op(const Ctx& cx, int pm, int pn, int wc, int row, int fq, const f32x4 (&va)[2][2]) const {
        const int ns0 = pn * 256 + wc * 32 + 4 * fq;
        const bool sample = (pm == 128);
        float* okp = cx.outp + OUT_BKP; float* ovp = cx.outp + OUT_BVP; float* oks = cx.outp + OUT_BKS; float* ovs = cx.outp + OUT_BVS;
        const int dlo = 16 * (wc & 1) + 4 * fq;
        float mean, rstd; row_mean_rstd(cx.st, row, fq, mean, rstd);
        int b, pos; if (!sample) { b = row >> 11; pos = row & 2047; } else { const int r = row - MP; b = r >> 4; pos = r & 15; }
        if (pn < 5) {
            const int rp = sample ? 2048 + pos : pos;
            const f32x4 cs0 = *(const f32x4*)(cx.rope + ((unsigned)rp * 32 + dlo) * 2), cs1 = *(const f32x4*)(cx.rope + ((unsigned)rp * 32 + dlo) * 2 + 4);
            const f32x4 cc = (f32x4){cs0[0], cs0[2], cs1[0], cs1[2]}, ss = (f32x4){cs0[1], cs0[3], cs1[1], cs1[3]};
#pragma unroll
            for (int bj = 0; bj < 2; ++bj) {
                const f32x4 x1 = (va[bj][0] - mean * *(const f32x4*)(cx.c1 + ns0 + bj * 128)) * rstd + *(const f32x4*)(cx.c2 + ns0 + bj * 128);
                const f32x4 x2 = (va[bj][1] - mean * *(const f32x4*)(cx.c1 + ns0 + bj * 128 + 16)) * rstd + *(const f32x4*)(cx.c2 + ns0 + bj * 128 + 16);
                const f32x4 lo = x1 * cc - x2 * ss, hi = x2 * cc + x1 * ss;
                const int hit = bj * 2 + (wc >> 1);
                if (pn < 4) {
                    const int hc = (pn * 4 + hit) * 64 + dlo;
                    *(u32x2*)(cx.Q + (unsigned)row * DM + hc) = pk4(lo); *(u32x2*)(cx.Q + (unsigned)row * DM + hc + 32) = pk4(hi);
                } else {
                    const int kc = hit * 64 + dlo;
                    if (!sample) {
                        *(u32x2*)(cx.Kp + (unsigned)row * 256 + kc) = pk4(lo); *(u32x2*)(cx.Kp + (unsigned)row * 256 + kc + 32) = pk4(hi);
                        if (pos >= 1920) { float* o = okp + ((unsigned)(b * 128 + pos - 1920) * 256 + kc); *(f32x4*)o = lo; *(f32x4*)(o + 32) = hi; }
                    } else {
                        bf16_t* kd = cx.Ks + ((unsigned)(b * 160 + 128 + pos) * 256 + kc); *(u32x2*)kd = pk4(lo); *(u32x2*)(kd + 32) = pk4(hi);
                        float* o = oks + ((unsigned)(b * 16 + pos) * 256 + kc); *(f32x4*)o = lo; *(f32x4*)(o + 32) = hi;
                    }
                }
            }
        } else {
#pragma unroll
            for (int bj = 0; bj < 2; ++bj)
#pragma unroll
                for (int n = 0; n < 2; ++n) {
                    const int hc = bj * 128 + wc * 32 + n * 16 + 4 * fq, kvh = hc >> 6, d = hc & 63;
                    const f32x4 v = (va[bj][n] - mean * *(const f32x4*)(cx.c1 + ns0 + bj * 128 + n * 16)) * rstd + *(const f32x4*)(cx.c2 + ns0 + bj * 128 + n * 16);
                    if (!sample) {
                        *(u32x2*)(cx.Vtp + (unsigned)row * 256 + hc) = pk4(v);
                        if (pos >= 1920) *(f32x4*)(ovp + ((unsigned)(b * 128 + pos - 1920) * 256 + hc)) = v;
                    } else {
                        bf16_t* vt = cx.Vts + ((unsigned)((b * 4 + kvh) * 64 + d) * 160 + 128 + pos);
#pragma unroll
                        for (int j = 0; j < 4; ++j) vt[(unsigned)j * 160] = (bf16_t)f2bf(v[j]);
                        *(f32x4*)(ovs + ((unsigned)(b * 16 + pos) * 256 + hc)) = v;
                    }
                }
        }
    }
    PG8_EPI_WALK()
};

template <class Epi>
__device__ __forceinline__ void small_gemm(PG8_LAS unsigned char* lds, const bf16_t* A, const bf16_t* Bt, int N, int K, const Epi& E) {
    typedef float f32x16 __attribute__((ext_vector_type(16)));
    int tid_o = threadIdx.x; asm volatile("" : "+v"(tid_o));
    const int tid = tid_o, wid = __builtin_amdgcn_readfirstlane(tid >> 6), lane = tid & 63, r = lane & 31, h = lane >> 5;
    const int ntiles = 8 * (N / 64), ks = K / 8;
    PG8_LAS float* part = (PG8_LAS float*)lds;
    const typename Epi::Ctx cx = E.ctx();
    for (int tile = blockIdx.x; tile < ntiles; tile += gridDim.x) {
        const int tm = tile & 7, tn = tile >> 3, pn = tn >> 2, wc = tn & 3;
        const bf16_t* ap = A + (size_t)(MP + tm * 32 + r) * K + wid * ks + 8 * h;
        const bf16_t* bp0 = Bt + (size_t)(pn * 256 + wc * 32 + r) * K + wid * ks + 8 * h;
        const bf16_t* bp1 = bp0 + (size_t)128 * K;
        f32x16 acc0, acc1;
#pragma unroll
        for (int i = 0; i < 16; ++i) { acc0[i] = 0.f; acc1[i] = 0.f; }
#pragma unroll 2
        for (int k0 = 0; k0 < ks; k0 += 16) {
            const bf16x8 a = *(const bf16x8*)(ap + k0), b0 = *(const bf16x8*)(bp0 + k0), b1 = *(const bf16x8*)(bp1 + k0);
            acc0 = __builtin_amdgcn_mfma_f32_32x32x16_bf16(b0, a, acc0, 0, 0, 0);
            acc1 = __builtin_amdgcn_mfma_f32_32x32x16_bf16(b1, a, acc1, 0, 0, 0);
        }
#pragma unroll
        for (int g = 0; g < 4; ++g) {
            *(PG8_LAS f32x4*)(part + ((wid * 2 + 0) * 32 + r) * 36 + 8 * g + 4 * h) = (f32x4){acc0[4 * g], acc0[4 * g + 1], acc0[4 * g + 2], acc0[4 * g + 3]};
            *(PG8_LAS f32x4*)(part + ((wid * 2 + 1) * 32 + r) * 36 + 8 * g + 4 * h) = (f32x4){acc1[4 * g], acc1[4 * g + 1], acc1[4 * g + 2], acc1[4 * g + 3]};
        }
        __syncthreads();
        if (wid < 2) {
            const int fr = lane & 15, fq = lane >> 4, rr = wid * 16 + fr;
            f32x4 v[2][2];
#pragma unroll
            for (int bj = 0; bj < 2; ++bj)
#pragma unroll
                for (int n = 0; n < 2; ++n) {
                    f32x4 s = *(const PG8_LAS f32x4*)(part + ((0 * 2 + bj) * 32 + rr) * 36 + 16 * n + 4 * fq);
#pragma unroll
                    for (int w = 1; w < 8; ++w) s += *(const PG8_LAS f32x4*)(part + ((w * 2 + bj) * 32 + rr) * 36 + 16 * n + 4 * fq);
                    v[bj][n] = s;
                }
            E.row_op(cx, 128, pn, wc, MP + tm * 32 + rr, fq, v);
        }
        __syncthreads();
    }
}
}
template <bool MODE_A, bool MASK>
__device__ __forceinline__ void attn_wave(const bf16_t* Qrow0, int ldq, int nq, const bf16_t* Kb, int ldk, const bf16_t* Vt, int ldv,
                                          int kt0, int npairs, int ktl, int nvalid, int qpos0, const float* tabg, LAS float* tab, float sink, bf16_t* Orow0, int ldo, int lane) {
    const int r = lane & 31, h = lane >> 5;
    const int qr = r < nq ? r : nq - 1;
    if (MODE_A) {
#pragma unroll
        for (int i = 0; i < 5; ++i) { const int idx = lane + 64 * i; if (idx < 257) tab[idx] = tabg[idx] * LOG2E; }
        asm volatile("s_waitcnt vmcnt(0) lgkmcnt(0)" ::: "memory");
    }
    bf16x8 qf[4];
#pragma unroll
    for (int s = 0; s < 4; ++s) qf[s] = *(const bf16x8*)(Qrow0 + (size_t)qr * ldq + 16 * s + 8 * h);
    const int pr = (r & ~12) | ((r & 4) << 1) | ((r & 8) >> 1);
    f32x16 O0, O1;
#pragma unroll
    for (int i = 0; i < 16; ++i) { O0[i] = 0.f; O1[i] = 0.f; }
    float mrun = MODE_A ? -1e30f : sink * LOG2E;
    float l = MODE_A ? 0.f : (h == 0 ? 1.f : 0.f);
    const float SC = 0.125f * LOG2E;
    const bf16_t* kbase = Kb + (size_t)pr * ldk + 8 * h;
    const bf16_t* vbase = Vt + (size_t)r * ldv + 8 * h;
    const int relb0 = qpos0 + r - 8 * h;
#define ATT_LOAD(kt_, kf_, vf_) do { const int kc_ = (kt_) < ktl ? (kt_) : ktl; const int k0_ = kc_ * 32; const bf16_t* kp_ = kbase + (size_t)k0_ * ldk; \
        _Pragma("unroll") for (int s = 0; s < 4; ++s) kf_[s] = *(const bf16x8*)(kp_ + 16 * s); \
        _Pragma("unroll") for (int dt = 0; dt < 2; ++dt) _Pragma("unroll") for (int s = 0; s < 2; ++s) vf_[dt][s] = *(const bf16x8*)(vbase + (size_t)(dt * 32) * ldv + k0_ + 16 * s); } while (0)
#define ATT_COMPUTE(kt_, kf_, vf_) do { const int k0 = (kt_) * 32; \
        f32x16 S; _Pragma("unroll") for (int i = 0; i < 16; ++i) S[i] = 0.f; \
        _Pragma("unroll") for (int s = 0; s < 4; ++s) S = __builtin_amdgcn_mfma_f32_32x32x16_bf16(kf_[s], qf[s], S, 0, 0, 0); \
        float t[16]; const int relt = relb0 - k0; const int keyb = k0 + 8 * h; \
        float mx = -1e30f; \
        _Pragma("unroll") for (int i = 0; i < 16; ++i) { \
            float v; \
            if (MODE_A) { int rel = relt - (16 * (i >> 3) + (i & 7)); rel = rel < -128 ? -128 : (rel > 128 ? 128 : rel); v = S[i] * SC + tab[rel + 128]; } \
            else v = S[i] * SC; \
            if (MASK) { if (keyb + 16 * (i >> 3) + (i & 7) >= nvalid) v = -1e30f; } \
            t[i] = v; mx = fmaxf(mx, v); } \
        mx = fmaxf(mx, __shfl_xor(mx, 32)); \
        const float mnew = fmaxf(mrun, mx); const float alpha = __builtin_amdgcn_exp2f(mrun - mnew); mrun = mnew; \
        float ps = 0.f; \
        _Pragma("unroll") for (int i = 0; i < 16; ++i) { t[i] = __builtin_amdgcn_exp2f(t[i] - mnew); ps += t[i]; } \
        l = l * alpha + ps; \
        _Pragma("unroll") for (int i = 0; i < 16; ++i) { O0[i] *= alpha; O1[i] *= alpha; } \
        bf16x8 pf[2]; \
        _Pragma("unroll") for (int s = 0; s < 2; ++s) { u32x4 w; w.x = pg8::cvt_pk_bf16(t[8 * s + 0], t[8 * s + 1]); w.y = pg8::cvt_pk_bf16(t[8 * s + 2], t[8 * s + 3]); \
            w.z = pg8::cvt_pk_bf16(t[8 * s + 4], t[8 * s + 5]); w.w = pg8::cvt_pk_bf16(t[8 * s + 6], t[8 * s + 7]); pf[s] = __builtin_bit_cast(bf16x8, w); } \
        O0 = __builtin_amdgcn_mfma_f32_32x32x16_bf16(vf_[0][0], pf[0], O0, 0, 0, 0); O0 = __builtin_amdgcn_mfma_f32_32x32x16_bf16(vf_[0][1], pf[1], O0, 0, 0, 0); \
        O1 = __builtin_amdgcn_mfma_f32_32x32x16_bf16(vf_[1][0], pf[0], O1, 0, 0, 0); O1 = __builtin_amdgcn_mfma_f32_32x32x16_bf16(vf_[1][1], pf[1], O1, 0, 0, 0); } while (0)
    bf16x8 kfa[4], vfa[2][2], kfb[4], vfb[2][2];
    ATT_LOAD(kt0, kfa, vfa);
#pragma unroll 1
    for (int p = 0; p < npairs; ++p) {
        const int kt = kt0 + 2 * p;
        ATT_LOAD(kt + 1, kfb, vfb);
        ATT_COMPUTE(kt, kfa, vfa);
        ATT_LOAD(kt + 2, kfa, vfa);
        ATT_COMPUTE(kt + 1, kfb, vfb);
    }
#undef ATT_LOAD
#undef ATT_COMPUTE
    l += __shfl_xor(l, 32);
    const float inv = 1.0f / l;
    if (r < nq) {
        bf16_t* op = Orow0 + (size_t)r * ldo + 4 * h;
#pragma unroll
        for (int g = 0; g < 4; ++g) {
            f32x4 a = (f32x4){O0[4 * g], O0[4 * g + 1], O0[4 * g + 2], O0[4 * g + 3]} * inv;
            f32x4 b = (f32x4){O1[4 * g], O1[4 * g + 1], O1[4 * g + 2], O1[4 * g + 3]} * inv;
            *(u32x2*)(op + 8 * g) = pk4(a);
            *(u32x2*)(op + 32 + 8 * g) = pk4(b);
        }
    }
}

struct AttState { f32x16 O0, O1; float mrun, l; };
template <bool MODE_A>
__device__ __forceinline__ void att_tile_lds(AttState& st, const bf16x8 (&qf)[4], LAS unsigned char* slot, int tile, int relt, LAS float* tab, int pr, int r, int h) {
    const float SC = 0.125f * LOG2E;
    const int key = tile * 32 + pr;
    LAS unsigned char* krow = slot + key * 128; const int ksw = (key >> 1) & 7;
    bf16x8 kf[4], vf[2][2];
#pragma unroll
    for (int s = 0; s < 4; ++s) kf[s] = *(LAS bf16x8*)(krow + (((2 * s + h) ^ ksw) << 4));
#pragma unroll
    for (int dt = 0; dt < 2; ++dt) { const int d = dt * 32 + r; LAS unsigned char* vrow = slot + 8192 + d * 128; const int vsw = (d >> 1) & 7;
#pragma unroll
        for (int s = 0; s < 2; ++s) vf[dt][s] = *(LAS bf16x8*)(vrow + (((tile * 4 + 2 * s + h) ^ vsw) << 4)); }
    f32x16 S;
#pragma unroll
    for (int i = 0; i < 16; ++i) S[i] = 0.f;
#pragma unroll
    for (int s = 0; s < 4; ++s) S = __builtin_amdgcn_mfma_f32_32x32x16_bf16(kf[s], qf[s], S, 0, 0, 0);
    float t[16]; float mx = -1e30f;
#pragma unroll
    for (int i = 0; i < 16; ++i) {
        float v;
        if (MODE_A) { int rel = relt - (16 * (i >> 3) + (i & 7)); rel = rel < -128 ? -128 : (rel > 128 ? 128 : rel); v = S[i] * SC + tab[rel + 128]; }
        else v = S[i] * SC;
        t[i] = v; mx = fmaxf(mx, v);
    }
    mx = fmaxf(mx, __shfl_xor(mx, 32));
    const float mnew = fmaxf(st.mrun, mx); const float alpha = __builtin_amdgcn_exp2f(st.mrun - mnew); st.mrun = mnew;
    float ps = 0.f;
#pragma unroll
    for (int i = 0; i < 16; ++i) { t[i] = __builtin_amdgcn_exp2f(t[i] - mnew); ps += t[i]; }
    st.l = st.l * alpha + ps;
#pragma unroll
    for (int i = 0; i < 16; ++i) { st.O0[i] *= alpha; st.O1[i] *= alpha; }
    bf16x8 pf[2];
#pragma unroll
    for (int s = 0; s < 2; ++s) { u32x4 w; w.x = pg8::cvt_pk_bf16(t[8 * s + 0], t[8 * s + 1]); w.y = pg8::cvt_pk_bf16(t[8 * s + 2], t[8 * s + 3]);
        w.z = pg8::cvt_pk_bf16(t[8 * s + 4], t[8 * s + 5]); w.w = pg8::cvt_pk_bf16(t[8 * s + 6], t[8 * s + 7]); pf[s] = __builtin_bit_cast(bf16x8, w); }
    st.O0 = __builtin_amdgcn_mfma_f32_32x32x16_bf16(vf[0][0], pf[0], st.O0, 0, 0, 0); st.O0 = __builtin_amdgcn_mfma_f32_32x32x16_bf16(vf[0][1], pf[1], st.O0, 0, 0, 0);
    st.O1 = __builtin_amdgcn_mfma_f32_32x32x16_bf16(vf[1][0], pf[0], st.O1, 0, 0, 0); st.O1 = __builtin_amdgcn_mfma_f32_32x32x16_bf16(vf[1][1], pf[1], st.O1, 0, 0, 0);
}
__device__ __forceinline__ void att_chunk_write(LAS unsigned char* slot, const u32x4& kreg, const u32x4& vreg, int tid) {
    const int key = tid >> 3, c16 = tid & 7;
    *(LAS u32x4*)(slot + key * 128 + ((c16 ^ ((key >> 1) & 7)) << 4)) = kreg;
    const unsigned vw[4] = {vreg.x, vreg.y, vreg.z, vreg.w};
#pragma unroll
    for (int j = 0; j < 8; ++j) { const int d = c16 * 8 + j;
        *(LAS unsigned short*)(slot + 8192 + d * 128 + ((((key >> 3) ^ ((d >> 1) & 7)) << 4)) + (key & 7) * 2) = (unsigned short)((j & 1) ? (vw[j >> 1] >> 16) : (vw[j >> 1] & 0xffffu)); }
}
__device__ __forceinline__ void att_store_o(const AttState& st, bf16_t* Orow0, int ldo, int r, int h) {
    float l = st.l; l += __shfl_xor(l, 32);
    const float inv = 1.0f / l;
    bf16_t* op = Orow0 + (size_t)r * ldo + 4 * h;
#pragma unroll
    for (int g = 0; g < 4; ++g) {
        f32x4 a = (f32x4){st.O0[4 * g], st.O0[4 * g + 1], st.O0[4 * g + 2], st.O0[4 * g + 3]} * inv;
        f32x4 b = (f32x4){st.O1[4 * g], st.O1[4 * g + 1], st.O1[4 * g + 2], st.O1[4 * g + 3]} * inv;
        *(u32x2*)(op + 8 * g) = pk4(a);
        *(u32x2*)(op + 32 + 8 * g) = pk4(b);
    }
}
__device__ __forceinline__ void attn_block_a(LAS unsigned char* lds, const bf16_t* Q, const bf16_t* K, const bf16_t* V, bf16_t* O, const float* tabg, int b, int hd, int c0, int tid, int wave, int lane) {
    const int r = lane & 31, h = lane >> 5, j = wave >> 1, half = wave & 1;
    const int pr = (r & ~12) | ((r & 4) << 1) | ((r & 8) >> 1);
    LAS float* tab = (LAS float*)(lds + 6 * 16384 + wave * 2048);
    __syncthreads();
#pragma unroll
    for (int i = 0; i < 5; ++i) { const int idx = lane + 64 * i; if (idx < 257) tab[idx] = tabg[idx] * LOG2E; }
    const size_t rowb = (size_t)b * 2048;
    const bf16_t* kg = K + (rowb + (tid >> 3)) * DM + hd * 64 + (tid & 7) * 8;
    const bf16_t* vg = V + (rowb + (tid >> 3)) * DM + hd * 64 + (tid & 7) * 8;
#pragma unroll
    for (int i = 0; i < 4; ++i) { const int kc = c0 - 8 + i;
        if (kc >= 0) { const u32x4 kr = *(const u32x4*)(kg + (size_t)kc * 64 * DM), vr = *(const u32x4*)(vg + (size_t)kc * 64 * DM); att_chunk_write(lds + ((kc + 18) % 6) * 16384, kr, vr, tid); } }
    const size_t qrow = rowb + (size_t)(c0 + j) * 64 + half * 32;
    bf16x8 qf[4];
#pragma unroll
    for (int s = 0; s < 4; ++s) qf[s] = *(const bf16x8*)(Q + (qrow + r) * DM + hd * 64 + 16 * s + 8 * h);
    AttState st;
#pragma unroll
    for (int i = 0; i < 16; ++i) { st.O0[i] = 0.f; st.O1[i] = 0.f; }
    st.mrun = -1e30f; st.l = 0.f;
    asm volatile("s_waitcnt vmcnt(0) lgkmcnt(0)" ::: "memory");
    __syncthreads();
#pragma unroll 1
    for (int p = 0; p < 9; ++p) {
        const int kn = c0 - 4 + p;
        const bool ld = (kn >= 0) && (p < 8);
        u32x4 kr = (u32x4){0u, 0u, 0u, 0u}, vr = (u32x4){0u, 0u, 0u, 0u};
        if (ld) { kr = *(const u32x4*)(kg + (size_t)kn * 64 * DM); vr = *(const u32x4*)(vg + (size_t)kn * 64 * DM); }
        const int kc = c0 + j - 8 + p;
        if (kc >= 0) {
            LAS unsigned char* slot = lds + ((kc + 18) % 6) * 16384;
            const int relt0 = (c0 + j - kc) * 64 + half * 32 + r - 8 * h;
            att_tile_lds<true>(st, qf, slot, 0, relt0, tab, pr, r, h);
            att_tile_lds<true>(st, qf, slot, 1, relt0 - 32, tab, pr, r, h);
        }
        if (ld) att_chunk_write(lds + ((kn + 18) % 6) * 16384, kr, vr, tid);
        asm volatile("s_waitcnt lgkmcnt(0)" ::: "memory");
        __syncthreads();
    }
    att_store_o(st, O + qrow * DM + hd * 64, DM, r, h);
}
__device__ __forceinline__ void attn_block_b(LAS unsigned char* lds, const bf16_t* Q, const bf16_t* K, const bf16_t* V, bf16_t* O, const float* sinks_, int b, int kvh, int c, int tid, int wave, int lane) {
    const int r = lane & 31, h = lane >> 5, qh = kvh * 4 + (wave >> 1), half = wave & 1;
    const int pr = (r & ~12) | ((r & 4) << 1) | ((r & 8) >> 1);
    const size_t rowb = (size_t)b * 2048;
    const bf16_t* kg = K + (rowb + (tid >> 3)) * 256 + kvh * 64 + (tid & 7) * 8;
    const bf16_t* vg = V + (rowb + (tid >> 3)) * 256 + kvh * 64 + (tid & 7) * 8;
    u32x4 kr[3], vr[3];
#pragma unroll
    for (int i = 0; i < 3; ++i) { const int kc = c - 2 + i; kr[i] = (u32x4){0u, 0u, 0u, 0u}; vr[i] = kr[i];
        if (kc >= 0) { kr[i] = *(const u32x4*)(kg + (size_t)kc * 64 * 256); vr[i] = *(const u32x4*)(vg + (size_t)kc * 64 * 256); } }
    const size_t qrow = rowb + (size_t)c * 64 + half * 32;
    bf16x8 qf[4];
#pragma unroll
    for (int s = 0; s < 4; ++s) qf[s] = *(const bf16x8*)(Q + (qrow + r) * DM + qh * 64 + 16 * s + 8 * h);
    const float sink = sinks_[qh];
    __syncthreads();
#pragma unroll
    for (int i = 0; i < 3; ++i) if (c - 2 + i >= 0) att_chunk_write(lds + i * 16384, kr[i], vr[i], tid);
    AttState st;
#pragma unroll
    for (int i = 0; i < 16; ++i) { st.O0[i] = 0.f; st.O1[i] = 0.f; }
    st.mrun = sink * LOG2E; st.l = (h == 0) ? 1.f : 0.f;
    asm volatile("s_waitcnt lgkmcnt(0)" ::: "memory");
    __syncthreads();
#pragma unroll 1
    for (int i = 0; i < 3; ++i) {
        if (c - 2 + i >= 0) {
            att_tile_lds<false>(st, qf, lds + i * 16384, 0, 0, nullptr, pr, r, h);
            att_tile_lds<false>(st, qf, lds + i * 16384, 1, 0, nullptr, pr, r, h);
        }
    }
    att_store_o(st, O + qrow * DM + qh * 64, DM, r, h);
}

__device__ __forceinline__ void prep_weight_item(const float* W, int K, int N, int cb0, int cb1, const float* g, const float* b, bf16_t* Bt, int row0, float* c1, float* c2,
                                                 LAS float* scr, int lane, int kbeg, int kend) {
    const int c = lane & 31, col = c < 16 ? cb0 + c : cb1 + c - 16;
    float a1 = 0.f, a2 = 0.f;
    for (int k0 = kbeg; k0 < kend; k0 += 64) {
#pragma unroll 8
        for (int i = 0; i < 32; ++i) {
            const int kk = 2 * i + (lane >> 5);
            const float w = W[(size_t)(k0 + kk) * N + col];
            float v = w;
            if (g) { v = w * g[k0 + kk]; a2 += w * b[k0 + kk]; }
            v = bfround(v); a1 += v;
            scr[kk * 33 + c] = v;
        }
        asm volatile("s_waitcnt lgkmcnt(0)" ::: "memory");
        const int c8 = lane & 7;
#pragma unroll
        for (int j = 0; j < 4; ++j) {
            const int n = (lane >> 3) + 8 * j; const LAS float* s = scr + (8 * c8) * 33 + n;
            u32x4 o;
            o.x = (__builtin_bit_cast(unsigned, s[0 * 33]) >> 16) | (__builtin_bit_cast(unsigned, s[1 * 33]) & 0xffff0000u);
            o.y = (__builtin_bit_cast(unsigned, s[2 * 33]) >> 16) | (__builtin_bit_cast(unsigned, s[3 * 33]) & 0xffff0000u);
            o.z = (__builtin_bit_cast(unsigned, s[4 * 33]) >> 16) | (__builtin_bit_cast(unsigned, s[5 * 33]) & 0xffff0000u);
            o.w = (__builtin_bit_cast(unsigned, s[6 * 33]) >> 16) | (__builtin_bit_cast(unsigned, s[7 * 33]) & 0xffff0000u);
            *(u32x4*)(Bt + (size_t)(row0 + n) * K + k0 + 8 * c8) = o;
        }
        asm volatile("s_waitcnt lgkmcnt(0)" ::: "memory");
    }
    a1 += __shfl_xor(a1, 32); a2 += __shfl_xor(a2, 32);
    if (c1 && lane < 32) { atomicAdd(c1 + row0 + c, a1); atomicAdd(c2 + row0 + c, a2); }
}
constexpr int N_PHASES = 16;
#include <cstdint>
#include <cstdlib>
#include <vector>

#include <cstdint>
#include <cstdlib>
#include <vector>

#define XB_TMO      128
#define XB_XCNT(j)  (256  + 64 * (j))
#define XB_XSUB(j)  (1280 + 64 * (j))
#define XB_XGEN(j)  (2304 + 64 * (j))
#define XB_TOP      3328
#define XB_TOPGEN   3392
#define XCD_BAR_WORDS 3456
#define XB_SPIN_CAP (1u << 18)

__device__ __forceinline__ unsigned xb_ld(unsigned* p)              { return __hip_atomic_load(p, __ATOMIC_RELAXED, __HIP_MEMORY_SCOPE_AGENT); }
__device__ __forceinline__ unsigned xb_add(unsigned* p, unsigned v) { return __hip_atomic_fetch_add(p, v, __ATOMIC_RELAXED, __HIP_MEMORY_SCOPE_AGENT); }
__device__ __forceinline__ unsigned xb_xcc_id() { return (unsigned)__builtin_amdgcn_s_getreg((3 << 11) | 20) & 0xFu; }
#define XB_SPIN(cond, bar) do { unsigned _sp = 0; while (cond) { __builtin_amdgcn_s_sleep(1); \
    if ((++_sp & 255u) == 0u) { if (xb_ld(&(bar)[XB_TMO])) break; if (_sp > XB_SPIN_CAP) { atomicAdd(&(bar)[XB_TMO], 1u); break; } } } } while (0)

struct XcdBarrier {
    unsigned* bar; unsigned x;
    volatile LAS unsigned* st;
};

__device__ __forceinline__ XcdBarrier xcd_barrier_post(unsigned* bar, volatile LAS unsigned* st) {
    XcdBarrier b; b.bar = bar; b.x = xb_xcc_id(); b.st = st;
    if (threadIdx.x == 0) (void)xb_add(&bar[XB_XCNT(b.x)], 1u);
    return b;
}
__device__ __forceinline__ void xcd_barrier_complete(unsigned* bar, unsigned x, unsigned& nloc, unsigned& nx) {
    const unsigned G = gridDim.x * gridDim.y * gridDim.z;
    unsigned sum, cnt, mine, sp = 0u;
    for (;;) {
        sum = 0u; cnt = 0u; mine = 0u;
#pragma unroll
        for (unsigned j = 0; j < 16; ++j) { const unsigned c = xb_ld(&bar[XB_XCNT(j)]); sum += c; cnt += (c > 0u) ? 1u : 0u; mine = (j == x) ? c : mine; }
        if (sum == G) break;
        __builtin_amdgcn_s_sleep(1);
        if ((++sp & 255u) == 0u) { if (xb_ld(&bar[XB_TMO])) break; if (sp > XB_SPIN_CAP) { atomicAdd(&bar[XB_TMO], 1u); break; } }
    }
    nloc = mine > 0u ? mine : 1u; nx = cnt > 0u ? cnt : 1u;
}

__device__ __forceinline__ void xcd_barrier(const XcdBarrier& b) {
    asm volatile("s_waitcnt vmcnt(0)" ::: "memory");
    __syncthreads();
    if (threadIdx.x == 0) {
        unsigned* bar = b.bar;
        __builtin_amdgcn_s_waitcnt(0);
        unsigned nloc = b.st[0], nx = b.st[1];
        if (nloc == 0u) { xcd_barrier_complete(bar, b.x, nloc, nx); b.st[0] = nloc; b.st[1] = nx; }
        const unsigned old = xb_add(&bar[XB_XSUB(b.x)], 1u);
        const unsigned gen = old / nloc;
        if (old + 1u == (gen + 1u) * nloc) {
            __builtin_amdgcn_fence(__ATOMIC_RELEASE, "agent");
            asm volatile("s_waitcnt vmcnt(0)" ::: "memory");
            const unsigned og = xb_add(&bar[XB_TOP], 1u);
            const unsigned tg = og / nx;
            if (og + 1u == (tg + 1u) * nx) xb_add(&bar[XB_TOPGEN], 1u);
            else XB_SPIN(xb_ld(&bar[XB_TOPGEN]) == tg, bar);
            __builtin_amdgcn_fence(__ATOMIC_ACQUIRE, "agent");
            xb_add(&bar[XB_XGEN(b.x)], 1u);
            asm volatile("s_waitcnt vmcnt(0)" ::: "memory");
        } else {
            XB_SPIN(xb_ld(&bar[XB_XGEN(b.x)]) == gen, bar);
            __builtin_amdgcn_fence(__ATOMIC_ACQUIRE, "agent");
            asm volatile("s_waitcnt vmcnt(0)" ::: "memory");
        }
    }
    __syncthreads();
}


__device__ const double ROPE_INV[32] = {1.0, 0.7498942093324559, 0.5623413251903491, 0.4216965034285822, 0.31622776601683794, 0.23713737056616552, 0.1778279410038923, 0.1333521432163324, 0.1,
    0.07498942093324558, 0.05623413251903491, 0.042169650342858224, 0.03162277660168379, 0.023713737056616554, 0.01778279410038923, 0.01333521432163324, 0.01, 0.007498942093324558,
    0.005623413251903491, 0.004216965034285823, 0.0031622776601683794, 0.0023713737056616554, 0.0017782794100389228, 0.001333521432163324, 0.001, 0.0007498942093324559, 0.0005623413251903491,
    0.00042169650342858224, 0.00031622776601683794, 0.00023713737056616554, 0.00017782794100389227, 0.0001333521432163324};


#define AIN(i) ((const float*)get_args()->in[i])
#define x_p AIN(0)
#define x_s AIN(1)
#define cak AIN(2)
#define cav AIN(3)
#define cbk AIN(4)
#define cbv AIN(5)
#define ln_g AIN(6)
#define ln_b AIN(7)
#define w_in AIN(8)
#define w_dn AIN(9)
#define w_qkva AIN(10)
#define w_oa AIN(11)
#define relb AIN(12)
#define w_qkvb AIN(13)
#define w_ob AIN(14)
#define sinks AIN(15)
#define out ((float*)get_args()->out)
#define WSP ((unsigned char*)get_args()->ws)
#define Win ((bf16_t*)(WSP + WS_WIN))
#define Wdn ((bf16_t*)(WSP + WS_WDN))
#define Wqkva ((bf16_t*)(WSP + WS_WQKVA))
#define Woa ((bf16_t*)(WSP + WS_WOA))
#define Wqkvb ((bf16_t*)(WSP + WS_WQKVB))
#define Wob ((bf16_t*)(WSP + WS_WOB))
#define misc ((float*)(WSP + WS_MISC))
#define stA ((float*)(WSP + WS_STA))
#define stB ((float*)(WSP + WS_STB))
#define Zb ((bf16_t*)(WSP + WS_ZB))
#define Ksa ((bf16_t*)(WSP + WS_KSA))
#define Vtsa ((bf16_t*)(WSP + WS_VTSA))
#define Ksb ((bf16_t*)(WSP + WS_KSB))
#define Vtsb ((bf16_t*)(WSP + WS_VTSB))
#define Hb ((bf16_t*)(WSP + WS_BIG))
#define Qb ((bf16_t*)(WSP + WS_BIG))
#define Kpb ((bf16_t*)(WSP + WS_BIG + BIG_K))
#define Vtpb ((bf16_t*)(WSP + WS_BIG + BIG_VT))
#define rope (misc + MC_ROPE)
__global__ void __launch_bounds__(512, 2) fwd_kernel(Args args) {
    extern __shared__ __attribute__((aligned(16))) unsigned char lds_raw[];
    LAS unsigned char* lds = (LAS unsigned char*)lds_raw;
    cg::grid_group grid = cg::this_grid();
    const int tid = threadIdx.x, lane = tid & 63, wave = __builtin_amdgcn_readfirstlane(tid >> 6);
    const int G = gridDim.x, bid = blockIdx.x;
    if (tid < 4) ((LAS unsigned*)(lds + 131072))[tid] = 0u;
    __syncthreads();
    const XcdBarrier xbar = xcd_barrier_post((unsigned*)WSP, (volatile LAS unsigned*)(lds + 131072));
    const int lo = args.ph_lo, hi = args.ph_hi;
#define IN(k) (lo <= (k) && (k) < hi)
#ifndef PROBE_DUP
#define PROBE_DUP 0
#endif
#define SEAM(k) do { if (IN(k) && IN((k) + 1)) { if ((k) == 0) grid.sync(); else { xcd_barrier(xbar); if (PROBE_DUP & 1) xcd_barrier(xbar); } } } while (0)

    if (IN(0))
#pragma unroll 1
    for (int rep = 0; rep < ((PROBE_DUP & 8) ? 2 : 1); ++rep) {
        const int gw = bid * 8 + wave, NGW = G * 8;
        const long gt = (long)bid * 512 + tid, NGT = (long)G * 512;
        LAS float* scr = (LAS float*)(lds + wave * 16384);
        for (int it = gw; it < 5056; it += NGW) {
            int r = it;
            if (r < 2816) { const int w = r / 704, grp = (r % 704) >> 2, kc = r & 3;
                const int lnidx = (w == 1) ? 1 : (w == 2) ? 2 : 4;
                const float* g = (w == 0) ? nullptr : ln_g + lnidx * DM; const float* b = (w == 0) ? nullptr : ln_b + lnidx * DM;
                float* c1 = (w == 0) ? nullptr : misc + MC_WIN + w * 2 * 5632;
                prep_weight_item(w_in + (size_t)w * DM * 2 * FF, DM, 2 * FF, grp * 16, FF + grp * 16, g, b, Win + (size_t)w * 2 * FF * DM, grp * 32, c1, c1 + 5632, scr, lane, kc * 256, kc * 256 + 256);
                continue; }
            r -= 2816;
            if (r < 1408) { const int w = r / 352, grp = (r % 352) / 11, kc = r % 11;
                prep_weight_item(w_dn + (size_t)w * FF * DM, FF, DM, grp * 32, grp * 32 + 16, nullptr, nullptr, Wdn + (size_t)w * DM * FF, grp * 32, nullptr, nullptr, scr, lane, kc * 256, kc * 256 + 256);
                continue; }
            r -= 1408;
            const int kc = r & 3; r >>= 2;
            if (r < 96) { prep_weight_item(w_qkva, DM, 3072, r * 32, r * 32 + 16, ln_g + 0 * DM, ln_b + 0 * DM, Wqkva, r * 32, misc + MC_QKVA, misc + MC_QKVA + 3072, scr, lane, kc * 256, kc * 256 + 256); continue; }
            r -= 96;
            if (r < 32) { prep_weight_item(w_oa, DM, DM, r * 32, r * 32 + 16, nullptr, nullptr, Woa, r * 32, nullptr, nullptr, scr, lane, kc * 256, kc * 256 + 256); continue; }
            r -= 32;
            if (r < 48) { int cb0, cb1; if (r < 40) { cb0 = (r >> 1) * 64 + 16 * (r & 1); cb1 = cb0 + 32; } else { cb0 = r * 32; cb1 = cb0 + 16; }
                prep_weight_item(w_qkvb, DM, 1536, cb0, cb1, ln_g + 3 * DM, ln_b + 3 * DM, Wqkvb, r * 32, misc + MC_QKVB, misc + MC_QKVB + 1536, scr, lane, kc * 256, kc * 256 + 256); continue; }
            r -= 48;
            prep_weight_item(w_ob, DM, DM, r * 32, r * 32 + 16, nullptr, nullptr, Wob, r * 32, nullptr, nullptr, scr, lane, kc * 256, kc * 256 + 256);
        }
        for (long i = gt; i < (long)MT * 128; i += NGT) {
            const int row = (int)(i >> 7), c8 = (int)(i & 127);
            const float* src = (row < MP ? x_p + (size_t)row * DM : x_s + (size_t)(row - MP) * DM) + c8 * 8;
            const f32x4 a = *(const f32x4*)src, b = *(const f32x4*)(src + 4);
            u32x4 o; o.x = pk2(a[0], a[1]); o.y = pk2(a[2], a[3]); o.z = pk2(b[0], b[1]); o.w = pk2(b[2], b[3]);
            *(u32x4*)(Zb + (size_t)row * DM + c8 * 8) = o;
        }
        for (long i = gt; i < 2064 * 32; i += NGT) {
            const int pos = (int)(i >> 5), fi = (int)(i & 31);
            const double a = (double)pos * ROPE_INV[fi];
            const double n = __builtin_floor(a * 0.15915494309189535);
            const float rr = (float)__builtin_fma(-n, 6.283185307179586, a);
            rope[2 * i] = cosf(rr); rope[2 * i + 1] = sinf(rr);
        }
        for (long i = gt; i < 16L * 544 * 128; i += NGT) {
            const int c8 = (int)(i & 127); const int bp = (int)(i >> 7); const int b = bp / 544, pos = bp % 544;
            u32x4 o = (u32x4){0u, 0u, 0u, 0u};
            if (pos < 512) { const float* src = cak + ((size_t)(b * 512 + pos) * DM + c8 * 8); const f32x4 a = *(const f32x4*)src, c = *(const f32x4*)(src + 4);
                o.x = pk2(a[0], a[1]); o.y = pk2(a[2], a[3]); o.z = pk2(c[0], c[1]); o.w = pk2(c[2], c[3]); }
            if (pos < 512 || pos >= 528) *(u32x4*)(Ksa + (size_t)bp * DM + c8 * 8) = o;
        }
        for (long i = gt; i < 16L * 16 * 68 * 64; i += NGT) {
            const int d = (int)(i & 63); long t = i >> 6; const int p8 = (int)(t % 68); t /= 68; const int h = (int)(t & 15), b = (int)(t >> 4);
            u32x4 o = (u32x4){0u, 0u, 0u, 0u};
            if (p8 < 64) { float v[8];
#pragma unroll
                for (int e = 0; e < 8; ++e) v[e] = cav[((size_t)(b * 512 + p8 * 8 + e) * 16 + h) * 64 + d];
                o.x = pk2(v[0], v[1]); o.y = pk2(v[2], v[3]); o.z = pk2(v[4], v[5]); o.w = pk2(v[6], v[7]); }
            if (p8 < 64 || p8 >= 66) *(u32x4*)(Vtsa + ((size_t)((b * 16 + h) * 64 + d) * 544 + p8 * 8)) = o;
        }
        for (long i = gt; i < 16L * 160 * 32; i += NGT) {
            const int c8 = (int)(i & 31); const int bp = (int)(i >> 5); const int b = bp / 160, pos = bp % 160;
            u32x4 o = (u32x4){0u, 0u, 0u, 0u};
            if (pos < 128) { const float* src = cbk + ((size_t)(b * 128 + pos) * 256 + c8 * 8); const f32x4 a = *(const f32x4*)src, c = *(const f32x4*)(src + 4);
                o.x = pk2(a[0], a[1]); o.y = pk2(a[2], a[3]); o.z = pk2(c[0], c[1]); o.w = pk2(c[2], c[3]); }
            if (pos < 128 || pos >= 144) *(u32x4*)(Ksb + (size_t)bp * 256 + c8 * 8) = o;
        }
        for (long i = gt; i < 16L * 4 * 20 * 64; i += NGT) {
            const int d = (int)(i & 63); long t = i >> 6; const int p8 = (int)(t % 20); t /= 20; const int h = (int)(t & 3), b = (int)(t >> 2);
            u32x4 o = (u32x4){0u, 0u, 0u, 0u};
            if (p8 < 16) { float v[8];
#pragma unroll
                for (int e = 0; e < 8; ++e) v[e] = cbv[((size_t)(b * 128 + p8 * 8 + e) * 4 + h) * 64 + d];
                o.x = pk2(v[0], v[1]); o.y = pk2(v[2], v[3]); o.z = pk2(v[4], v[5]); o.w = pk2(v[6], v[7]); }
            if (p8 < 16 || p8 >= 18) *(u32x4*)(Vtsb + ((size_t)((b * 4 + h) * 64 + d) * 160 + p8 * 8)) = o;
        }
    }
    SEAM(0);

#pragma unroll 1
    for (int s = 0; s < 14; ++s) {
        if (IN(s + 1)) {
            const int L = s / 7, k = s % 7;
            const int c = 3 * L + (k > 1) + (k > 4);
            if (false) {}
#ifndef NO_SW
            else if (k == 0 || k == 5)
#pragma unroll 1
            for (int rep = 0; rep < ((PROBE_DUP & 2) ? 2 : 1); ++rep) {
                const int w = 2 * L + (k == 5);
                pg8::Gemm g{Zb, Win + (size_t)w * 2 * FF * DM, MP, 2 * FF, DM}; pg8::StaticOrder S; S.init(MP, 2 * FF, G, bid);
                pg8::EpiSwiglu E{w, c};
                pg8::small_gemm<pg8::EpiSwiglu>(lds, g.A, g.Bt, g.N, g.K, E);
                pg8::gemm_phase<pg8::EpiSwiglu, pg8::StaticOrder, true, true>(lds, g, S, E);
            }
#endif
#ifndef NO_RES
            else if (k == 1 || k == 6 || k == 4) {
                const bool wo = (k == 4);
                const bf16_t* Bt = wo ? (L == 0 ? Woa : Wob) : Wdn + (size_t)(2 * L + (k == 6)) * DM * FF;
                pg8::Gemm g{wo ? Qb : Hb, Bt, MP, DM, wo ? DM : FF}; pg8::StaticOrder S; S.init(MP, DM, G, bid);
                pg8::EpiResid E{c, wo ? 1.0f : 0.5f};
                pg8::small_gemm<pg8::EpiResid>(lds, g.A, g.Bt, g.N, g.K, E);
                pg8::gemm_phase<pg8::EpiResid, pg8::StaticOrder, true, true>(lds, g, S, E);
            }
#endif
#ifndef NO_QKV
            else if (k == 2)
#pragma unroll 1
            for (int rep = 0; rep < ((PROBE_DUP & 16) ? 2 : 1); ++rep) {
                if (L == 0) {
                    pg8::Gemm g{Zb, Wqkva, MP, 3072, DM}; pg8::StaticOrder S; S.init(MP, 3072, G, bid);
                    pg8::EpiQkvA E{c};
                    pg8::small_gemm<pg8::EpiQkvA>(lds, g.A, g.Bt, g.N, g.K, E);
                    pg8::gemm_phase<pg8::EpiQkvA, pg8::StaticOrder, true, true>(lds, g, S, E);
                } else {
                    pg8::Gemm g{Zb, Wqkvb, MP, 1536, DM}; pg8::StaticOrder S; S.init(MP, 1536, G, bid);
                    pg8::EpiQkvB E{c};
                    pg8::small_gemm<pg8::EpiQkvB>(lds, g.A, g.Bt, g.N, g.K, E);
                    pg8::gemm_phase<pg8::EpiQkvB, pg8::StaticOrder, true, true>(lds, g, S, E);
                }
            }
#endif
#ifndef NO_ATT
            else
#pragma unroll 1
            for (int rep = 0; rep < ((PROBE_DUP & 4) ? 2 : 1); ++rep) {
                bf16_t* Ob = ((PROBE_DUP & 4) && rep == 0) ? (bf16_t*)(WSP + 400 * MiB) : Qb;
                int tid_o2 = threadIdx.x; asm volatile("" : "+v"(tid_o2)); const int tid2 = tid_o2, lane = tid2 & 63;
                for (int bu = bid; bu < 2048 + 32; bu += G) {
                    if (bu < 2048) {
                        if (L == 0) attn_block_a(lds, Qb, Kpb, Vtpb, Ob, relb + ((bu >> 3) & 15) * 257, bu >> 7, (bu >> 3) & 15, (bu & 7) * 4, tid2, wave, lane);
                        else attn_block_b(lds, Qb, Kpb, Vtpb, Ob, sinks, bu >> 7, (bu >> 5) & 3, bu & 31, tid2, wave, lane);
                    } else {
                        __syncthreads();
                        const int wu = (bu - 2048) * 8 + wave, b = wu >> 4, h = wu & 15; const size_t row0 = (size_t)MP + b * 16;
                        if (L == 0) attn_wave<true, true>(Qb + row0 * DM + h * 64, DM, 16, Ksa + (size_t)b * 544 * DM + h * 64, DM, Vtsa + (size_t)((b * 16 + h) * 64) * 544, 544,
                                                          0, 9, 16, 528, 512, relb + h * 257, (LAS float*)(lds + 6 * 16384 + wave * 2048), 0.f, Ob + row0 * DM + h * 64, DM, lane);
                        else { const int kvh = h >> 2;
                               attn_wave<false, true>(Qb + row0 * DM + h * 64, DM, 16, Ksb + (size_t)b * 160 * 256 + kvh * 64, 256, Vtsb + (size_t)((b * 4 + kvh) * 64) * 160, 160,
                                                      0, 3, 4, 144, 0, nullptr, nullptr, sinks[h], Ob + row0 * DM + h * 64, DM, lane); }
                    }
                }
            }
#endif
        }
        SEAM(s + 1);
    }
    if (IN(15)) {
        const int gw = bid * 8 + wave, NGW = G * 8;
        const float* g = ln_g + 5 * DM; const float* b = ln_b + 5 * DM;
        f32x4 gv[4], bv[4];
#pragma unroll
        for (int j = 0; j < 4; ++j) { gv[j] = *(const f32x4*)(g + 4 * lane + 256 * j); bv[j] = *(const f32x4*)(b + 4 * lane + 256 * j); }
        for (int row = gw; row < MT; row += NGW) {
            float* zr = out + (size_t)row * DM + 4 * lane;
            f32x4 v[4]; float s = 0.f;
#pragma unroll
            for (int j = 0; j < 4; ++j) { v[j] = *(const f32x4*)(zr + 256 * j); s += (v[j][0] + v[j][1]) + (v[j][2] + v[j][3]); }
            const float mean = wave_sum(s) * (1.0f / DM); float s2 = 0.f;
#pragma unroll
            for (int j = 0; j < 4; ++j) { v[j] = v[j] - mean; s2 += (v[j][0] * v[j][0] + v[j][1] * v[j][1]) + (v[j][2] * v[j][2] + v[j][3] * v[j][3]); }
            const float rstd = 1.0f / sqrtf(wave_sum(s2) * (1.0f / DM) + 1e-5f);
#pragma unroll
            for (int j = 0; j < 4; ++j) *(f32x4*)(zr + 256 * j) = v[j] * rstd * gv[j] + bv[j];
        }
    }
#undef IN
#undef SEAM
}

#undef AIN
#undef x_p
#undef x_s
#undef cak
#undef cav
#undef cbk
#undef cbv
#undef ln_g
#undef ln_b
#undef w_in
#undef w_dn
#undef w_qkva
#undef w_oa
#undef relb
#undef w_qkvb
#undef w_ob
#undef sinks
#undef out
#undef WSP
#undef Win
#undef Wdn
#undef Wqkva
#undef Woa
#undef Wqkvb
#undef Wob
#undef misc
#undef stA
#undef stB
#undef Zb
#undef Ksa
#undef Vtsa
#undef Ksb
#undef Vtsb
#undef Hb
#undef Qb
#undef Kpb
#undef Vtpb
#undef rope
#ifndef N_LAUNCH_MODE
#define N_LAUNCH_MODE 1
#endif
extern "C" void kernel_launch(void* const* d_in, const int* in_sizes, int n_in, void* d_out, int out_size, void* d_ws, size_t ws_size, hipStream_t stream) {
    static int grid = 0;
    if (grid == 0) {
        if (n_in != 16 || ws_size < WS_END || (size_t)out_size != OUT_END) { fprintf(stderr, "kernel_launch: unexpected problem (n_in %d, out %d, ws %zu)\n", n_in, out_size, ws_size); grid = -1; return; }
        int dev = 0, cus = 0, per_cu = 0;
        (void)hipGetDevice(&dev); (void)hipDeviceGetAttribute(&cus, hipDeviceAttributeMultiprocessorCount, dev);
        if (hipFuncSetAttribute((const void*)fwd_kernel, hipFuncAttributeMaxDynamicSharedMemorySize, LDS_BYTES) != hipSuccess) { fprintf(stderr, "kernel_launch: hipFuncSetAttribute failed\n"); grid = -1; return; }
        if (hipOccupancyMaxActiveBlocksPerMultiprocessor(&per_cu, (const void*)fwd_kernel, 512, LDS_BYTES) != hipSuccess || per_cu < 1) { fprintf(stderr, "kernel_launch: occupancy query gave %d\n", per_cu); per_cu = 1; }
        (void)hipGetLastError();
        grid = cus * per_cu;
        fprintf(stderr, "kernel_launch: grid %d (cus %d x %d)\n", grid, cus, per_cu);
    }
    if (grid < 0) return;
    if (hipMemsetAsync(d_ws, 0, 16384, stream) != hipSuccess) { fprintf(stderr, "kernel_launch: memset failed\n"); return; }
    if (hipMemsetAsync((char*)d_ws + WS_MISC, 0, (size_t)MC_ROPE * 4, stream) != hipSuccess) { fprintf(stderr, "kernel_launch: memset failed\n"); return; }
    Args a{};
    for (int i = 0; i < 16; ++i) a.in[i] = (const float*)d_in[i];
    a.out = (float*)d_out; a.ws = (unsigned char*)d_ws;
    if (N_LAUNCH_MODE == 1) {
        a.ph_lo = 0; a.ph_hi = N_PHASES;
        void* kargs[] = {&a};
        hipError_t e = hipLaunchCooperativeKernel((const void*)fwd_kernel, dim3(grid), dim3(512), kargs, LDS_BYTES, stream);
        if (e != hipSuccess) fprintf(stderr, "cooperative launch failed: %s (grid %d)\n", hipGetErrorString(e), grid);
    } else {
        for (int p = 0; p < N_PHASES; ++p) { a.ph_lo = p; a.ph_hi = p + 1; hipLaunchKernelGGL(fwd_kernel, dim3(grid), dim3(512), LDS_BYTES, stream, a); }
    }
}
```

```cpp
#include <hip/hip_runtime.h>
#include <hip/hip_cooperative_groups.h>
#include <cstdio>
#include <cstdint>
namespace cg = cooperative_groups;
namespace pg8 {
#define PG8_LAS __attribute__((address_space(3)))
typedef unsigned short bf16_t;
typedef short bf16x8 __attribute__((ext_vector_type(8)));
typedef float f32x4 __attribute__((ext_vector_type(4)));
typedef unsigned u32x4 __attribute__((ext_vector_type(4)));
constexpr int BM = 256, BK = 64, HALF = 128, HTB = HALF * BK * 2  , STAGE_BYTES = 8 * HTB, NXCD = 8, WGM = 8;

__host__ __device__ __forceinline__ int lds_byte(int r, int c) { const int st = (r >> 4) * 2 + (c >> 5), rr = r & 15, cc = c & 31, ob = rr * 64 + cc * 2; return st * 1024 + (ob ^ (((ob >> 9) & 1) << 5)); }
__host__ __device__ __forceinline__ void stage_rc(int b, int& R, int& C) { const int st = b / 1024, sb = b % 1024, swz = sb ^ (((sb >> 9) & 1) << 5); R = (st >> 1) * 16 + swz / 64; C = (st & 1) * 32 + (swz % 64) / 2; }
__host__ __device__ __forceinline__ int perm32(int rho) { const int n = rho >> 4, i = rho & 15; return 8 * (i >> 2) + 4 * n + (i & 3); }

struct Unit { int pm, pn; };
struct Gemm { const bf16_t* A; const bf16_t* Bt; int M, N, K, lda; };

struct StaticOrder {
    int nM, nN, nwg, G, c;
    __host__ __device__ void init(int M, int N, int G_, int c_) { nM = M / BM; nN = N / BM; nwg = nM * nN; G = G_; c = c_; }
    __host__ __device__ bool next(int i, Unit& u) const {
        const long L = (long)i * G + c; if (L >= nwg) return false;
        int wgid = (int)L; { const int q = nwg / NXCD, r = nwg % NXCD, xcd = wgid % NXCD, off = wgid / NXCD; wgid = (xcd < r ? xcd * (q + 1) : r * (q + 1) + (xcd - r) * q) + off; }
        const int nig = WGM * nN, gid = wgid / nig, fm = gid * WGM, gsz = (nM - fm) < WGM ? (nM - fm) : WGM;
        u.pn = (wgid % nig) / gsz; u.pm = fm + ((wgid % nig) % gsz + u.pn) % gsz; return true;
    }
    __device__ __forceinline__ void a_ready(const Unit&) const {}
    __device__ __forceinline__ void done(const Unit&) const {}
};

__device__ __forceinline__ unsigned cvt_pk_bf16(float lo, float hi) { unsigned r; asm volatile("v_cvt_pk_bf16_f32 %0, %1, %2" : "=v"(r) : "v"(lo), "v"(hi)); return r; }
template <class Epi, class Sched, bool ALIGN_EPI = false, bool SP2 = false>
__device__ __forceinline__ void gemm_phase(PG8_LAS unsigned char* lds, const Gemm g, const Sched& S, const Epi& E) {
    int tid_o = threadIdx.x; asm volatile("" : "+v"(tid_o));
    const int tid = tid_o, wid = __builtin_amdgcn_readfirstlane(tid >> 6), lane = tid & 63, wr = wid >> 2, wc = wid & 3, fr = lane & 15, fq = lane >> 4;
    const int K = g.K, nt = K / BK;
    static_assert(!Epi::PERM, "this copy of the body stages natural row order only");
    unsigned voffA, voffB;
    { int R, C; stage_rc(tid * 16, R, C); voffA = (unsigned)(R * g.lda + C) * 2u; voffB = (unsigned)(R * K + C) * 2u; }
    const size_t rstepA = (size_t)64 * g.lda * 2, rstepB = (size_t)64 * K * 2;
    const size_t kstep = (size_t)(BK * 2);
    const size_t hstep = (size_t)HALF * K * 2, hstepA = (size_t)HALF * g.lda * 2;
    const size_t tstep = 2 * hstep, tstepA = 2 * hstepA;
    const unsigned ldsw = (unsigned)wid * 1024u;
    const int aoff = lds_byte(wr * 64 + fr, fq * 8), boff = lds_byte(wc * 32 + fr, fq * 8);
#define PG8_SA(b, h) (((b) * 2 + (h)) * HTB)
#define PG8_SB(b, h) ((4 + (b) * 2 + (h)) * HTB)
#define PG8_STAGE(bufoff, gbase, X) do { _Pragma("unroll") for (int _i = 0; _i < 2; ++_i) \
        __builtin_amdgcn_global_load_lds((const unsigned*)((const char*)(gbase) + (size_t)_i * rstep##X + voff##X), (PG8_LAS unsigned*)(lds + (bufoff) + ldsw + _i * 8192), 16, 0, 0); } while (0)
#define PG8_LDA(dst, b, h) do { _Pragma("unroll") for (int m = 0; m < 4; ++m) _Pragma("unroll") for (int k = 0; k < 2; ++k) dst[m][k] = *(const PG8_LAS bf16x8*)(lds + PG8_SA(b, h) + aoff + m * 2048 + k * 1024); } while (0)
#define PG8_LDB(dst, b, h) do { _Pragma("unroll") for (int n = 0; n < 2; ++n) _Pragma("unroll") for (int k = 0; k < 2; ++k) dst[n][k] = *(const PG8_LAS bf16x8*)(lds + PG8_SB(b, h) + boff + n * 2048 + k * 1024); } while (0)
#define PG8_MMA(ai, bj, At, Bt) do { __builtin_amdgcn_s_setprio(1); _Pragma("unroll") for (int m = 0; m < 4; ++m) _Pragma("unroll") for (int n = 0; n < 2; ++n) _Pragma("unroll") for (int k = 0; k < 2; ++k) \
        acc[ai][bj][m][n] = __builtin_amdgcn_mfma_f32_16x16x32_bf16(Bt[n][k], At[m][k], acc[ai][bj][m][n], 0, 0, 0); __builtin_amdgcn_s_setprio(0); } while (0)
#define PG8_WAIT_V(n) asm volatile("s_waitcnt vmcnt(" #n ")" ::: "memory")
#define PG8_WAIT_L(n) asm volatile("s_waitcnt lgkmcnt(" #n ")" ::: "memory")
#define PG8_BAR __builtin_amdgcn_s_barrier()
#define PG8_SCHED __builtin_amdgcn_sched_barrier(0)
    Unit cur, nxt; int ui = 0;
    if (!S.next(0, cur)) return;
    f32x4 acc[2][2][4][2];
#pragma unroll
    for (int a = 0; a < 2; ++a)
#pragma unroll
        for (int b = 0; b < 2; ++b)
#pragma unroll
            for (int m = 0; m < 4; ++m)
#pragma unroll
                for (int n = 0; n < 2; ++n) acc[a][b][m][n] = (f32x4){0.f, 0.f, 0.f, 0.f};
    bf16x8 At[4][2], B0[2][2], B1[2][2];
    const char* cA = (const char*)g.A + (size_t)cur.pm * tstepA; const char* cB = (const char*)g.Bt + (size_t)cur.pn * tstep;
    S.a_ready(cur);
    if constexpr (SP2) {
        PG8_STAGE(PG8_SB(0, 0), cB, B); PG8_STAGE(PG8_SB(0, 1), cB + hstep, B); PG8_STAGE(PG8_SA(0, 0), cA, A); PG8_STAGE(PG8_SA(0, 1), cA + hstepA, A);
        if (wr == 1) PG8_BAR;
        PG8_WAIT_V(2); PG8_BAR;
        PG8_STAGE(PG8_SB(1, 0), cB + kstep, B); PG8_STAGE(PG8_SA(1, 0), cA + kstep, A); PG8_STAGE(PG8_SB(1, 1), cB + hstep + kstep, B);
        PG8_WAIT_V(6); PG8_BAR;
    } else {
        PG8_STAGE(PG8_SB(0, 0), cB, B); PG8_STAGE(PG8_SA(0, 0), cA, A); PG8_STAGE(PG8_SB(0, 1), cB + hstep, B); PG8_STAGE(PG8_SA(0, 1), cA + hstepA, A);
        if (wr == 1) PG8_BAR;
        PG8_WAIT_V(4); PG8_BAR;
        PG8_STAGE(PG8_SB(1, 0), cB + kstep, B); PG8_STAGE(PG8_SA(1, 0), cA + kstep, A); PG8_STAGE(PG8_SB(1, 1), cB + hstep + kstep, B);
        PG8_WAIT_V(6); PG8_BAR;
    }
    for (;;) {
        const bool has_next = S.next(ui + 1, nxt);
        const char* nA = has_next ? (const char*)g.A + (size_t)nxt.pm * tstepA : cA; const char* nB = has_next ? (const char*)g.Bt + (size_t)nxt.pn * tstep : cB;
        for (int t = 0; t < nt; t += 2) {
            const bool last = (t == nt - 2);
            const char* a1 = cA + (size_t)(t + 1) * kstep;
            const char* a2 = last ? nA : cA + (size_t)(t + 2) * kstep; const char* b2 = last ? nB : cB + (size_t)(t + 2) * kstep;
            const char* a3 = a2 + kstep; const char* b3 = b2 + kstep;
            if (last && has_next) S.a_ready(nxt);
            if constexpr (SP2) {
            PG8_LDB(B0, 0, 0); PG8_LDB(B1, 0, 1); PG8_SCHED; PG8_LDA(At, 0, 0); PG8_STAGE(PG8_SA(1, 1), a1 + hstepA, A);
            PG8_WAIT_V(8); PG8_WAIT_L(0); PG8_BAR; PG8_MMA(0, 0, At, B0); PG8_MMA(0, 1, At, B1); PG8_BAR; PG8_SCHED;
            PG8_LDA(At, 0, 1); PG8_STAGE(PG8_SB(0, 0), b2, B); PG8_STAGE(PG8_SB(0, 1), b2 + hstep, B); PG8_STAGE(PG8_SA(0, 0), a2, A);
            PG8_WAIT_V(8); PG8_WAIT_L(0); PG8_BAR; PG8_MMA(1, 0, At, B0); PG8_MMA(1, 1, At, B1); PG8_BAR; PG8_SCHED;
            PG8_LDB(B0, 1, 0); PG8_LDB(B1, 1, 1); PG8_SCHED; PG8_LDA(At, 1, 0); PG8_STAGE(PG8_SA(0, 1), a2 + hstepA, A);
            PG8_WAIT_V(8); PG8_WAIT_L(0); PG8_BAR; PG8_MMA(0, 0, At, B0); PG8_MMA(0, 1, At, B1); PG8_BAR; PG8_SCHED;
            PG8_LDA(At, 1, 1); PG8_STAGE(PG8_SB(1, 0), b3, B); PG8_STAGE(PG8_SB(1, 1), b3 + hstep, B); PG8_STAGE(PG8_SA(1, 0), a3, A);
            PG8_WAIT_V(8); PG8_WAIT_L(0); PG8_BAR; PG8_MMA(1, 0, At, B0); PG8_MMA(1, 1, At, B1); PG8_BAR; PG8_SCHED;
            } else {
            PG8_LDB(B0, 0, 0); PG8_SCHED; PG8_LDA(At, 0, 0); PG8_STAGE(PG8_SA(1, 1), a1 + hstepA, A);
            PG8_WAIT_L(8); PG8_BAR; PG8_WAIT_L(0); PG8_MMA(0, 0, At, B0); PG8_BAR; PG8_SCHED;
            PG8_LDB(B1, 0, 1); PG8_STAGE(PG8_SB(0, 0), b2, B);
            PG8_BAR; PG8_WAIT_L(0); PG8_MMA(0, 1, At, B1); PG8_BAR;
            PG8_LDA(At, 0, 1); PG8_STAGE(PG8_SA(0, 0), a2, A);
            PG8_BAR; PG8_WAIT_L(0); PG8_MMA(1, 0, At, B0); PG8_BAR; PG8_SCHED;
            PG8_STAGE(PG8_SB(0, 1), b2 + hstep, B);
            PG8_WAIT_V(6); PG8_BAR; PG8_MMA(1, 1, At, B1); PG8_BAR;
            PG8_LDB(B0, 1, 0); PG8_SCHED; PG8_LDA(At, 1, 0); PG8_STAGE(PG8_SA(0, 1), a2 + hstepA, A);
            PG8_WAIT_L(8); PG8_BAR; PG8_WAIT_L(0); PG8_MMA(0, 0, At, B0); PG8_BAR; PG8_SCHED;
            PG8_LDB(B1, 1, 1); PG8_STAGE(PG8_SB(1, 0), b3, B);
            PG8_BAR; PG8_WAIT_L(0); PG8_MMA(0, 1, At, B1); PG8_BAR;
            PG8_LDA(At, 1, 1); PG8_STAGE(PG8_SA(1, 0), a3, A);
            PG8_BAR; PG8_WAIT_L(0); PG8_MMA(1, 0, At, B0); PG8_BAR; PG8_SCHED;
            PG8_STAGE(PG8_SB(1, 1), b3 + hstep, B);
            PG8_WAIT_V(6); PG8_BAR; PG8_MMA(1, 1, At, B1); PG8_BAR;
            }
        }
        if constexpr (ALIGN_EPI) { if (wr == 0) PG8_BAR; }
        if constexpr (!Epi::AFTER_DRAIN) { E(acc, cur, wr, wc, fr, fq); S.done(cur); }
        if (!has_next) break;
#pragma unroll
        for (int a = 0; a < 2; ++a)
#pragma unroll
            for (int b = 0; b < 2; ++b)
#pragma unroll
                for (int m = 0; m < 4; ++m)
#pragma unroll
                    for (int n = 0; n < 2; ++n) acc[a][b][m][n] = (f32x4){0.f, 0.f, 0.f, 0.f};
        cur = nxt; cA = nA; cB = nB; ++ui;
        if constexpr (ALIGN_EPI) { if (wr == 1) PG8_BAR; }
    }
    PG8_WAIT_V(0);
    if constexpr (!ALIGN_EPI) { if (wr == 0) PG8_BAR; }
    PG8_BAR;
    if constexpr (Epi::AFTER_DRAIN) { E.fused(acc, cur, wr, wc, fr, fq, lds, wid, lane); S.done(cur); }
#undef PG8_SA
#undef PG8_SB
#undef PG8_STAGE
#undef PG8_LDA
#undef PG8_LDB
#undef PG8_MMA
#undef PG8_WAIT_V
#undef PG8_WAIT_L
#undef PG8_BAR
#undef PG8_SCHED
}
}
constexpr int DM = 1024, FF = 2816, MP = 32768, MS = 256, MT = MP + MS, SEQ = 2048;
constexpr int ZLD = 1088, QLD = 1088, KBLD = 288;
constexpr float ALPHA = 1.4142135623730951f;
constexpr float LOG2E = 1.4426950408889634f;
typedef pg8::bf16_t bf16_t;
typedef pg8::bf16x8 bf16x8;
typedef pg8::f32x4 f32x4;
typedef pg8::u32x4 u32x4;
typedef float f32x2v __attribute__((ext_vector_type(2)));
typedef float f32x16 __attribute__((ext_vector_type(16)));
typedef unsigned u32x2 __attribute__((ext_vector_type(2)));
#define LAS __attribute__((address_space(3)))

constexpr size_t MiB = 1u << 20;
constexpr size_t WS_WIN = 1 * MiB;
constexpr size_t WS_WDN = 45 * MiB;
constexpr size_t WS_WQKVA = 67 * MiB;
constexpr size_t WS_WOA = 73 * MiB;
constexpr size_t WS_WQKVB = 75 * MiB;
constexpr size_t WS_WOB = 78 * MiB;
constexpr size_t WS_MISC = 80 * MiB;
constexpr size_t WS_STA = 82 * MiB;
constexpr size_t WS_STB = 87 * MiB;
constexpr size_t WS_ZB = 92 * MiB;
constexpr size_t WS_KSA = 161 * MiB;
constexpr size_t WS_VTSA = 178 * MiB;
constexpr size_t WS_KSB = 195 * MiB;
constexpr size_t WS_VTSB = 197 * MiB;
constexpr size_t WS_BIG = 199 * MiB;
constexpr size_t BIG_K = (size_t)MT * QLD * 2, BIG_VT = BIG_K + (size_t)MP * QLD * 2;
constexpr size_t WS_END = 404 * MiB, WS_DUMMY_O = 420 * MiB;
static_assert(BIG_VT + (size_t)MP * QLD * 2 <= WS_END - WS_BIG && (size_t)MT * FF * 2 <= WS_END - WS_BIG && WS_ZB + (size_t)MT * ZLD * 2 <= WS_KSA, "workspace map");
constexpr int MC_WIN = 0;
constexpr int MC_QKVA = 4 * 2 * 5632;
constexpr int MC_QKVB = MC_QKVA + 2 * 3072;
constexpr int MC_ROPE = MC_QKVB + 2 * 1536;
constexpr int LDS_BYTES = 131072 + 64;
struct Args { const float* in[16]; float* out; unsigned char* ws; int ph_lo, ph_hi; };
typedef const __attribute__((address_space(4))) Args* ArgsP;
__device__ __forceinline__ ArgsP get_args() { ArgsP p = (ArgsP)__builtin_amdgcn_kernarg_segment_ptr(); asm volatile("" : "+s"(p)); return p; }
constexpr size_t OUT_YP = 0, OUT_YS = (size_t)MP * DM, OUT_AKP = OUT_YS + (size_t)MS * DM, OUT_AVP = OUT_AKP + (size_t)16 * 512 * 1024, OUT_BKP = OUT_AVP + (size_t)16 * 512 * 1024,
                 OUT_BVP = OUT_BKP + (size_t)16 * 128 * 256, OUT_AKS = OUT_BVP + (size_t)16 * 128 * 256, OUT_AVS = OUT_AKS + (size_t)16 * 16 * 1024, OUT_BKS = OUT_AVS + (size_t)16 * 16 * 1024,
                 OUT_BVS = OUT_BKS + (size_t)16 * 16 * 256, OUT_END = OUT_BVS + (size_t)16 * 16 * 256;


__device__ __forceinline__ unsigned f2bf(float f) { unsigned u = __builtin_bit_cast(unsigned, f); return (u + 0x7fffu + ((u >> 16) & 1u)) >> 16; }
__device__ __forceinline__ unsigned pk2(float lo, float hi) { return f2bf(lo) | (f2bf(hi) << 16); }
__device__ __forceinline__ float bfround(float f) { return __builtin_bit_cast(float, f2bf(f) << 16); }
__device__ __forceinline__ u32x2 pk4(f32x4 v) { u32x2 r; r.x = pg8::cvt_pk_bf16(v[0], v[1]); r.y = pg8::cvt_pk_bf16(v[2], v[3]); return r; }
__device__ __forceinline__ float wave_sum(float v) {
#pragma unroll
    for (int o = 1; o < 64; o <<= 1) v += __shfl_xor(v, o);
    return v;
}

namespace pg8 {
__device__ __forceinline__ void row_mean_rstd(const float* st, int row, int fq, float& mean, float& rstd) {
    const f32x4* p = (const f32x4*)(st + (unsigned)row * 32 + 8 * fq);
    const f32x4 a = p[0], b = p[1];
    float s = (a[0] + a[2]) + (b[0] + b[2]), q = (a[1] + a[3]) + (b[1] + b[3]);
    s += __shfl_xor(s, 16); s += __shfl_xor(s, 32); q += __shfl_xor(q, 16); q += __shfl_xor(q, 32);
    mean = s * (1.0f / 1024.0f);
    const float var = fmaxf(q * (1.0f / 1024.0f) - mean * mean, 0.f);
    rstd = __builtin_amdgcn_rsqf(var + 1e-5f);
}

#define PG8_EPI_WALK() \
    __device__ __forceinline__ void operator()(const f32x4 (&acc)[2][2][4][2], const Unit& u, int wr, int wc, int fr, int fq) const { \
        const Ctx cx = ctx(); \
        f32x4 cv[8]; load_cv(cx, u.pn, wc, fq, cv);     \
        _Pragma("unroll") for (int ai = 0; ai < 2; ++ai) _Pragma("unroll") for (int m = 0; m < 4; ++m) { \
            const int row = u.pm * 256 + ai * 128 + wr * 64 + m * 16 + fr; \
            const f32x4 v[2][2] = {{acc[ai][0][m][0], acc[ai][0][m][1]}, {acc[ai][1][m][0], acc[ai][1][m][1]}}; \
            row_op(cx, u.pm, u.pn, wc, row, fq, v, cv); } }

struct EpiSwiglu {
    static constexpr bool PERM = false, AFTER_DRAIN = false;
    int w, cnt;
    struct Ctx { bf16_t* H; const float* st; const float* c1; const float* c2; };
    __device__ __forceinline__ Ctx ctx() const {
        unsigned char* wsp = get_args()->ws; Ctx c;
        c.H = (bf16_t*)(wsp + WS_BIG); c.st = cnt == 0 ? nullptr : (const float*)(wsp + ((cnt & 1) ? WS_STA : WS_STB));
        c.c1 = (const float*)(wsp + WS_MISC) + MC_WIN + w * 2 * 5632; c.c2 = c.c1 + 5632; return c; }
    __device__ __forceinline__ void load_cv(const Ctx& cx, int pn, int wc, int fq, f32x4 (&cv)[8]) const {
        const int sb0 = pn * 256 + wc * 32 + 4 * fq;
#pragma unroll
        for (int i = 0; i < 8; ++i) cv[i] = (f32x4){0.f, 0.f, 0.f, 0.f};
        if (cx.st != nullptr) {
#pragma unroll
            for (int bj = 0; bj < 2; ++bj) { cv[4 * bj + 0] = *(const f32x4*)(cx.c1 + sb0 + bj * 128); cv[4 * bj + 1] = *(const f32x4*)(cx.c1 + sb0 + bj * 128 + 16);
                                             cv[4 * bj + 2] = *(const f32x4*)(cx.c2 + sb0 + bj * 128); cv[4 * bj + 3] = *(const f32x4*)(cx.c2 + sb0 + bj * 128 + 16); } }
    }
    __device__ __forceinline__ void row_op(const Ctx& cx, int pm, int pn, int wc, int row, int fq, const f32x4 (&v)[2][2], const f32x4 (&cv)[8]) const {
        const int sb0 = pn * 256 + wc * 32 + 4 * fq, ff0 = pn * 128 + wc * 32 + 8 * fq;
        const bool fold = (cx.st != nullptr);
        float mean = 0.f, rstd = 1.f;
        if (fold) row_mean_rstd(cx.st, row, fq, mean, rstd);
        u32x2 hp[2];
#pragma unroll
        for (int bj = 0; bj < 2; ++bj) {
            f32x4 g = v[bj][0], up = v[bj][1];
            if (fold) {
                g = (g - mean * cv[4 * bj + 0]) * rstd + cv[4 * bj + 2]; up = (up - mean * cv[4 * bj + 1]) * rstd + cv[4 * bj + 3];
            }
            f32x4 hv;
#pragma unroll
            for (int j = 0; j < 4; ++j) hv[j] = g[j] * __builtin_amdgcn_rcpf(1.0f + __builtin_amdgcn_exp2f(-LOG2E * g[j])) * up[j];
            hp[bj] = pk4(hv);
        }
        *(u32x4*)(cx.H + (unsigned)row * FF + ff0) = (u32x4){hp[0].x, hp[0].y, hp[1].x, hp[1].y};
    }
    PG8_EPI_WALK()
};

struct EpiResid {
    static constexpr bool PERM = false, AFTER_DRAIN = false;
    int cnt; float cs;
    struct Ctx { float* Z; const float* xp; const float* xs; const float* stp; const float* g; const float* b; float* stn; bf16_t* Zb; };
    __device__ __forceinline__ Ctx ctx() const {
        unsigned char* wsp = get_args()->ws; Ctx c;
        c.Z = get_args()->out; c.xp = get_args()->in[0]; c.xs = get_args()->in[1];
        c.stp = cnt == 0 ? nullptr : (const float*)(wsp + ((cnt & 1) ? WS_STA : WS_STB)); c.stn = (float*)(wsp + ((cnt & 1) ? WS_STB : WS_STA));
        const int lni = cnt > 0 ? cnt - 1 : 0;
        c.g = get_args()->in[6] + lni * DM; c.b = get_args()->in[7] + lni * DM; c.Zb = (bf16_t*)(wsp + WS_ZB); return c; }
    __device__ __forceinline__ void load_cv(const Ctx& cx, int pn, int wc, int fq, f32x4 (&cv)[8]) const {
        const int col0 = pn * 256 + wc * 32 + 8 * fq;
#pragma unroll
        for (int i = 0; i < 8; ++i) cv[i] = (f32x4){0.f, 0.f, 0.f, 0.f};
        if (cx.stp != nullptr) {
#pragma unroll
            for (int bj = 0; bj < 2; ++bj) { const int col = col0 + bj * 128;
                cv[4 * bj + 0] = *(const f32x4*)(cx.g + col); cv[4 * bj + 1] = *(const f32x4*)(cx.g + col + 4); cv[4 * bj + 2] = *(const f32x4*)(cx.b + col); cv[4 * bj + 3] = *(const f32x4*)(cx.b + col + 4); } }
    }
    __device__ __forceinline__ void row_op(const Ctx& cx, int pm, int pn, int wc, int row, int fq, const f32x4 (&v)[2][2], const f32x4 (&cv)[8]) const {
        const int col0 = pn * 256 + wc * 32 + 8 * fq;
        const bool first = (cx.stp == nullptr);
        float mean = 0.f, rstd = 1.f;
        if (!first) row_mean_rstd(cx.stp, row, fq, mean, rstd);
        const float* src = pm < 128 ? cx.xp + (unsigned)row * DM : cx.xs + (unsigned)(row - MP) * DM;
        float s = 0.f, q = 0.f;
#pragma unroll
        for (int bj = 0; bj < 2; ++bj) {
            const int col = col0 + bj * 128;
            f32x4 x0, x1;
            if (first) { x0 = *(const f32x4*)(src + col); x1 = *(const f32x4*)(src + col + 4); }
            else { const u32x4 zz = *(const u32x4*)(cx.Zb + (unsigned)row * ZLD + col);
                   x0 = (f32x4){__builtin_bit_cast(float, zz.x << 16), __builtin_bit_cast(float, zz.x & 0xffff0000u), __builtin_bit_cast(float, zz.y << 16), __builtin_bit_cast(float, zz.y & 0xffff0000u)};
                   x1 = (f32x4){__builtin_bit_cast(float, zz.z << 16), __builtin_bit_cast(float, zz.z & 0xffff0000u), __builtin_bit_cast(float, zz.w << 16), __builtin_bit_cast(float, zz.w & 0xffff0000u)};
                   x0 = (x0 - mean) * rstd * cv[4 * bj + 0] + cv[4 * bj + 2];
                   x1 = (x1 - mean) * rstd * cv[4 * bj + 1] + cv[4 * bj + 3]; }
            const f32x4 z0 = ALPHA * x0 + cs * v[bj][0], z1 = ALPHA * x1 + cs * v[bj][1];
            const u32x2 p0 = pk4(z0), p1 = pk4(z1);
            *(u32x4*)(cx.Zb + (unsigned)row * ZLD + col) = (u32x4){p0.x, p0.y, p1.x, p1.y};
            s += ((z0[0] + z0[1]) + (z0[2] + z0[3])) + ((z1[0] + z1[1]) + (z1[2] + z1[3]));
            q += ((z0[0] * z0[0] + z0[1] * z0[1]) + (z0[2] * z0[2] + z0[3] * z0[3])) + ((z1[0] * z1[0] + z1[1] * z1[1]) + (z1[2] * z1[2] + z1[3] * z1[3]));
        }
        s += __shfl_xor(s, 16); s += __shfl_xor(s, 32); q += __shfl_xor(q, 16); q += __shfl_xor(q, 32);
        if (fq == 0) *(f32x2v*)(cx.stn + (unsigned)row * 32 + (pn * 4 + wc) * 2) = (f32x2v){s, q};
    }
    PG8_EPI_WALK()
};

struct EpiQkvA {
    static constexpr bool PERM = false, AFTER_DRAIN = false;
    int cnt;
    struct Ctx { const float* st; const float* c1; const float* c2; bf16_t* Q; bf16_t* Kp; bf16_t* Vtp; bf16_t* Ks; bf16_t* Vts; float* outp; };
    __device__ __forceinline__ Ctx ctx() const {
        unsigned char* wsp = get_args()->ws; Ctx c; c.outp = get_args()->out;
        c.st = (const float*)(wsp + ((cnt & 1) ? WS_STA : WS_STB)); c.c1 = (const float*)(wsp + WS_MISC) + MC_QKVA; c.c2 = c.c1 + 3072;
        c.Q = (bf16_t*)(wsp + WS_BIG); c.Kp = (bf16_t*)(wsp + WS_BIG + BIG_K); c.Vtp = (bf16_t*)(wsp + WS_BIG + BIG_VT); c.Ks = (bf16_t*)(wsp + WS_KSA); c.Vts = (bf16_t*)(wsp + WS_VTSA); return c; }
    __device__ __forceinline__ void load_cv(const Ctx& cx, int pn, int wc, int fq, f32x4 (&cv)[8]) const {
        const int ns0 = pn * 256 + wc * 32 + 4 * fq;
#pragma unroll
        for (int bj = 0; bj < 2; ++bj) { cv[4 * bj + 0] = *(const f32x4*)(cx.c1 + ns0 + bj * 128); cv[4 * bj + 1] = *(const f32x4*)(cx.c1 + ns0 + bj * 128 + 16);
                                         cv[4 * bj + 2] = *(const f32x4*)(cx.c2 + ns0 + bj * 128); cv[4 * bj + 3] = *(const f32x4*)(cx.c2 + ns0 + bj * 128 + 16); }
    }
    __device__ __forceinline__ void row_op(const Ctx& cx, int pm, int pn, int wc, int row, int fq, const f32x4 (&va)[2][2], const f32x4 (&cv)[8]) const {
        const int typ = pn >> 2, hc0 = (pn & 3) * 256 + wc * 32 + 8 * fq, ns0 = pn * 256 + wc * 32 + 4 * fq;
        const bool sample = (pm == 128);
        float* okp = cx.outp + OUT_AKP; float* ovp = cx.outp + OUT_AVP; float* oks = cx.outp + OUT_AKS; float* ovs = cx.outp + OUT_AVS;
        float mean, rstd; row_mean_rstd(cx.st, row, fq, mean, rstd);
        int b, pos; if (!sample) { b = row >> 11; pos = row & 2047; } else { const int r = row - MP; b = r >> 4; pos = r & 15; }
#pragma unroll
        for (int bj = 0; bj < 2; ++bj) {
            const int hc = hc0 + bj * 128;
            const f32x4 v0 = (va[bj][0] - mean * cv[4 * bj + 0]) * rstd + cv[4 * bj + 2];
            const f32x4 v1 = (va[bj][1] - mean * cv[4 * bj + 1]) * rstd + cv[4 * bj + 3];
            const u32x2 p0 = pk4(v0), p1 = pk4(v1); const u32x4 pk = (u32x4){p0.x, p0.y, p1.x, p1.y};
            if (typ == 0) { *(u32x4*)(cx.Q + (unsigned)row * QLD + hc) = pk; }
            else if (typ == 1) {
                if (!sample) { *(u32x4*)(cx.Kp + (unsigned)row * QLD + hc) = pk; if (pos >= 1536) { float* o = okp + ((unsigned)(b * 512 + pos - 1536) * DM + hc); *(f32x4*)o = v0; *(f32x4*)(o + 4) = v1; } }
                else { *(u32x4*)(cx.Ks + ((unsigned)(b * 544 + 512 + pos) * DM + hc)) = pk; float* o = oks + ((unsigned)(b * 16 + pos) * DM + hc); *(f32x4*)o = v0; *(f32x4*)(o + 4) = v1; }
            } else {
                if (!sample) {
                    *(u32x4*)(cx.Vtp + (unsigned)row * QLD + hc) = pk;
                    if (pos >= 1536) { float* o = ovp + ((unsigned)(b * 512 + pos - 1536) * DM + hc); *(f32x4*)o = v0; *(f32x4*)(o + 4) = v1; }
                } else {
                    const int h = hc >> 6, d = hc & 63;
                    bf16_t* vt = cx.Vts + ((unsigned)((b * 16 + h) * 64 + d) * 544 + 512 + pos);
#pragma unroll
                    for (int j = 0; j < 4; ++j) { vt[(unsigned)j * 544] = (bf16_t)f2bf(v0[j]); vt[(unsigned)(j + 4) * 544] = (bf16_t)f2bf(v1[j]); }
                    float* o = ovs + ((unsigned)(b * 16 + pos) * DM + hc); *(f32x4*)o = v0; *(f32x4*)(o + 4) = v1;
                }
            }
        }
    }
    PG8_EPI_WALK()
};

struct EpiQkvB {
    static constexpr bool PERM = false, AFTER_DRAIN = false;
    int cnt;
    struct Ctx { const float* st; const float* c1; const float* c2; const float* rope; bf16_t* Q; bf16_t* Kp; bf16_t* Vtp; bf16_t* Ks; bf16_t* Vts; float* outp; };
    __device__ __forceinline__ Ctx ctx() const {
        unsigned char* wsp = get_args()->ws; Ctx c; c.outp = get_args()->out;
        c.st = (const float*)(wsp + ((cnt & 1) ? WS_STA : WS_STB)); c.c1 = (const float*)(wsp + WS_MISC) + MC_QKVB; c.c2 = c.c1 + 1536; c.rope = (const float*)(wsp + WS_MISC) + MC_ROPE;
        c.Q = (bf16_t*)(wsp + WS_BIG); c.Kp = (bf16_t*)(wsp + WS_BIG + BIG_K); c.Vtp = (bf16_t*)(wsp + WS_BIG + BIG_VT); c.Ks = (bf16_t*)(wsp + WS_KSB); c.Vts = (bf16_t*)(wsp + WS_VTSB); return c; }
    __device__ __forceinline__ void load_cv(const Ctx& cx, int pn, int wc, int fq, f32x4 (&cv)[8]) const {
        const int ns0 = pn * 256 + wc * 32 + 4 * fq;
#pragma unroll
        for (int bj = 0; bj < 2; ++bj) { cv[2 * bj + 0] = *(const f32x4*)(cx.c1 + ns0 + bj * 128); cv[2 * bj + 1] = *(const f32x4*)(cx.c1 + ns0 + bj * 128 + 16); }
    }
    __device__ __forceinline__ void row_op(const Ctx& cx, int pm, int pn, int wc, int row, int fq, const f32x4 (&va)[2][2], const f32x4 (&cv)[8]) const {
        const int ns0 = pn * 256 + wc * 32 + 4 * fq;
        const bool sample = (pm == 128);
        float* okp = cx.outp + OUT_BKP; float* ovp = cx.outp + OUT_BVP; float* oks = cx.outp + OUT_BKS; float* ovs = cx.outp + OUT_BVS;
        const int dlo = 16 * (wc & 1) + 4 * fq;
        float mean, rstd; row_mean_rstd(cx.st, row, fq, mean, rstd);
        int b, pos; if (!sample) { b = row >> 11; pos = row & 2047; } else { const int r = row - MP; b = r >> 4; pos = r & 15; }
        if (pn < 5) {
            const int rp = sample ? 2048 + pos : pos;
            const f32x4 cs0 = *(const f32x4*)(cx.rope + ((unsigned)rp * 32 + dlo) * 2), cs1 = *(const f32x4*)(cx.rope + ((unsigned)rp * 32 + dlo) * 2 + 4);
            const f32x4 cc = (f32x4){cs0[0], cs0[2], cs1[0], cs1[2]}, ss = (f32x4){cs0[1], cs0[3], cs1[1], cs1[3]};
#pragma unroll
            for (int bj = 0; bj < 2; ++bj) {
                const f32x4 x1 = (va[bj][0] - mean * cv[2 * bj + 0]) * rstd + *(const f32x4*)(cx.c2 + ns0 + bj * 128);
                const f32x4 x2 = (va[bj][1] - mean * cv[2 * bj + 1]) * rstd + *(const f32x4*)(cx.c2 + ns0 + bj * 128 + 16);
                const f32x4 lo = x1 * cc - x2 * ss, hi = x2 * cc + x1 * ss;
                const int hit = bj * 2 + (wc >> 1);
                if (pn < 4) {
                    const int hc = (pn * 4 + hit) * 64 + dlo;
                    *(u32x2*)(cx.Q + (unsigned)row * QLD + hc) = pk4(lo); *(u32x2*)(cx.Q + (unsigned)row * QLD + hc + 32) = pk4(hi);
                } else {
                    const int kc = hit * 64 + dlo;
                    if (!sample) {
                        *(u32x2*)(cx.Kp + (unsigned)row * KBLD + kc) = pk4(lo); *(u32x2*)(cx.Kp + (unsigned)row * KBLD + kc + 32) = pk4(hi);
                        if (pos >= 1920) { float* o = okp + ((unsigned)(b * 128 + pos - 1920) * 256 + kc); *(f32x4*)o = lo; *(f32x4*)(o + 32) = hi; }
                    } else {
                        bf16_t* kd = cx.Ks + ((unsigned)(b * 160 + 128 + pos) * 256 + kc); *(u32x2*)kd = pk4(lo); *(u32x2*)(kd + 32) = pk4(hi);
                        float* o = oks + ((unsigned)(b * 16 + pos) * 256 + kc); *(f32x4*)o = lo; *(f32x4*)(o + 32) = hi;
                    }
                }
            }
        } else {
#pragma unroll
            for (int bj = 0; bj < 2; ++bj)
#pragma unroll
                for (int n = 0; n < 2; ++n) {
                    const int hc = bj * 128 + wc * 32 + n * 16 + 4 * fq, kvh = hc >> 6, d = hc & 63;
                    const f32x4 v = (va[bj][n] - mean * cv[2 * bj + n]) * rstd + *(const f32x4*)(cx.c2 + ns0 + bj * 128 + n * 16);
                    if (!sample) {
                        *(u32x2*)(cx.Vtp + (unsigned)row * KBLD + hc) = pk4(v);
                        if (pos >= 1920) *(f32x4*)(ovp + ((unsigned)(b * 128 + pos - 1920) * 256 + hc)) = v;
                    } else {
                        bf16_t* vt = cx.Vts + ((unsigned)((b * 4 + kvh) * 64 + d) * 160 + 128 + pos);
#pragma unroll
                        for (int j = 0; j < 4; ++j) vt[(unsigned)j * 160] = (bf16_t)f2bf(v[j]);
                        *(f32x4*)(ovs + ((unsigned)(b * 16 + pos) * 256 + hc)) = v;
                    }
                }
        }
    }
    PG8_EPI_WALK()
};

template <class Epi>
__device__ __forceinline__ void small_gemm(PG8_LAS unsigned char* lds, const bf16_t* A, int lda, const bf16_t* Bt, int N, int K, const Epi& E) {
    typedef float f32x16 __attribute__((ext_vector_type(16)));
    int tid_o = threadIdx.x; asm volatile("" : "+v"(tid_o));
    const int tid = tid_o, wid = __builtin_amdgcn_readfirstlane(tid >> 6), lane = tid & 63, r = lane & 31, h = lane >> 5;
    const int ntiles = 8 * (N / 64), ks = K / 8;
    PG8_LAS float* part = (PG8_LAS float*)lds;
    const typename Epi::Ctx cx = E.ctx();
    for (int tile = blockIdx.x; tile < ntiles; tile += gridDim.x) {
        const int tm = tile & 7, tn = tile >> 3, pn = tn >> 2, wc = tn & 3;
        const bf16_t* ap = A + (size_t)(MP + tm * 32 + r) * lda + wid * ks + 8 * h;
        const bf16_t* bp0 = Bt + (size_t)(pn * 256 + wc * 32 + r) * K + wid * ks + 8 * h;
        const bf16_t* bp1 = bp0 + (size_t)128 * K;
        f32x16 acc0, acc1;
#pragma unroll
        for (int i = 0; i < 16; ++i) { acc0[i] = 0.f; acc1[i] = 0.f; }
#define PG8_SG_BATCH(NS, kb) do { bf16x8 fa[NS], fb0[NS], fb1[NS]; \
            _Pragma("unroll") for (int i = 0; i < NS; ++i) { fa[i] = *(const bf16x8*)(ap + (kb) + 16 * i); fb0[i] = *(const bf16x8*)(bp0 + (kb) + 16 * i); fb1[i] = *(const bf16x8*)(bp1 + (kb) + 16 * i); } \
            _Pragma("unroll") for (int i = 0; i < NS; ++i) { acc0 = __builtin_amdgcn_mfma_f32_32x32x16_bf16(fb0[i], fa[i], acc0, 0, 0, 0);     \
                                                             acc1 = __builtin_amdgcn_mfma_f32_32x32x16_bf16(fb1[i], fa[i], acc1, 0, 0, 0); } } while (0)
#pragma unroll 1
        for (int kb = 0; kb + 128 <= ks; kb += 128) PG8_SG_BATCH(8, kb);
        if (ks & 127) PG8_SG_BATCH(6, ks & ~127);
#undef PG8_SG_BATCH
#pragma unroll
        for (int g = 0; g < 4; ++g) {
            *(PG8_LAS f32x4*)(part + ((wid * 2 + 0) * 32 + r) * 36 + 8 * g + 4 * h) = (f32x4){acc0[4 * g], acc0[4 * g + 1], acc0[4 * g + 2], acc0[4 * g + 3]};
            *(PG8_LAS f32x4*)(part + ((wid * 2 + 1) * 32 + r) * 36 + 8 * g + 4 * h) = (f32x4){acc1[4 * g], acc1[4 * g + 1], acc1[4 * g + 2], acc1[4 * g + 3]};
        }
        __syncthreads();
        if (wid < 2) {
            const int fr = lane & 15, fq = lane >> 4, rr = wid * 16 + fr;
            f32x4 v[2][2];
#pragma unroll
            for (int bj = 0; bj < 2; ++bj)
#pragma unroll
                for (int n = 0; n < 2; ++n) {
                    f32x4 s = *(const PG8_LAS f32x4*)(part + ((0 * 2 + bj) * 32 + rr) * 36 + 16 * n + 4 * fq);
#pragma unroll
                    for (int w = 1; w < 8; ++w) s += *(const PG8_LAS f32x4*)(part + ((w * 2 + bj) * 32 + rr) * 36 + 16 * n + 4 * fq);
                    v[bj][n] = s;
                }
            f32x4 cv[8]; E.load_cv(cx, pn, wc, fq, cv);
            E.row_op(cx, 128, pn, wc, MP + tm * 32 + rr, fq, v, cv);
        }
        __syncthreads();
    }
}
}
template <bool MODE_A, bool MASK>
__device__ __forceinline__ void attn_wave(const bf16_t* Qrow0, int ldq, int nq, const bf16_t* Kb, int ldk, const bf16_t* Vt, int ldv,
                                          int kt0, int npairs, int ktl, int nvalid, int qpos0, const float* tabg, LAS float* tab, float sink, bf16_t* Orow0, int ldo, int lane) {
    const int r = lane & 31, h = lane >> 5;
    const int qr = r < nq ? r : nq - 1;
    if (MODE_A) {
#pragma unroll
        for (int i = 0; i < 5; ++i) { const int idx = lane + 64 * i; if (idx < 257) tab[idx] = tabg[idx] * LOG2E; }
        asm volatile("s_waitcnt vmcnt(0) lgkmcnt(0)" ::: "memory");
    }
    bf16x8 qf[4];
#pragma unroll
    for (int s = 0; s < 4; ++s) qf[s] = *(const bf16x8*)(Qrow0 + (size_t)qr * ldq + 16 * s + 8 * h);
    const int pr = (r & ~12) | ((r & 4) << 1) | ((r & 8) >> 1);
    f32x16 O0, O1;
#pragma unroll
    for (int i = 0; i < 16; ++i) { O0[i] = 0.f; O1[i] = 0.f; }
    float mrun = MODE_A ? -1e30f : sink * LOG2E;
    float l = MODE_A ? 0.f : (h == 0 ? 1.f : 0.f);
    const float SC = 0.125f * LOG2E;
    const bf16_t* kbase = Kb + (size_t)pr * ldk + 8 * h;
    const bf16_t* vbase = Vt + (size_t)r * ldv + 8 * h;
    const int relb0 = qpos0 + r - 8 * h;
#define ATT_LOAD(kt_, kf_, vf_) do { const int kc_ = (kt_) < ktl ? (kt_) : ktl; const int k0_ = kc_ * 32; const bf16_t* kp_ = kbase + (size_t)k0_ * ldk; \
        _Pragma("unroll") for (int s = 0; s < 4; ++s) kf_[s] = *(const bf16x8*)(kp_ + 16 * s); \
        _Pragma("unroll") for (int dt = 0; dt < 2; ++dt) _Pragma("unroll") for (int s = 0; s < 2; ++s) vf_[dt][s] = *(const bf16x8*)(vbase + (size_t)(dt * 32) * ldv + k0_ + 16 * s); } while (0)
#define ATT_COMPUTE(kt_, kf_, vf_) do { const int k0 = (kt_) * 32; \
        f32x16 S; _Pragma("unroll") for (int i = 0; i < 16; ++i) S[i] = 0.f; \
        _Pragma("unroll") for (int s = 0; s < 4; ++s) S = __builtin_amdgcn_mfma_f32_32x32x16_bf16(kf_[s], qf[s], S, 0, 0, 0); \
        float t[16]; const int relt = relb0 - k0; const int keyb = k0 + 8 * h; \
        float mx = -1e30f; \
        _Pragma("unroll") for (int i = 0; i < 16; ++i) { \
            float v; \
            if (MODE_A) { int rel = relt - (16 * (i >> 3) + (i & 7)); rel = rel < -128 ? -128 : (rel > 128 ? 128 : rel); v = S[i] * SC + tab[rel + 128]; } \
            else v = S[i] * SC; \
            if (MASK) { if (keyb + 16 * (i >> 3) + (i & 7) >= nvalid) v = -1e30f; } \
            t[i] = v; mx = fmaxf(mx, v); } \
        mx = fmaxf(mx, __shfl_xor(mx, 32)); \
        const float mnew = fmaxf(mrun, mx); const float alpha = __builtin_amdgcn_exp2f(mrun - mnew); mrun = mnew; \
        float ps = 0.f; \
        _Pragma("unroll") for (int i = 0; i < 16; ++i) { t[i] = __builtin_amdgcn_exp2f(t[i] - mnew); ps += t[i]; } \
        l = l * alpha + ps; \
        _Pragma("unroll") for (int i = 0; i < 16; ++i) { O0[i] *= alpha; O1[i] *= alpha; } \
        bf16x8 pf[2]; \
        _Pragma("unroll") for (int s = 0; s < 2; ++s) { u32x4 w; w.x = pg8::cvt_pk_bf16(t[8 * s + 0], t[8 * s + 1]); w.y = pg8::cvt_pk_bf16(t[8 * s + 2], t[8 * s + 3]); \
            w.z = pg8::cvt_pk_bf16(t[8 * s + 4], t[8 * s + 5]); w.w = pg8::cvt_pk_bf16(t[8 * s + 6], t[8 * s + 7]); pf[s] = __builtin_bit_cast(bf16x8, w); } \
        O0 = __builtin_amdgcn_mfma_f32_32x32x16_bf16(vf_[0][0], pf[0], O0, 0, 0, 0); O0 = __builtin_amdgcn_mfma_f32_32x32x16_bf16(vf_[0][1], pf[1], O0, 0, 0, 0); \
        O1 = __builtin_amdgcn_mfma_f32_32x32x16_bf16(vf_[1][0], pf[0], O1, 0, 0, 0); O1 = __builtin_amdgcn_mfma_f32_32x32x16_bf16(vf_[1][1], pf[1], O1, 0, 0, 0); } while (0)
    bf16x8 kfa[4], vfa[2][2], kfb[4], vfb[2][2];
    ATT_LOAD(kt0, kfa, vfa);
#pragma unroll 1
    for (int p = 0; p < npairs; ++p) {
        const int kt = kt0 + 2 * p;
        ATT_LOAD(kt + 1, kfb, vfb);
        ATT_COMPUTE(kt, kfa, vfa);
        ATT_LOAD(kt + 2, kfa, vfa);
        ATT_COMPUTE(kt + 1, kfb, vfb);
    }
#undef ATT_LOAD
#undef ATT_COMPUTE
    l += __shfl_xor(l, 32);
    const float inv = __builtin_amdgcn_rcpf(l);
    if (r < nq) {
        bf16_t* op = Orow0 + (size_t)r * ldo + 4 * h;
#pragma unroll
        for (int g = 0; g < 4; ++g) {
            f32x4 a = (f32x4){O0[4 * g], O0[4 * g + 1], O0[4 * g + 2], O0[4 * g + 3]} * inv;
            f32x4 b = (f32x4){O1[4 * g], O1[4 * g + 1], O1[4 * g + 2], O1[4 * g + 3]} * inv;
            *(u32x2*)(op + 8 * g) = pk4(a);
            *(u32x2*)(op + 32 + 8 * g) = pk4(b);
        }
    }
}

struct AttState { f32x16 O0, O1; float mrun, l; };
template <bool MODE_A, bool FAR = false>
__device__ __forceinline__ void att_tile_lds(AttState& st, const bf16x8 (&qf)[4], LAS unsigned char* slot, int tile, int relt, LAS float* tab, int pr, int r, int h) {
    const float SC = 0.125f * LOG2E;
    const int key = tile * 32 + pr;
    LAS unsigned char* krow = slot + key * 128; const int ksw = (key >> 1) & 7;
    bf16x8 kf[4], vf[2][2];
#pragma unroll
    for (int s = 0; s < 4; ++s) kf[s] = *(LAS bf16x8*)(krow + (((2 * s + h) ^ ksw) << 4));
#pragma unroll
    for (int dt = 0; dt < 2; ++dt) { const int d = dt * 32 + r; LAS unsigned char* vrow = slot + 8192 + d * 128; const int vsw = (d >> 1) & 7;
#pragma unroll
        for (int s = 0; s < 2; ++s) vf[dt][s] = *(LAS bf16x8*)(vrow + (((tile * 4 + 2 * s + h) ^ vsw) << 4)); }
    f32x16 S;
#pragma unroll
    for (int i = 0; i < 16; ++i) S[i] = 0.f;
#pragma unroll
    for (int s = 0; s < 4; ++s) S = __builtin_amdgcn_mfma_f32_32x32x16_bf16(kf[s], qf[s], S, 0, 0, 0);
    float t[16]; float mx = -1e30f;
    const float tfar = (MODE_A && FAR) ? tab[256] : 0.f;
#pragma unroll
    for (int i = 0; i < 16; ++i) {
        float v;
        if (MODE_A && !FAR) { int rel = relt - (16 * (i >> 3) + (i & 7)); rel = rel < -128 ? -128 : (rel > 128 ? 128 : rel); v = S[i] * SC + tab[rel + 128]; }
        else if (MODE_A) v = S[i] * SC + tfar;
        else v = S[i] * SC;
        t[i] = v; mx = fmaxf(mx, v);
    }
    mx = fmaxf(mx, __shfl_xor(mx, 32));
    const float mnew = fmaxf(st.mrun, mx); const float alpha = __builtin_amdgcn_exp2f(st.mrun - mnew); st.mrun = mnew;
    float ps = 0.f;
#pragma unroll
    for (int i = 0; i < 16; ++i) { t[i] = __builtin_amdgcn_exp2f(t[i] - mnew); ps += t[i]; }
    st.l = st.l * alpha + ps;
#pragma unroll
    for (int i = 0; i < 16; ++i) { st.O0[i] *= alpha; st.O1[i] *= alpha; }
    bf16x8 pf[2];
#pragma unroll
    for (int s = 0; s < 2; ++s) { u32x4 w; w.x = pg8::cvt_pk_bf16(t[8 * s + 0], t[8 * s + 1]); w.y = pg8::cvt_pk_bf16(t[8 * s + 2], t[8 * s + 3]);
        w.z = pg8::cvt_pk_bf16(t[8 * s + 4], t[8 * s + 5]); w.w = pg8::cvt_pk_bf16(t[8 * s + 6], t[8 * s + 7]); pf[s] = __builtin_bit_cast(bf16x8, w); }
    st.O0 = __builtin_amdgcn_mfma_f32_32x32x16_bf16(vf[0][0], pf[0], st.O0, 0, 0, 0); st.O0 = __builtin_amdgcn_mfma_f32_32x32x16_bf16(vf[0][1], pf[1], st.O0, 0, 0, 0);
    st.O1 = __builtin_amdgcn_mfma_f32_32x32x16_bf16(vf[1][0], pf[0], st.O1, 0, 0, 0); st.O1 = __builtin_amdgcn_mfma_f32_32x32x16_bf16(vf[1][1], pf[1], st.O1, 0, 0, 0);
}
__device__ __forceinline__ void att_chunk_write(LAS unsigned char* slot, const u32x4& kreg, const u32x4& vreg, int tid) {
    const int key = tid >> 3, c16 = tid & 7;
    *(LAS u32x4*)(slot + key * 128 + ((c16 ^ ((key >> 1) & 7)) << 4)) = kreg;
    const unsigned vw[4] = {vreg.x, vreg.y, vreg.z, vreg.w};
#pragma unroll
    for (int j = 0; j < 8; ++j) { const int d = c16 * 8 + j;
        *(LAS unsigned short*)(slot + 8192 + d * 128 + ((((key >> 3) ^ ((d >> 1) & 7)) << 4)) + (key & 7) * 2) = (unsigned short)((j & 1) ? (vw[j >> 1] >> 16) : (vw[j >> 1] & 0xffffu)); }
}
__device__ __forceinline__ void att_store_o(const AttState& st, bf16_t* Orow0, int ldo, int r, int h) {
    float l = st.l; l += __shfl_xor(l, 32);
    const float inv = __builtin_amdgcn_rcpf(l);
    bf16_t* op = Orow0 + (size_t)r * ldo + 4 * h;
#pragma unroll
    for (int g = 0; g < 4; ++g) {
        f32x4 a = (f32x4){st.O0[4 * g], st.O0[4 * g + 1], st.O0[4 * g + 2], st.O0[4 * g + 3]} * inv;
        f32x4 b = (f32x4){st.O1[4 * g], st.O1[4 * g + 1], st.O1[4 * g + 2], st.O1[4 * g + 3]} * inv;
        *(u32x2*)(op + 8 * g) = pk4(a);
        *(u32x2*)(op + 32 + 8 * g) = pk4(b);
    }
}
__device__ __forceinline__ void attn_block_a(LAS unsigned char* lds, const bf16_t* Q, const bf16_t* K, const bf16_t* V, bf16_t* O, const float* tabg, int b, int hd, int c0, int tid, int wave, int lane) {
    const int r = lane & 31, h = lane >> 5, j = wave >> 1, half = wave & 1;
    const int pr = (r & ~12) | ((r & 4) << 1) | ((r & 8) >> 1);
    LAS float* tab = (LAS float*)(lds + 6 * 16384 + wave * 2048);
    __syncthreads();
#pragma unroll
    for (int i = 0; i < 5; ++i) { const int idx = lane + 64 * i; if (idx < 257) tab[idx] = tabg[idx] * LOG2E; }
    const size_t rowb = (size_t)b * 2048;
    const bf16_t* kg = K + (rowb + (tid >> 3)) * QLD + hd * 64 + (tid & 7) * 8;
    const bf16_t* vg = V + (rowb + (tid >> 3)) * QLD + hd * 64 + (tid & 7) * 8;
#pragma unroll
    for (int i = 0; i < 4; ++i) { const int kc = c0 - 8 + i;
        if (kc >= 0) { const u32x4 kr = *(const u32x4*)(kg + (size_t)kc * 64 * QLD), vr = *(const u32x4*)(vg + (size_t)kc * 64 * QLD); att_chunk_write(lds + ((kc + 18) % 6) * 16384, kr, vr, tid); } }
    const size_t qrow = rowb + (size_t)(c0 + j) * 64 + half * 32;
    bf16x8 qf[4];
#pragma unroll
    for (int s = 0; s < 4; ++s) qf[s] = *(const bf16x8*)(Q + (qrow + r) * QLD + hd * 64 + 16 * s + 8 * h);
    AttState st;
#pragma unroll
    for (int i = 0; i < 16; ++i) { st.O0[i] = 0.f; st.O1[i] = 0.f; }
    st.mrun = -1e30f; st.l = 0.f;
    asm volatile("s_waitcnt vmcnt(0) lgkmcnt(0)" ::: "memory");
    __syncthreads();
#pragma unroll 1
    for (int p = 0; p < 9; ++p) {
        const int kn = c0 - 4 + p;
        const bool ld = (kn >= 0) && (p < 8);
        u32x4 kr = (u32x4){0u, 0u, 0u, 0u}, vr = (u32x4){0u, 0u, 0u, 0u};
        if (ld) { kr = *(const u32x4*)(kg + (size_t)kn * 64 * QLD); vr = *(const u32x4*)(vg + (size_t)kn * 64 * QLD); }
        const int kc = c0 + j - 8 + p;
        if (kc >= 0) {
            LAS unsigned char* slot = lds + ((kc + 18) % 6) * 16384;
            const int relt0 = (c0 + j - kc) * 64 + half * 32 + r - 8 * h;
            att_tile_lds<true>(st, qf, slot, 0, relt0, tab, pr, r, h);
            att_tile_lds<true>(st, qf, slot, 1, relt0 - 32, tab, pr, r, h);
        }
        if (ld) att_chunk_write(lds + ((kn + 18) % 6) * 16384, kr, vr, tid);
        asm volatile("s_waitcnt lgkmcnt(0)" ::: "memory");
        __syncthreads();
    }
    att_store_o(st, O + qrow * QLD + hd * 64, QLD, r, h);
}
__device__ __forceinline__ void attn_block_b(LAS unsigned char* lds, const bf16_t* Q, const bf16_t* K, const bf16_t* V, bf16_t* O, const float* sinks_, int b, int kvh, int c, int tid, int wave, int lane) {
    const int r = lane & 31, h = lane >> 5, qh = kvh * 4 + (wave >> 1), half = wave & 1;
    const int pr = (r & ~12) | ((r & 4) << 1) | ((r & 8) >> 1);
    const size_t rowb = (size_t)b * 2048;
    const bf16_t* kg = K + (rowb + (tid >> 3)) * KBLD + kvh * 64 + (tid & 7) * 8;
    const bf16_t* vg = V + (rowb + (tid >> 3)) * KBLD + kvh * 64 + (tid & 7) * 8;
    u32x4 kr[3], vr[3];
#pragma unroll
    for (int i = 0; i < 3; ++i) { const int kc = c - 2 + i; kr[i] = (u32x4){0u, 0u, 0u, 0u}; vr[i] = kr[i];
        if (kc >= 0) { kr[i] = *(const u32x4*)(kg + (size_t)kc * 64 * KBLD); vr[i] = *(const u32x4*)(vg + (size_t)kc * 64 * KBLD); } }
    const size_t qrow = rowb + (size_t)c * 64 + half * 32;
    bf16x8 qf[4];
#pragma unroll
    for (int s = 0; s < 4; ++s) qf[s] = *(const bf16x8*)(Q + (qrow + r) * QLD + qh * 64 + 16 * s + 8 * h);
    const float sink = sinks_[qh];
    __syncthreads();
#pragma unroll
    for (int i = 0; i < 3; ++i) if (c - 2 + i >= 0) att_chunk_write(lds + i * 16384, kr[i], vr[i], tid);
    AttState st;
#pragma unroll
    for (int i = 0; i < 16; ++i) { st.O0[i] = 0.f; st.O1[i] = 0.f; }
    st.mrun = sink * LOG2E; st.l = (h == 0) ? 1.f : 0.f;
    asm volatile("s_waitcnt lgkmcnt(0)" ::: "memory");
    __syncthreads();
#pragma unroll 1
    for (int i = 0; i < 3; ++i) {
        if (c - 2 + i >= 0) {
            att_tile_lds<false>(st, qf, lds + i * 16384, 0, 0, nullptr, pr, r, h);
            att_tile_lds<false>(st, qf, lds + i * 16384, 1, 0, nullptr, pr, r, h);
        }
    }
    att_store_o(st, O + qrow * QLD + qh * 64, QLD, r, h);
}

__device__ __forceinline__ void prep_weight_item(const float* W, int K, int N, int cb0, int cb1, const float* g, const float* b, bf16_t* Bt, int row0, float* c1, float* c2,
                                                 LAS float* scr, int lane, int kbeg, int kend) {
    const int c = lane & 31, col = cb1 == -2 ? (c >> 4) * FF + cb0 + 8 * ((c & 15) >> 2) + (c & 3) : cb1 < 0 ? cb0 + 8 * ((c & 15) >> 2) + 4 * (c >> 4) + (c & 3) : (c < 16 ? cb0 + c : cb1 + c - 16), hi = lane >> 5;
    float a1 = 0.f, a2 = 0.f;
    LAS float* gl = scr + 2304; LAS float* bl = scr + 2304 + 256;
    if (g) { const f32x4 gv = *(const f32x4*)(g + kbeg + 4 * lane), bv = *(const f32x4*)(b + kbeg + 4 * lane);
             *(LAS f32x4*)(gl + 4 * lane) = gv; *(LAS f32x4*)(bl + 4 * lane) = bv; }
    asm volatile("s_waitcnt lgkmcnt(0)" ::: "memory");
#pragma unroll 1
    for (int tp = 0; tp < 2; ++tp) {
    float wv[2][32];
#pragma unroll
    for (int t = 0; t < 2; ++t)
#pragma unroll
        for (int i = 0; i < 32; ++i) wv[t][i] = W[(size_t)(kbeg + 64 * (2 * tp + t) + 2 * i + hi) * N + col];
#pragma unroll
    for (int t2 = 0; t2 < 2; ++t2) {
        const int t = 2 * tp + t2;
        const int k0 = kbeg + 64 * t;
#pragma unroll
        for (int i = 0; i < 32; ++i) {
            const int kk = 2 * i + hi;
            const float w = wv[t2][i];
            float v = w;
            if (g) { v = w * gl[64 * t + kk]; a2 += w * bl[64 * t + kk]; }
            v = bfround(v); a1 += v;
            scr[kk * 33 + c] = v;
        }
        asm volatile("s_waitcnt lgkmcnt(0)" ::: "memory");
        const int c8 = lane & 7;
#pragma unroll
        for (int j = 0; j < 4; ++j) {
            const int n = (lane >> 3) + 8 * j; const LAS float* s = scr + (8 * c8) * 33 + n;
            u32x4 o;
            o.x = (__builtin_bit_cast(unsigned, s[0 * 33]) >> 16) | (__builtin_bit_cast(unsigned, s[1 * 33]) & 0xffff0000u);
            o.y = (__builtin_bit_cast(unsigned, s[2 * 33]) >> 16) | (__builtin_bit_cast(unsigned, s[3 * 33]) & 0xffff0000u);
            o.z = (__builtin_bit_cast(unsigned, s[4 * 33]) >> 16) | (__builtin_bit_cast(unsigned, s[5 * 33]) & 0xffff0000u);
            o.w = (__builtin_bit_cast(unsigned, s[6 * 33]) >> 16) | (__builtin_bit_cast(unsigned, s[7 * 33]) & 0xffff0000u);
            *(u32x4*)(Bt + (size_t)(row0 + n) * K + k0 + 8 * c8) = o;
        }
        asm volatile("s_waitcnt lgkmcnt(0)" ::: "memory");
    }
    }
    a1 += __shfl_xor(a1, 32); a2 += __shfl_xor(a2, 32);
    if (c1 && lane < 32) { atomicAdd(c1 + row0 + c, a1); atomicAdd(c2 + row0 + c, a2); }
}
constexpr int N_PHASES = 16;
#include <cstdint>
#include <cstdlib>
#include <vector>

#include <cstdint>
#include <cstdlib>
#include <vector>

#define XB_TMO      128
#define XB_XCNT(j)  (256  + 64 * (j))
#define XB_XSUB(j)  (1280 + 64 * (j))
#define XB_XGEN(j)  (2304 + 64 * (j))
#define XB_TOP      3328
#define XB_TOPGEN   3392
#define XCD_BAR_WORDS 3456
#define XB_SPIN_CAP (1u << 18)

__device__ __forceinline__ unsigned xb_ld(unsigned* p)              { return __hip_atomic_load(p, __ATOMIC_RELAXED, __HIP_MEMORY_SCOPE_AGENT); }
__device__ __forceinline__ unsigned xb_add(unsigned* p, unsigned v) { return __hip_atomic_fetch_add(p, v, __ATOMIC_RELAXED, __HIP_MEMORY_SCOPE_AGENT); }
__device__ __forceinline__ unsigned xb_xcc_id() { return (unsigned)__builtin_amdgcn_s_getreg((3 << 11) | 20) & 0xFu; }
#define XB_SPIN(cond, bar) do { unsigned _sp = 0; while (cond) { __builtin_amdgcn_s_sleep(1); \
    if ((++_sp & 255u) == 0u) { if (xb_ld(&(bar)[XB_TMO])) break; if (_sp > XB_SPIN_CAP) { atomicAdd(&(bar)[XB_TMO], 1u); break; } } } } while (0)

struct XcdBarrier {
    unsigned* bar; unsigned x;
    volatile LAS unsigned* st;
};

__device__ __forceinline__ XcdBarrier xcd_barrier_post(unsigned* bar, volatile LAS unsigned* st) {
    XcdBarrier b; b.bar = bar; b.x = xb_xcc_id(); b.st = st;
    if (threadIdx.x == 0) (void)xb_add(&bar[XB_XCNT(b.x)], 1u);
    return b;
}
__device__ __forceinline__ void xcd_barrier_complete(unsigned* bar, unsigned x, unsigned& nloc, unsigned& nx) {
    const unsigned G = gridDim.x * gridDim.y * gridDim.z;
    unsigned sum, cnt, mine, sp = 0u;
    for (;;) {
        sum = 0u; cnt = 0u; mine = 0u;
#pragma unroll
        for (unsigned j = 0; j < 16; ++j) { const unsigned c = xb_ld(&bar[XB_XCNT(j)]); sum += c; cnt += (c > 0u) ? 1u : 0u; mine = (j == x) ? c : mine; }
        if (sum == G) break;
        __builtin_amdgcn_s_sleep(1);
        if ((++sp & 255u) == 0u) { if (xb_ld(&bar[XB_TMO])) break; if (sp > XB_SPIN_CAP) { atomicAdd(&bar[XB_TMO], 1u); break; } }
    }
    nloc = mine > 0u ? mine : 1u; nx = cnt > 0u ? cnt : 1u;
}

__device__ __forceinline__ void xcd_barrier(const XcdBarrier& b) {
    asm volatile("s_waitcnt vmcnt(0)" ::: "memory");
    __syncthreads();
    if (threadIdx.x == 0) {
        unsigned* bar = b.bar;
        __builtin_amdgcn_s_waitcnt(0);
        unsigned nloc = b.st[0], nx = b.st[1];
        if (nloc == 0u) { xcd_barrier_complete(bar, b.x, nloc, nx); b.st[0] = nloc; b.st[1] = nx; }
        const unsigned old = xb_add(&bar[XB_XSUB(b.x)], 1u);
        const unsigned gen = old / nloc;
        if (old + 1u == (gen + 1u) * nloc) {
            __builtin_amdgcn_fence(__ATOMIC_RELEASE, "agent");
            asm volatile("s_waitcnt vmcnt(0)" ::: "memory");
            const unsigned og = xb_add(&bar[XB_TOP], 1u);
            const unsigned tg = og / nx;
            if (og + 1u == (tg + 1u) * nx) xb_add(&bar[XB_TOPGEN], 1u);
            else XB_SPIN(xb_ld(&bar[XB_TOPGEN]) == tg, bar);
            __builtin_amdgcn_fence(__ATOMIC_ACQUIRE, "agent");
            xb_add(&bar[XB_XGEN(b.x)], 1u);
            asm volatile("s_waitcnt vmcnt(0)" ::: "memory");
        } else {
            XB_SPIN(xb_ld(&bar[XB_XGEN(b.x)]) == gen, bar);
            __builtin_amdgcn_fence(__ATOMIC_ACQUIRE, "agent");
            asm volatile("s_waitcnt vmcnt(0)" ::: "memory");
        }
    }
    __syncthreads();
}


__device__ const double ROPE_INV[32] = {1.0, 0.7498942093324559, 0.5623413251903491, 0.4216965034285822, 0.31622776601683794, 0.23713737056616552, 0.1778279410038923, 0.1333521432163324, 0.1,
    0.07498942093324558, 0.05623413251903491, 0.042169650342858224, 0.03162277660168379, 0.023713737056616554, 0.01778279410038923, 0.01333521432163324, 0.01, 0.007498942093324558,
    0.005623413251903491, 0.004216965034285823, 0.0031622776601683794, 0.0023713737056616554, 0.0017782794100389228, 0.001333521432163324, 0.001, 0.0007498942093324559, 0.0005623413251903491,
    0.00042169650342858224, 0.00031622776601683794, 0.00023713737056616554, 0.00017782794100389227, 0.0001333521432163324};


#define AIN(i) ((const float*)get_args()->in[i])
#define x_p AIN(0)
#define x_s AIN(1)
#define cak AIN(2)
#define cav AIN(3)
#define cbk AIN(4)
#define cbv AIN(5)
#define ln_g AIN(6)
#define ln_b AIN(7)
#define w_in AIN(8)
#define w_dn AIN(9)
#define w_qkva AIN(10)
#define w_oa AIN(11)
#define relb AIN(12)
#define w_qkvb AIN(13)
#define w_ob AIN(14)
#define sinks AIN(15)
#define out ((float*)get_args()->out)
#define WSP ((unsigned char*)get_args()->ws)
#define Win ((bf16_t*)(WSP + WS_WIN))
#define Wdn ((bf16_t*)(WSP + WS_WDN))
#define Wqkva ((bf16_t*)(WSP + WS_WQKVA))
#define Woa ((bf16_t*)(WSP + WS_WOA))
#define Wqkvb ((bf16_t*)(WSP + WS_WQKVB))
#define Wob ((bf16_t*)(WSP + WS_WOB))
#define misc ((float*)(WSP + WS_MISC))
#define stA ((float*)(WSP + WS_STA))
#define stB ((float*)(WSP + WS_STB))
#define Zb ((bf16_t*)(WSP + WS_ZB))
#define Ksa ((bf16_t*)(WSP + WS_KSA))
#define Vtsa ((bf16_t*)(WSP + WS_VTSA))
#define Ksb ((bf16_t*)(WSP + WS_KSB))
#define Vtsb ((bf16_t*)(WSP + WS_VTSB))
#define Hb ((bf16_t*)(WSP + WS_BIG))
#define Qb ((bf16_t*)(WSP + WS_BIG))
#define Kpb ((bf16_t*)(WSP + WS_BIG + BIG_K))
#define Vtpb ((bf16_t*)(WSP + WS_BIG + BIG_VT))
#define rope (misc + MC_ROPE)
__global__ void __launch_bounds__(512, 2) fwd_kernel(Args args) {
    extern __shared__ __attribute__((aligned(16))) unsigned char lds_raw[];
    LAS unsigned char* lds = (LAS unsigned char*)lds_raw;
    cg::grid_group grid = cg::this_grid();
    const int tid = threadIdx.x, lane = tid & 63, wave = __builtin_amdgcn_readfirstlane(tid >> 6);
    const int G = gridDim.x, bid = blockIdx.x;
    if (tid < 4) ((LAS unsigned*)(lds + 131072))[tid] = 0u;
    __syncthreads();
    const XcdBarrier xbar = xcd_barrier_post((unsigned*)WSP, (volatile LAS unsigned*)(lds + 131072));
    const int lo = args.ph_lo, hi = args.ph_hi;
#define IN(k) (lo <= (k) && (k) < hi)
#ifndef PROBE_DUP
#define PROBE_DUP 0
#endif
#ifndef PROBE_SPIN_MASK
#define PROBE_SPIN_MASK 0u
#endif
#ifndef PROBE_SPIN_MULT
#define PROBE_SPIN_MULT 8
#endif
    unsigned long long pr_acc = 0ull, pr_t0 = (PROBE_SPIN_MASK != 0u) ? __builtin_amdgcn_s_memrealtime() : 0ull;
#define PROBE_MARK(k) do { if (PROBE_SPIN_MASK != 0u) { const unsigned long long t_ = __builtin_amdgcn_s_memrealtime(); if ((PROBE_SPIN_MASK >> (k)) & 1u) pr_acc += t_ - pr_t0; pr_t0 = t_; } } while (0)
#define SEAM(k) do { if (IN(k) && IN((k) + 1)) { if ((k) == 0) grid.sync(); else { xcd_barrier(xbar); if (PROBE_DUP & 1) xcd_barrier(xbar); } } } while (0)

    if (IN(0))
#pragma unroll 1
    for (int rep = 0; rep < ((PROBE_DUP & 8) ? 2 : 1); ++rep) {
        const int gw = bid * 8 + wave, NGW = G * 8;
        const long gt = (long)bid * 512 + tid, NGT = (long)G * 512;
        LAS float* scr = (LAS float*)(lds + wave * 16384);
        for (int it = gw; it < 5056; it += NGW) {
            int r = it;
            if (r < 2816) { const int w = r / 704, grp = (r % 704) >> 2, kc = r & 3;
                const int lnidx = (w == 1) ? 1 : (w == 2) ? 2 : 4;
                const float* g = (w == 0) ? nullptr : ln_g + lnidx * DM; const float* b = (w == 0) ? nullptr : ln_b + lnidx * DM;
                float* c1 = (w == 0) ? nullptr : misc + MC_WIN + w * 2 * 5632;
                prep_weight_item(w_in + (size_t)w * DM * 2 * FF, DM, 2 * FF, (grp >> 3) * 128 + (grp & 3) * 32 + ((grp >> 2) & 1) * 4, -2, g, b, Win + (size_t)w * 2 * FF * DM, grp * 32, c1, c1 + 5632, scr, lane, kc * 256, kc * 256 + 256);
                continue; }
            r -= 2816;
            if (r < 1408) { const int w = r / 352, grp = (r % 352) / 11, kc = r % 11;
                prep_weight_item(w_dn + (size_t)w * FF * DM, FF, DM, grp * 32, -1, nullptr, nullptr, Wdn + (size_t)w * DM * FF, grp * 32, nullptr, nullptr, scr, lane, kc * 256, kc * 256 + 256);
                continue; }
            r -= 1408;
            const int kc = r & 3; r >>= 2;
            if (r < 96) { prep_weight_item(w_qkva, DM, 3072, r * 32, -1, ln_g + 0 * DM, ln_b + 0 * DM, Wqkva, r * 32, misc + MC_QKVA, misc + MC_QKVA + 3072, scr, lane, kc * 256, kc * 256 + 256); continue; }
            r -= 96;
            if (r < 32) { prep_weight_item(w_oa, DM, DM, r * 32, -1, nullptr, nullptr, Woa, r * 32, nullptr, nullptr, scr, lane, kc * 256, kc * 256 + 256); continue; }
            r -= 32;
            if (r < 48) { int cb0, cb1; if (r < 40) { cb0 = (r >> 1) * 64 + 16 * (r & 1); cb1 = cb0 + 32; } else { cb0 = r * 32; cb1 = cb0 + 16; }
                prep_weight_item(w_qkvb, DM, 1536, cb0, cb1, ln_g + 3 * DM, ln_b + 3 * DM, Wqkvb, r * 32, misc + MC_QKVB, misc + MC_QKVB + 1536, scr, lane, kc * 256, kc * 256 + 256); continue; }
            r -= 48;
            prep_weight_item(w_ob, DM, DM, r * 32, -1, nullptr, nullptr, Wob, r * 32, nullptr, nullptr, scr, lane, kc * 256, kc * 256 + 256);
        }
        for (long i0 = gt; i0 < (long)MT * 128; i0 += 8 * NGT) {
            f32x4 a[8], b[8];
#pragma unroll
            for (int u = 0; u < 8; ++u) { const long i = i0 + (long)u * NGT; if (i < (long)MT * 128) { const int row = (int)(i >> 7), c8 = (int)(i & 127);
                const float* src = (row < MP ? x_p + (size_t)row * DM : x_s + (size_t)(row - MP) * DM) + c8 * 8; a[u] = *(const f32x4*)src; b[u] = *(const f32x4*)(src + 4); } }
#pragma unroll
            for (int u = 0; u < 8; ++u) { const long i = i0 + (long)u * NGT; if (i < (long)MT * 128) { const int row = (int)(i >> 7), c8 = (int)(i & 127);
                u32x4 o; o.x = pk2(a[u][0], a[u][1]); o.y = pk2(a[u][2], a[u][3]); o.z = pk2(b[u][0], b[u][1]); o.w = pk2(b[u][2], b[u][3]);
                *(u32x4*)(Zb + (size_t)row * ZLD + c8 * 8) = o; } }
        }
        for (long i = gt; i < 2064 * 32; i += NGT) {
            const int pos = (int)(i >> 5), fi = (int)(i & 31);
            const double a = (double)pos * ROPE_INV[fi];
            const double n = __builtin_floor(a * 0.15915494309189535);
            const float rr = (float)__builtin_fma(-n, 6.283185307179586, a);
            rope[2 * i] = cosf(rr); rope[2 * i + 1] = sinf(rr);
        }
        for (long i0 = gt; i0 < 16L * 544 * 128; i0 += 4 * NGT) {
            f32x4 ka[4], kc[4];
#pragma unroll
            for (int u = 0; u < 4; ++u) { const long i = i0 + (long)u * NGT; ka[u] = (f32x4){0.f, 0.f, 0.f, 0.f}; kc[u] = ka[u];
                if (i < 16L * 544 * 128) { const int c8 = (int)(i & 127); const int bp = (int)(i >> 7); const int b = bp / 544, pos = bp % 544;
                    if (pos < 512) { const float* src = cak + ((size_t)(b * 512 + pos) * DM + c8 * 8); ka[u] = *(const f32x4*)src; kc[u] = *(const f32x4*)(src + 4); } } }
#pragma unroll
            for (int u = 0; u < 4; ++u) { const long i = i0 + (long)u * NGT;
                if (i < 16L * 544 * 128) { const int c8 = (int)(i & 127); const int bp = (int)(i >> 7); const int pos = bp % 544;
                    u32x4 o; o.x = pk2(ka[u][0], ka[u][1]); o.y = pk2(ka[u][2], ka[u][3]); o.z = pk2(kc[u][0], kc[u][1]); o.w = pk2(kc[u][2], kc[u][3]);
                    if (pos < 512 || pos >= 528) *(u32x4*)(Ksa + (size_t)bp * DM + c8 * 8) = o; } }
        }
        for (long i0 = gt; i0 < 16L * 16 * 68 * 64; i0 += 2 * NGT) {
            float v[2][8];
#pragma unroll
            for (int u = 0; u < 2; ++u) { const long i = i0 + (long)u * NGT;
#pragma unroll
                for (int e = 0; e < 8; ++e) v[u][e] = 0.f;
                if (i < 16L * 16 * 68 * 64) { const int d = (int)(i & 63); long t = i >> 6; const int p8 = (int)(t % 68); t /= 68; const int h = (int)(t & 15), b = (int)(t >> 4);
                    if (p8 < 64) {
#pragma unroll
                        for (int e = 0; e < 8; ++e) v[u][e] = cav[((size_t)(b * 512 + p8 * 8 + e) * 16 + h) * 64 + d]; } } }
#pragma unroll
            for (int u = 0; u < 2; ++u) { const long i = i0 + (long)u * NGT;
                if (i < 16L * 16 * 68 * 64) { const int d = (int)(i & 63); long t = i >> 6; const int p8 = (int)(t % 68); t /= 68; const int h = (int)(t & 15), b = (int)(t >> 4);
                    u32x4 o; o.x = pk2(v[u][0], v[u][1]); o.y = pk2(v[u][2], v[u][3]); o.z = pk2(v[u][4], v[u][5]); o.w = pk2(v[u][6], v[u][7]);
                    if (p8 < 64 || p8 >= 66) *(u32x4*)(Vtsa + ((size_t)((b * 16 + h) * 64 + d) * 544 + p8 * 8)) = o; } }
        }
        for (long i = gt; i < 16L * 160 * 32; i += NGT) {
            const int c8 = (int)(i & 31); const int bp = (int)(i >> 5); const int b = bp / 160, pos = bp % 160;
            u32x4 o = (u32x4){0u, 0u, 0u, 0u};
            if (pos < 128) { const float* src = cbk + ((size_t)(b * 128 + pos) * 256 + c8 * 8); const f32x4 a = *(const f32x4*)src, c = *(const f32x4*)(src + 4);
                o.x = pk2(a[0], a[1]); o.y = pk2(a[2], a[3]); o.z = pk2(c[0], c[1]); o.w = pk2(c[2], c[3]); }
            if (pos < 128 || pos >= 144) *(u32x4*)(Ksb + (size_t)bp * 256 + c8 * 8) = o;
        }
        for (long i = gt; i < 16L * 4 * 20 * 64; i += NGT) {
            const int d = (int)(i & 63); long t = i >> 6; const int p8 = (int)(t % 20); t /= 20; const int h = (int)(t & 3), b = (int)(t >> 2);
            u32x4 o = (u32x4){0u, 0u, 0u, 0u};
            if (p8 < 16) { float v[8];
#pragma unroll
                for (int e = 0; e < 8; ++e) v[e] = cbv[((size_t)(b * 128 + p8 * 8 + e) * 4 + h) * 64 + d];
                o.x = pk2(v[0], v[1]); o.y = pk2(v[2], v[3]); o.z = pk2(v[4], v[5]); o.w = pk2(v[6], v[7]); }
            if (p8 < 16 || p8 >= 18) *(u32x4*)(Vtsb + ((size_t)((b * 4 + h) * 64 + d) * 160 + p8 * 8)) = o;
        }
    }
    SEAM(0); PROBE_MARK(0);

#pragma unroll 1
    for (int s = 0; s < 14; ++s) {
        if (IN(s + 1)) {
            const int L = s / 7, k = s % 7;
            const int c = 3 * L + (k > 1) + (k > 4);
            if (false) {}
#ifndef NO_SW
            else if (k == 0 || k == 5)
#pragma unroll 1
            for (int rep = 0; rep < ((PROBE_DUP & 2) ? 2 : 1); ++rep) {
                const int w = 2 * L + (k == 5);
                pg8::Gemm g{Zb, Win + (size_t)w * 2 * FF * DM, MP, 2 * FF, DM, ZLD}; pg8::StaticOrder S; S.init(MP, 2 * FF, G, bid);
                pg8::EpiSwiglu E{w, c};
                pg8::small_gemm<pg8::EpiSwiglu>(lds, g.A, g.lda, g.Bt, g.N, g.K, E);
                pg8::gemm_phase<pg8::EpiSwiglu, pg8::StaticOrder, true, true>(lds, g, S, E);
            }
#endif
#ifndef NO_RES
            else if (k == 1 || k == 6 || k == 4) {
                const bool wo = (k == 4);
                const bf16_t* Bt = wo ? (L == 0 ? Woa : Wob) : Wdn + (size_t)(2 * L + (k == 6)) * DM * FF;
                pg8::Gemm g{wo ? Qb : Hb, Bt, MP, DM, wo ? DM : FF, wo ? QLD : FF}; pg8::StaticOrder S; S.init(MP, DM, G, bid);
                pg8::EpiResid E{c, wo ? 1.0f : 0.5f};
                pg8::small_gemm<pg8::EpiResid>(lds, g.A, g.lda, g.Bt, g.N, g.K, E);
                pg8::gemm_phase<pg8::EpiResid, pg8::StaticOrder, true, true>(lds, g, S, E);
            }
#endif
#ifndef NO_QKV
            else if (k == 2)
#pragma unroll 1
            for (int rep = 0; rep < ((PROBE_DUP & 16) ? 2 : 1); ++rep) {
                if (L == 0) {
                    pg8::Gemm g{Zb, Wqkva, MP, 3072, DM, ZLD}; pg8::StaticOrder S; S.init(MP, 3072, G, bid);
                    pg8::EpiQkvA E{c};
                    pg8::small_gemm<pg8::EpiQkvA>(lds, g.A, g.lda, g.Bt, g.N, g.K, E);
                    pg8::gemm_phase<pg8::EpiQkvA, pg8::StaticOrder, true, true>(lds, g, S, E);
                } else {
                    pg8::Gemm g{Zb, Wqkvb, MP, 1536, DM, ZLD}; pg8::StaticOrder S; S.init(MP, 1536, G, bid);
                    pg8::EpiQkvB E{c};
                    pg8::small_gemm<pg8::EpiQkvB>(lds, g.A, g.lda, g.Bt, g.N, g.K, E);
                    pg8::gemm_phase<pg8::EpiQkvB, pg8::StaticOrder, true, true>(lds, g, S, E);
                }
            }
#endif
#ifndef NO_ATT
            else
#pragma unroll 1
            for (int rep = 0; rep < ((PROBE_DUP & 4) ? 2 : 1); ++rep) {
                bf16_t* Ob = ((PROBE_DUP & 4) && rep == 0) ? (bf16_t*)(WSP + WS_DUMMY_O) : Qb;
                int tid_o2 = threadIdx.x; asm volatile("" : "+v"(tid_o2)); const int tid2 = tid_o2, lane = tid2 & 63;
                unsigned* qctr = (unsigned*)WSP + 4000 + 64 * L + 16 * rep;
                volatile LAS unsigned* qslot = (volatile LAS unsigned*)(lds + 131072 + 16);
                for (;;) {
                    __syncthreads();
                    if (tid2 == 0) *qslot = __hip_atomic_fetch_add(qctr, 1u, __ATOMIC_RELAXED, __HIP_MEMORY_SCOPE_AGENT);
                    __syncthreads();
                    const int qi = (int)*qslot;
                    if (qi >= 2048 + 32) break;
                    const int bu = qi < 32 ? 2048 + qi : qi - 32;
                    if (bu < 2048) {
                        if (L == 0) attn_block_a(lds, Qb, Kpb, Vtpb, Ob, relb + ((bu >> 3) & 15) * 257, bu >> 7, (bu >> 3) & 15, (bu & 7) * 4, tid2, wave, lane);
                        else attn_block_b(lds, Qb, Kpb, Vtpb, Ob, sinks, bu >> 7, (bu >> 5) & 3, bu & 31, tid2, wave, lane);
                    } else {
                        __syncthreads();
                        const int wu = (bu - 2048) * 8 + wave, b = wu >> 4, h = wu & 15; const size_t row0 = (size_t)MP + b * 16;
                        if (L == 0) attn_wave<true, true>(Qb + row0 * QLD + h * 64, QLD, 16, Ksa + (size_t)b * 544 * DM + h * 64, DM, Vtsa + (size_t)((b * 16 + h) * 64) * 544, 544,
                                                          0, 9, 16, 528, 512, relb + h * 257, (LAS float*)(lds + 6 * 16384 + wave * 2048), 0.f, Ob + row0 * QLD + h * 64, QLD, lane);
                        else { const int kvh = h >> 2;
                               attn_wave<false, true>(Qb + row0 * QLD + h * 64, QLD, 16, Ksb + (size_t)b * 160 * 256 + kvh * 64, 256, Vtsb + (size_t)((b * 4 + kvh) * 64) * 160, 160,
                                                      0, 3, 4, 144, 0, nullptr, nullptr, sinks[h], Ob + row0 * QLD + h * 64, QLD, lane); }
                    }
                }
            }
#endif
        }
        SEAM(s + 1); PROBE_MARK(s + 1);
    }
    if (IN(15)) {
        const int gw = bid * 8 + wave, NGW = G * 8;
        const float* g = ln_g + 5 * DM; const float* b = ln_b + 5 * DM;
        f32x4 gv[4], bv[4];
#pragma unroll
        for (int j = 0; j < 4; ++j) { gv[j] = *(const f32x4*)(g + 4 * lane + 256 * j); bv[j] = *(const f32x4*)(b + 4 * lane + 256 * j); }
        for (int row0 = gw; row0 < MT; row0 += 4 * NGW) {
            f32x4 v[4][4];
#pragma unroll
            for (int u = 0; u < 4; ++u) { const int row = row0 + u * NGW;
                if (row < MT) { const bf16_t* zb = Zb + (size_t)row * ZLD + 4 * lane;
#pragma unroll
                    for (int j = 0; j < 4; ++j) { const u32x2 zz = *(const u32x2*)(zb + 256 * j);
                        v[u][j] = (f32x4){__builtin_bit_cast(float, zz.x << 16), __builtin_bit_cast(float, zz.x & 0xffff0000u), __builtin_bit_cast(float, zz.y << 16), __builtin_bit_cast(float, zz.y & 0xffff0000u)}; } }
                else {
#pragma unroll
                    for (int j = 0; j < 4; ++j) v[u][j] = (f32x4){0.f, 0.f, 0.f, 0.f}; } }
#pragma unroll
            for (int u = 0; u < 4; ++u) { const int row = row0 + u * NGW;
                float s = 0.f;
#pragma unroll
                for (int j = 0; j < 4; ++j) s += (v[u][j][0] + v[u][j][1]) + (v[u][j][2] + v[u][j][3]);
                const float mean = wave_sum(s) * (1.0f / DM); float s2 = 0.f;
#pragma unroll
                for (int j = 0; j < 4; ++j) { v[u][j] = v[u][j] - mean; s2 += (v[u][j][0] * v[u][j][0] + v[u][j][1] * v[u][j][1]) + (v[u][j][2] * v[u][j][2] + v[u][j][3] * v[u][j][3]); }
                const float rstd = __builtin_amdgcn_rsqf(wave_sum(s2) * (1.0f / DM) + 1e-5f);
                if (row < MT) { float* zr = out + (size_t)row * DM + 4 * lane;
#pragma unroll
                    for (int j = 0; j < 4; ++j) *(f32x4*)(zr + 256 * j) = v[u][j] * rstd * gv[j] + bv[j]; } }
        }
    }
    if (PROBE_SPIN_MASK != 0u) { PROBE_MARK(15);
        if (bid == 0) { const unsigned long long tend = __builtin_amdgcn_s_memrealtime() + (unsigned long long)PROBE_SPIN_MULT * pr_acc; while (__builtin_amdgcn_s_memrealtime() < tend) __builtin_amdgcn_s_sleep(16); } }
#undef IN
#undef SEAM
}

#undef AIN
#undef x_p
#undef x_s
#undef cak
#undef cav
#undef cbk
#undef cbv
#undef ln_g
#undef ln_b
#undef w_in
#undef w_dn
#undef w_qkva
#undef w_oa
#undef relb
#undef w_qkvb
#undef w_ob
#undef sinks
#undef out
#undef WSP
#undef Win
#undef Wdn
#undef Wqkva
#undef Woa
#undef Wqkvb
#undef Wob
#undef misc
#undef stA
#undef stB
#undef Zb
#undef Ksa
#undef Vtsa
#undef Ksb
#undef Vtsb
#undef Hb
#undef Qb
#undef Kpb
#undef Vtpb
#undef rope
#ifndef N_LAUNCH_MODE
#define N_LAUNCH_MODE 1
#endif
extern "C" void kernel_launch(void* const* d_in, const int* in_sizes, int n_in, void* d_out, int out_size, void* d_ws, size_t ws_size, hipStream_t stream) {
    static int grid = 0;
    if (grid == 0) {
        if (n_in != 16 || ws_size < WS_END || (size_t)out_size != OUT_END) { fprintf(stderr, "kernel_launch: unexpected problem (n_in %d, out %d, ws %zu)\n", n_in, out_size, ws_size); grid = -1; return; }
        int dev = 0, cus = 0, per_cu = 0;
        (void)hipGetDevice(&dev); (void)hipDeviceGetAttribute(&cus, hipDeviceAttributeMultiprocessorCount, dev);
        if (hipFuncSetAttribute((const void*)fwd_kernel, hipFuncAttributeMaxDynamicSharedMemorySize, LDS_BYTES) != hipSuccess) { fprintf(stderr, "kernel_launch: hipFuncSetAttribute failed\n"); grid = -1; return; }
        if (hipOccupancyMaxActiveBlocksPerMultiprocessor(&per_cu, (const void*)fwd_kernel, 512, LDS_BYTES) != hipSuccess || per_cu < 1) { fprintf(stderr, "kernel_launch: occupancy query gave %d\n", per_cu); per_cu = 1; }
        (void)hipGetLastError();
        grid = cus * per_cu;
        fprintf(stderr, "kernel_launch: grid %d (cus %d x %d)\n", grid, cus, per_cu);
    }
    if (grid < 0) return;
    if (hipMemsetAsync(d_ws, 0, 16384, stream) != hipSuccess) { fprintf(stderr, "kernel_launch: memset failed\n"); return; }
    if (hipMemsetAsync((char*)d_ws + WS_MISC, 0, (size_t)MC_ROPE * 4, stream) != hipSuccess) { fprintf(stderr, "kernel_launch: memset failed\n"); return; }
    Args a{};
    for (int i = 0; i < 16; ++i) a.in[i] = (const float*)d_in[i];
    a.out = (float*)d_out; a.ws = (unsigned char*)d_ws;
    if (N_LAUNCH_MODE == 1) {
        a.ph_lo = 0; a.ph_hi = N_PHASES;
        void* kargs[] = {&a};
        hipError_t e = hipLaunchCooperativeKernel((const void*)fwd_kernel, dim3(grid), dim3(512), kargs, LDS_BYTES, stream);
        if (e != hipSuccess) fprintf(stderr, "cooperative launch failed: %s (grid %d)\n", hipGetErrorString(e), grid);
    } else {
        for (int p = 0; p < N_PHASES; ++p) { a.ph_lo = p; a.ph_hi = p + 1; hipLaunchKernelGGL(fwd_kernel, dim3(grid), dim3(512), LDS_BYTES, stream, a); }
    }
}
```

```cpp
#include <hip/hip_runtime.h>
#include <hip/hip_cooperative_groups.h>
#include <cstdio>
#include <cstdint>
namespace cg = cooperative_groups;
namespace pg8 {
#define PG8_LAS __attribute__((address_space(3)))
typedef unsigned short bf16_t;
typedef short bf16x8 __attribute__((ext_vector_type(8)));
typedef float f32x4 __attribute__((ext_vector_type(4)));
typedef unsigned u32x4 __attribute__((ext_vector_type(4)));
constexpr int BM = 256, BK = 64, HALF = 128, HTB = HALF * BK * 2  , STAGE_BYTES = 8 * HTB, NXCD = 8, WGM = 8;

__host__ __device__ __forceinline__ int lds_byte(int r, int c) { const int st = (r >> 4) * 2 + (c >> 5), rr = r & 15, cc = c & 31, ob = rr * 64 + cc * 2; return st * 1024 + (ob ^ (((ob >> 9) & 1) << 5)); }
__host__ __device__ __forceinline__ void stage_rc(int b, int& R, int& C) { const int st = b / 1024, sb = b % 1024, swz = sb ^ (((sb >> 9) & 1) << 5); R = (st >> 1) * 16 + swz / 64; C = (st & 1) * 32 + (swz % 64) / 2; }
__host__ __device__ __forceinline__ int perm32(int rho) { const int n = rho >> 4, i = rho & 15; return 8 * (i >> 2) + 4 * n + (i & 3); }

struct Unit { int pm, pn; };
struct Gemm { const bf16_t* A; const bf16_t* Bt; int M, N, K, lda; };

struct StaticOrder {
    int nM, nN, nwg, G, c;
    __host__ __device__ void init(int M, int N, int G_, int c_) { nM = M / BM; nN = N / BM; nwg = nM * nN; G = G_; c = c_; }
    __host__ __device__ bool next(int i, Unit& u) const {
        const long L = (long)i * G + c; if (L >= nwg) return false;
        int wgid = (int)L; { const int q = nwg / NXCD, r = nwg % NXCD, xcd = wgid % NXCD, off = wgid / NXCD; wgid = (xcd < r ? xcd * (q + 1) : r * (q + 1) + (xcd - r) * q) + off; }
        const int nig = WGM * nN, gid = wgid / nig, fm = gid * WGM, gsz = (nM - fm) < WGM ? (nM - fm) : WGM;
        u.pn = (wgid % nig) / gsz; u.pm = fm + ((wgid % nig) % gsz + u.pn) % gsz; return true;
    }
    __device__ __forceinline__ void a_ready(const Unit&) const {}
    __device__ __forceinline__ void done(const Unit&) const {}
};

__device__ __forceinline__ unsigned cvt_pk_bf16(float lo, float hi) { unsigned r; asm volatile("v_cvt_pk_bf16_f32 %0, %1, %2" : "=v"(r) : "v"(lo), "v"(hi)); return r; }
template <class Epi, class Sched, bool ALIGN_EPI = false, bool SP2 = false>
__device__ __forceinline__ void gemm_phase(PG8_LAS unsigned char* lds, const Gemm g, const Sched& S, const Epi& E) {
    int tid_o = threadIdx.x; asm volatile("" : "+v"(tid_o));
    const int tid = tid_o, wid = __builtin_amdgcn_readfirstlane(tid >> 6), lane = tid & 63, wr = wid >> 2, wc = wid & 3, fr = lane & 15, fq = lane >> 4;
    const int K = g.K, nt = K / BK;
    static_assert(!Epi::PERM, "this copy of the body stages natural row order only");
    unsigned voffA, voffB;
    { int R, C; stage_rc(tid * 16, R, C); voffA = (unsigned)(R * g.lda + C) * 2u; voffB = (unsigned)(R * K + C) * 2u; }
    const size_t rstepA = (size_t)64 * g.lda * 2, rstepB = (size_t)64 * K * 2;
    const size_t kstep = (size_t)(BK * 2);
    const size_t hstep = (size_t)HALF * K * 2, hstepA = (size_t)HALF * g.lda * 2;
    const size_t tstep = 2 * hstep, tstepA = 2 * hstepA;
    const unsigned ldsw = (unsigned)wid * 1024u;
    const int aoff = lds_byte(wr * 64 + fr, fq * 8), boff = lds_byte(wc * 32 + fr, fq * 8);
#define PG8_SA(b, h) (((b) * 2 + (h)) * HTB)
#define PG8_SB(b, h) ((4 + (b) * 2 + (h)) * HTB)
#define PG8_STAGE(bufoff, gbase, X) do { _Pragma("unroll") for (int _i = 0; _i < 2; ++_i) \
        __builtin_amdgcn_global_load_lds((const unsigned*)((const char*)(gbase) + (size_t)_i * rstep##X + voff##X), (PG8_LAS unsigned*)(lds + (bufoff) + ldsw + _i * 8192), 16, 0, 0); } while (0)
#define PG8_LDA(dst, b, h) do { _Pragma("unroll") for (int m = 0; m < 4; ++m) _Pragma("unroll") for (int k = 0; k < 2; ++k) dst[m][k] = *(const PG8_LAS bf16x8*)(lds + PG8_SA(b, h) + aoff + m * 2048 + k * 1024); } while (0)
#define PG8_LDB(dst, b, h) do { _Pragma("unroll") for (int n = 0; n < 2; ++n) _Pragma("unroll") for (int k = 0; k < 2; ++k) dst[n][k] = *(const PG8_LAS bf16x8*)(lds + PG8_SB(b, h) + boff + n * 2048 + k * 1024); } while (0)
#define PG8_MMA(ai, bj, At, Bt) do { __builtin_amdgcn_s_setprio(1); _Pragma("unroll") for (int m = 0; m < 4; ++m) _Pragma("unroll") for (int n = 0; n < 2; ++n) _Pragma("unroll") for (int k = 0; k < 2; ++k) \
        acc[ai][bj][m][n] = __builtin_amdgcn_mfma_f32_16x16x32_bf16(Bt[n][k], At[m][k], acc[ai][bj][m][n], 0, 0, 0); __builtin_amdgcn_s_setprio(0); } while (0)
#define PG8_WAIT_V(n) asm volatile("s_waitcnt vmcnt(" #n ")" ::: "memory")
#define PG8_WAIT_L(n) asm volatile("s_waitcnt lgkmcnt(" #n ")" ::: "memory")
#define PG8_BAR __builtin_amdgcn_s_barrier()
#define PG8_SCHED __builtin_amdgcn_sched_barrier(0)
    Unit cur, nxt; int ui = 0;
    if (!S.next(0, cur)) return;
    f32x4 acc[2][2][4][2];
#pragma unroll
    for (int a = 0; a < 2; ++a)
#pragma unroll
        for (int b = 0; b < 2; ++b)
#pragma unroll
            for (int m = 0; m < 4; ++m)
#pragma unroll
                for (int n = 0; n < 2; ++n) acc[a][b][m][n] = (f32x4){0.f, 0.f, 0.f, 0.f};
    bf16x8 At[4][2], B0[2][2], B1[2][2];
    const char* cA = (const char*)g.A + (size_t)cur.pm * tstepA; const char* cB = (const char*)g.Bt + (size_t)cur.pn * tstep;
    S.a_ready(cur);
    if constexpr (SP2) {
        PG8_STAGE(PG8_SB(0, 0), cB, B); PG8_STAGE(PG8_SB(0, 1), cB + hstep, B); PG8_STAGE(PG8_SA(0, 0), cA, A); PG8_STAGE(PG8_SA(0, 1), cA + hstepA, A);
        if (wr == 1) PG8_BAR;
        PG8_WAIT_V(2); PG8_BAR;
        PG8_STAGE(PG8_SB(1, 0), cB + kstep, B); PG8_STAGE(PG8_SA(1, 0), cA + kstep, A); PG8_STAGE(PG8_SB(1, 1), cB + hstep + kstep, B);
        PG8_WAIT_V(6); PG8_BAR;
    } else {
        PG8_STAGE(PG8_SB(0, 0), cB, B); PG8_STAGE(PG8_SA(0, 0), cA, A); PG8_STAGE(PG8_SB(0, 1), cB + hstep, B); PG8_STAGE(PG8_SA(0, 1), cA + hstepA, A);
        if (wr == 1) PG8_BAR;
        PG8_WAIT_V(4); PG8_BAR;
        PG8_STAGE(PG8_SB(1, 0), cB + kstep, B); PG8_STAGE(PG8_SA(1, 0), cA + kstep, A); PG8_STAGE(PG8_SB(1, 1), cB + hstep + kstep, B);
        PG8_WAIT_V(6); PG8_BAR;
    }
    for (;;) {
        const bool has_next = S.next(ui + 1, nxt);
        const char* nA = has_next ? (const char*)g.A + (size_t)nxt.pm * tstepA : cA; const char* nB = has_next ? (const char*)g.Bt + (size_t)nxt.pn * tstep : cB;
        for (int t = 0; t < nt; t += 2) {
            const bool last = (t == nt - 2);
            const char* a1 = cA + (size_t)(t + 1) * kstep;
            const char* a2 = last ? nA : cA + (size_t)(t + 2) * kstep; const char* b2 = last ? nB : cB + (size_t)(t + 2) * kstep;
            const char* a3 = a2 + kstep; const char* b3 = b2 + kstep;
            if (last && has_next) S.a_ready(nxt);
            if constexpr (SP2) {
            PG8_LDB(B0, 0, 0); PG8_LDB(B1, 0, 1); PG8_SCHED; PG8_LDA(At, 0, 0); PG8_STAGE(PG8_SA(1, 1), a1 + hstepA, A);
            PG8_WAIT_V(8); PG8_WAIT_L(0); PG8_BAR; PG8_MMA(0, 0, At, B0); PG8_MMA(0, 1, At, B1); PG8_BAR; PG8_SCHED;
            PG8_LDA(At, 0, 1); PG8_STAGE(PG8_SB(0, 0), b2, B); PG8_STAGE(PG8_SB(0, 1), b2 + hstep, B); PG8_STAGE(PG8_SA(0, 0), a2, A);
            PG8_WAIT_V(8); PG8_WAIT_L(0); PG8_BAR; PG8_MMA(1, 0, At, B0); PG8_MMA(1, 1, At, B1); PG8_BAR; PG8_SCHED;
            PG8_LDB(B0, 1, 0); PG8_LDB(B1, 1, 1); PG8_SCHED; PG8_LDA(At, 1, 0); PG8_STAGE(PG8_SA(0, 1), a2 + hstepA, A);
            PG8_WAIT_V(8); PG8_WAIT_L(0); PG8_BAR; PG8_MMA(0, 0, At, B0); PG8_MMA(0, 1, At, B1); PG8_BAR; PG8_SCHED;
            PG8_LDA(At, 1, 1); PG8_STAGE(PG8_SB(1, 0), b3, B); PG8_STAGE(PG8_SB(1, 1), b3 + hstep, B); PG8_STAGE(PG8_SA(1, 0), a3, A);
            PG8_WAIT_V(8); PG8_WAIT_L(0); PG8_BAR; PG8_MMA(1, 0, At, B0); PG8_MMA(1, 1, At, B1); PG8_BAR; PG8_SCHED;
            } else {
            PG8_LDB(B0, 0, 0); PG8_SCHED; PG8_LDA(At, 0, 0); PG8_STAGE(PG8_SA(1, 1), a1 + hstepA, A);
            PG8_WAIT_L(8); PG8_BAR; PG8_WAIT_L(0); PG8_MMA(0, 0, At, B0); PG8_BAR; PG8_SCHED;
            PG8_LDB(B1, 0, 1); PG8_STAGE(PG8_SB(0, 0), b2, B);
            PG8_BAR; PG8_WAIT_L(0); PG8_MMA(0, 1, At, B1); PG8_BAR;
            PG8_LDA(At, 0, 1); PG8_STAGE(PG8_SA(0, 0), a2, A);
            PG8_BAR; PG8_WAIT_L(0); PG8_MMA(1, 0, At, B0); PG8_BAR; PG8_SCHED;
            PG8_STAGE(PG8_SB(0, 1), b2 + hstep, B);
            PG8_WAIT_V(6); PG8_BAR; PG8_MMA(1, 1, At, B1); PG8_BAR;
            PG8_LDB(B0, 1, 0); PG8_SCHED; PG8_LDA(At, 1, 0); PG8_STAGE(PG8_SA(0, 1), a2 + hstepA, A);
            PG8_WAIT_L(8); PG8_BAR; PG8_WAIT_L(0); PG8_MMA(0, 0, At, B0); PG8_BAR; PG8_SCHED;
            PG8_LDB(B1, 1, 1); PG8_STAGE(PG8_SB(1, 0), b3, B);
            PG8_BAR; PG8_WAIT_L(0); PG8_MMA(0, 1, At, B1); PG8_BAR;
            PG8_LDA(At, 1, 1); PG8_STAGE(PG8_SA(1, 0), a3, A);
            PG8_BAR; PG8_WAIT_L(0); PG8_MMA(1, 0, At, B0); PG8_BAR; PG8_SCHED;
            PG8_STAGE(PG8_SB(1, 1), b3 + hstep, B);
            PG8_WAIT_V(6); PG8_BAR; PG8_MMA(1, 1, At, B1); PG8_BAR;
            }
        }
        if constexpr (ALIGN_EPI) { if (wr == 0) PG8_BAR; }
        if constexpr (!Epi::AFTER_DRAIN) { E(acc, cur, wr, wc, fr, fq); S.done(cur); }
        if (!has_next) break;
#pragma unroll
        for (int a = 0; a < 2; ++a)
#pragma unroll
            for (int b = 0; b < 2; ++b)
#pragma unroll
                for (int m = 0; m < 4; ++m)
#pragma unroll
                    for (int n = 0; n < 2; ++n) acc[a][b][m][n] = (f32x4){0.f, 0.f, 0.f, 0.f};
        cur = nxt; cA = nA; cB = nB; ++ui;
        if constexpr (ALIGN_EPI) { if (wr == 1) PG8_BAR; }
    }
    PG8_WAIT_V(0);
    if constexpr (!ALIGN_EPI) { if (wr == 0) PG8_BAR; }
    PG8_BAR;
    if constexpr (Epi::AFTER_DRAIN) { E.fused(acc, cur, wr, wc, fr, fq, lds, wid, lane); S.done(cur); }
#undef PG8_SA
#undef PG8_SB
#undef PG8_STAGE
#undef PG8_LDA
#undef PG8_LDB
#undef PG8_MMA
#undef PG8_WAIT_V
#undef PG8_WAIT_L
#undef PG8_BAR
#undef PG8_SCHED
}
}
constexpr int DM = 1024, FF = 2816, MP = 32768, MS = 256, MT = MP + MS, SEQ = 2048;
constexpr int ZLD = 1088, QLD = 1088, KBLD = 288;
constexpr float ALPHA = 1.4142135623730951f;
constexpr float LOG2E = 1.4426950408889634f;
typedef pg8::bf16_t bf16_t;
typedef pg8::bf16x8 bf16x8;
typedef pg8::f32x4 f32x4;
typedef pg8::u32x4 u32x4;
typedef float f32x2v __attribute__((ext_vector_type(2)));
typedef float f32x16 __attribute__((ext_vector_type(16)));
typedef unsigned u32x2 __attribute__((ext_vector_type(2)));
#define LAS __attribute__((address_space(3)))

constexpr size_t MiB = 1u << 20;
constexpr size_t WS_WIN = 1 * MiB;
constexpr size_t WS_WDN = 45 * MiB;
constexpr size_t WS_WQKVA = 67 * MiB;
constexpr size_t WS_WOA = 73 * MiB;
constexpr size_t WS_WQKVB = 75 * MiB;
constexpr size_t WS_WOB = 78 * MiB;
constexpr size_t WS_MISC = 80 * MiB;
constexpr size_t WS_STA = 82 * MiB;
constexpr size_t WS_STB = 87 * MiB;
constexpr size_t WS_ZB = 92 * MiB;
constexpr size_t WS_KSA = 161 * MiB;
constexpr size_t WS_VTSA = 178 * MiB;
constexpr size_t WS_KSB = 195 * MiB;
constexpr size_t WS_VTSB = 197 * MiB;
constexpr size_t WS_BIG = 199 * MiB;
constexpr size_t BIG_K = (size_t)MT * QLD * 2, BIG_VT = BIG_K + (size_t)MP * QLD * 2;
constexpr size_t WS_END = 404 * MiB, WS_DUMMY_O = 420 * MiB;
static_assert(BIG_VT + (size_t)MP * QLD * 2 <= WS_END - WS_BIG && (size_t)MT * FF * 2 <= WS_END - WS_BIG && WS_ZB + (size_t)MT * ZLD * 2 <= WS_KSA, "workspace map");
constexpr int MC_WIN = 0;
constexpr int MC_QKVA = 4 * 2 * 5632;
constexpr int MC_QKVB = MC_QKVA + 2 * 3072;
constexpr int MC_ROPE = MC_QKVB + 2 * 1536;
constexpr int LDS_BYTES = 131072 + 64;
struct Args { const float* in[16]; float* out; unsigned char* ws; int ph_lo, ph_hi; };
typedef const __attribute__((address_space(4))) Args* ArgsP;
__device__ __forceinline__ ArgsP get_args() { ArgsP p = (ArgsP)__builtin_amdgcn_kernarg_segment_ptr(); asm volatile("" : "+s"(p)); return p; }
constexpr size_t OUT_YP = 0, OUT_YS = (size_t)MP * DM, OUT_AKP = OUT_YS + (size_t)MS * DM, OUT_AVP = OUT_AKP + (size_t)16 * 512 * 1024, OUT_BKP = OUT_AVP + (size_t)16 * 512 * 1024,
                 OUT_BVP = OUT_BKP + (size_t)16 * 128 * 256, OUT_AKS = OUT_BVP + (size_t)16 * 128 * 256, OUT_AVS = OUT_AKS + (size_t)16 * 16 * 1024, OUT_BKS = OUT_AVS + (size_t)16 * 16 * 1024,
                 OUT_BVS = OUT_BKS + (size_t)16 * 16 * 256, OUT_END = OUT_BVS + (size_t)16 * 16 * 256;


__device__ __forceinline__ unsigned f2bf(float f) { unsigned u = __builtin_bit_cast(unsigned, f); return (u + 0x7fffu + ((u >> 16) & 1u)) >> 16; }
__device__ __forceinline__ unsigned pk2(float lo, float hi) { return f2bf(lo) | (f2bf(hi) << 16); }
__device__ __forceinline__ float bfround(float f) { return __builtin_bit_cast(float, f2bf(f) << 16); }
__device__ __forceinline__ u32x2 pk4(f32x4 v) { u32x2 r; r.x = pg8::cvt_pk_bf16(v[0], v[1]); r.y = pg8::cvt_pk_bf16(v[2], v[3]); return r; }
__device__ __forceinline__ float wave_sum(float v) {
#pragma unroll
    for (int o = 1; o < 64; o <<= 1) v += __shfl_xor(v, o);
    return v;
}

namespace pg8 {
__device__ __forceinline__ void row_mean_rstd(const float* st, int row, int fq, float& mean, float& rstd) {
    const f32x4* p = (const f32x4*)(st + (unsigned)row * 32 + 8 * fq);
    const f32x4 a = p[0], b = p[1];
    float s = (a[0] + a[2]) + (b[0] + b[2]), q = (a[1] + a[3]) + (b[1] + b[3]);
    s += __shfl_xor(s, 16); s += __shfl_xor(s, 32); q += __shfl_xor(q, 16); q += __shfl_xor(q, 32);
    mean = s * (1.0f / 1024.0f);
    const float var = fmaxf(q * (1.0f / 1024.0f) - mean * mean, 0.f);
    rstd = __builtin_amdgcn_rsqf(var + 1e-5f);
}

#define PG8_EPI_WALK() \
    __device__ __forceinline__ void operator()(const f32x4 (&acc)[2][2][4][2], const Unit& u, int wr, int wc, int fr, int fq) const { \
        const Ctx cx = ctx(); \
        f32x4 cv[8]; load_cv(cx, u.pn, wc, fq, cv);     \
        _Pragma("unroll") for (int ai = 0; ai < 2; ++ai) _Pragma("unroll") for (int m = 0; m < 4; ++m) { \
            const int row = u.pm * 256 + ai * 128 + wr * 64 + m * 16 + fr; \
            const f32x4 v[2][2] = {{acc[ai][0][m][0], acc[ai][0][m][1]}, {acc[ai][1][m][0], acc[ai][1][m][1]}}; \
            row_op(cx, u.pm, u.pn, wc, row, fq, v, cv); } }

struct EpiSwiglu {
    static constexpr bool PERM = false, AFTER_DRAIN = false;
    int w, cnt;
    struct Ctx { bf16_t* H; const float* st; const float* c1; const float* c2; };
    __device__ __forceinline__ Ctx ctx() const {
        unsigned char* wsp = get_args()->ws; Ctx c;
        c.H = (bf16_t*)(wsp + WS_BIG); c.st = cnt == 0 ? nullptr : (const float*)(wsp + ((cnt & 1) ? WS_STA : WS_STB));
        c.c1 = (const float*)(wsp + WS_MISC) + MC_WIN + w * 2 * 5632; c.c2 = c.c1 + 5632; return c; }
    __device__ __forceinline__ void load_cv(const Ctx& cx, int pn, int wc, int fq, f32x4 (&cv)[8]) const {
        const int sb0 = pn * 256 + wc * 32 + 4 * fq;
#pragma unroll
        for (int i = 0; i < 8; ++i) cv[i] = (f32x4){0.f, 0.f, 0.f, 0.f};
        if (cx.st != nullptr) {
#pragma unroll
            for (int bj = 0; bj < 2; ++bj) { cv[4 * bj + 0] = *(const f32x4*)(cx.c1 + sb0 + bj * 128); cv[4 * bj + 1] = *(const f32x4*)(cx.c1 + sb0 + bj * 128 + 16);
                                             cv[4 * bj + 2] = *(const f32x4*)(cx.c2 + sb0 + bj * 128); cv[4 * bj + 3] = *(const f32x4*)(cx.c2 + sb0 + bj * 128 + 16); } }
    }
    __device__ __forceinline__ void row_op(const Ctx& cx, int pm, int pn, int wc, int row, int fq, const f32x4 (&v)[2][2], const f32x4 (&cv)[8]) const {
        const int sb0 = pn * 256 + wc * 32 + 4 * fq, ff0 = pn * 128 + wc * 32 + 8 * fq;
        const bool fold = (cx.st != nullptr);
        float mean = 0.f, rstd = 1.f;
        if (fold) row_mean_rstd(cx.st, row, fq, mean, rstd);
        u32x2 hp[2];
#pragma unroll
        for (int bj = 0; bj < 2; ++bj) {
            f32x4 g = v[bj][0], up = v[bj][1];
            if (fold) {
                g = (g - mean * cv[4 * bj + 0]) * rstd + cv[4 * bj + 2]; up = (up - mean * cv[4 * bj + 1]) * rstd + cv[4 * bj + 3];
            }
            f32x4 hv;
#pragma unroll
            for (int j = 0; j < 4; ++j) hv[j] = g[j] * __builtin_amdgcn_rcpf(1.0f + __builtin_amdgcn_exp2f(-LOG2E * g[j])) * up[j];
            hp[bj] = pk4(hv);
        }
        *(u32x4*)(cx.H + (unsigned)row * FF + ff0) = (u32x4){hp[0].x, hp[0].y, hp[1].x, hp[1].y};
    }
    PG8_EPI_WALK()
};

struct EpiResid {
    static constexpr bool PERM = false, AFTER_DRAIN = false;
    int cnt; float cs;
    struct Ctx { float* Z; const float* xp; const float* xs; const float* stp; const float* g; const float* b; float* stn; bf16_t* Zb; };
    __device__ __forceinline__ Ctx ctx() const {
        unsigned char* wsp = get_args()->ws; Ctx c;
        c.Z = get_args()->out; c.xp = get_args()->in[0]; c.xs = get_args()->in[1];
        c.stp = cnt == 0 ? nullptr : (const float*)(wsp + ((cnt & 1) ? WS_STA : WS_STB)); c.stn = (float*)(wsp + ((cnt & 1) ? WS_STB : WS_STA));
        const int lni = cnt > 0 ? cnt - 1 : 0;
        c.g = get_args()->in[6] + lni * DM; c.b = get_args()->in[7] + lni * DM; c.Zb = (bf16_t*)(wsp + WS_ZB); return c; }
    __device__ __forceinline__ void load_cv(const Ctx& cx, int pn, int wc, int fq, f32x4 (&cv)[8]) const {
        const int col0 = pn * 256 + wc * 32 + 8 * fq;
#pragma unroll
        for (int i = 0; i < 8; ++i) cv[i] = (f32x4){0.f, 0.f, 0.f, 0.f};
        if (cx.stp != nullptr) {
#pragma unroll
            for (int bj = 0; bj < 2; ++bj) { const int col = col0 + bj * 128;
                cv[4 * bj + 0] = *(const f32x4*)(cx.g + col); cv[4 * bj + 1] = *(const f32x4*)(cx.g + col + 4); cv[4 * bj + 2] = *(const f32x4*)(cx.b + col); cv[4 * bj + 3] = *(const f32x4*)(cx.b + col + 4); } }
    }
    __device__ __forceinline__ void row_op(const Ctx& cx, int pm, int pn, int wc, int row, int fq, const f32x4 (&v)[2][2], const f32x4 (&cv)[8]) const {
        const int col0 = pn * 256 + wc * 32 + 8 * fq;
        const bool first = (cx.stp == nullptr);
        float mean = 0.f, rstd = 1.f;
        if (!first) row_mean_rstd(cx.stp, row, fq, mean, rstd);
        const float* src = pm < 128 ? cx.xp + (unsigned)row * DM : cx.xs + (unsigned)(row - MP) * DM;
        float s = 0.f, q = 0.f;
#pragma unroll
        for (int bj = 0; bj < 2; ++bj) {
            const int col = col0 + bj * 128;
            f32x4 x0, x1;
            if (first) { x0 = *(const f32x4*)(src + col); x1 = *(const f32x4*)(src + col + 4); }
            else { const u32x4 zz = *(const u32x4*)(cx.Zb + (unsigned)row * ZLD + col);
                   x0 = (f32x4){__builtin_bit_cast(float, zz.x << 16), __builtin_bit_cast(float, zz.x & 0xffff0000u), __builtin_bit_cast(float, zz.y << 16), __builtin_bit_cast(float, zz.y & 0xffff0000u)};
                   x1 = (f32x4){__builtin_bit_cast(float, zz.z << 16), __builtin_bit_cast(float, zz.z & 0xffff0000u), __builtin_bit_cast(float, zz.w << 16), __builtin_bit_cast(float, zz.w & 0xffff0000u)};
                   x0 = (x0 - mean) * rstd * cv[4 * bj + 0] + cv[4 * bj + 2];
                   x1 = (x1 - mean) * rstd * cv[4 * bj + 1] + cv[4 * bj + 3]; }
            const f32x4 z0 = ALPHA * x0 + cs * v[bj][0], z1 = ALPHA * x1 + cs * v[bj][1];
            const u32x2 p0 = pk4(z0), p1 = pk4(z1);
            *(u32x4*)(cx.Zb + (unsigned)row * ZLD + col) = (u32x4){p0.x, p0.y, p1.x, p1.y};
            s += ((z0[0] + z0[1]) + (z0[2] + z0[3])) + ((z1[0] + z1[1]) + (z1[2] + z1[3]));
            q += ((z0[0] * z0[0] + z0[1] * z0[1]) + (z0[2] * z0[2] + z0[3] * z0[3])) + ((z1[0] * z1[0] + z1[1] * z1[1]) + (z1[2] * z1[2] + z1[3] * z1[3]));
        }
        s += __shfl_xor(s, 16); s += __shfl_xor(s, 32); q += __shfl_xor(q, 16); q += __shfl_xor(q, 32);
        if (fq == 0) *(f32x2v*)(cx.stn + (unsigned)row * 32 + (pn * 4 + wc) * 2) = (f32x2v){s, q};
    }
    PG8_EPI_WALK()
};

struct EpiQkvA {
    static constexpr bool PERM = false, AFTER_DRAIN = false;
    int cnt;
    struct Ctx { const float* st; const float* c1; const float* c2; bf16_t* Q; bf16_t* Kp; bf16_t* Vtp; bf16_t* Ks; bf16_t* Vts; float* outp; };
    __device__ __forceinline__ Ctx ctx() const {
        unsigned char* wsp = get_args()->ws; Ctx c; c.outp = get_args()->out;
        c.st = (const float*)(wsp + ((cnt & 1) ? WS_STA : WS_STB)); c.c1 = (const float*)(wsp + WS_MISC) + MC_QKVA; c.c2 = c.c1 + 3072;
        c.Q = (bf16_t*)(wsp + WS_BIG); c.Kp = (bf16_t*)(wsp + WS_BIG + BIG_K); c.Vtp = (bf16_t*)(wsp + WS_BIG + BIG_VT); c.Ks = (bf16_t*)(wsp + WS_KSA); c.Vts = (bf16_t*)(wsp + WS_VTSA); return c; }
    __device__ __forceinline__ void load_cv(const Ctx& cx, int pn, int wc, int fq, f32x4 (&cv)[8]) const {
        const int ns0 = pn * 256 + wc * 32 + 4 * fq;
#pragma unroll
        for (int bj = 0; bj < 2; ++bj) { cv[4 * bj + 0] = *(const f32x4*)(cx.c1 + ns0 + bj * 128); cv[4 * bj + 1] = *(const f32x4*)(cx.c1 + ns0 + bj * 128 + 16);
                                         cv[4 * bj + 2] = *(const f32x4*)(cx.c2 + ns0 + bj * 128); cv[4 * bj + 3] = *(const f32x4*)(cx.c2 + ns0 + bj * 128 + 16); }
    }
    __device__ __forceinline__ void row_op(const Ctx& cx, int pm, int pn, int wc, int row, int fq, const f32x4 (&va)[2][2], const f32x4 (&cv)[8]) const {
        const int typ = pn >> 2, hc0 = (pn & 3) * 256 + wc * 32 + 8 * fq, ns0 = pn * 256 + wc * 32 + 4 * fq;
        const bool sample = (pm == 128);
        float* okp = cx.outp + OUT_AKP; float* ovp = cx.outp + OUT_AVP; float* oks = cx.outp + OUT_AKS; float* ovs = cx.outp + OUT_AVS;
        float mean, rstd; row_mean_rstd(cx.st, row, fq, mean, rstd);
        int b, pos; if (!sample) { b = row >> 11; pos = row & 2047; } else { const int r = row - MP; b = r >> 4; pos = r & 15; }
#pragma unroll
        for (int bj = 0; bj < 2; ++bj) {
            const int hc = hc0 + bj * 128;
            const f32x4 v0 = (va[bj][0] - mean * cv[4 * bj + 0]) * rstd + cv[4 * bj + 2];
            const f32x4 v1 = (va[bj][1] - mean * cv[4 * bj + 1]) * rstd + cv[4 * bj + 3];
            const u32x2 p0 = pk4(v0), p1 = pk4(v1); const u32x4 pk = (u32x4){p0.x, p0.y, p1.x, p1.y};
            if (typ == 0) { *(u32x4*)(cx.Q + (unsigned)row * QLD + hc) = pk; }
            else if (typ == 1) {
                if (!sample) { *(u32x4*)(cx.Kp + (unsigned)row * QLD + hc) = pk; if (pos >= 1536) { float* o = okp + ((unsigned)(b * 512 + pos - 1536) * DM + hc); *(f32x4*)o = v0; *(f32x4*)(o + 4) = v1; } }
                else { *(u32x4*)(cx.Ks + ((unsigned)(b * 544 + 512 + pos) * DM + hc)) = pk; float* o = oks + ((unsigned)(b * 16 + pos) * DM + hc); *(f32x4*)o = v0; *(f32x4*)(o + 4) = v1; }
            } else {
                if (!sample) {
                    *(u32x4*)(cx.Vtp + (unsigned)row * QLD + hc) = pk;
                    if (pos >= 1536) { float* o = ovp + ((unsigned)(b * 512 + pos - 1536) * DM + hc); *(f32x4*)o = v0; *(f32x4*)(o + 4) = v1; }
                } else {
                    const int h = hc >> 6, d = hc & 63;
                    bf16_t* vt = cx.Vts + ((unsigned)((b * 16 + h) * 64 + d) * 544 + 512 + pos);
#pragma unroll
                    for (int j = 0; j < 4; ++j) { vt[(unsigned)j * 544] = (bf16_t)f2bf(v0[j]); vt[(unsigned)(j + 4) * 544] = (bf16_t)f2bf(v1[j]); }
                    float* o = ovs + ((unsigned)(b * 16 + pos) * DM + hc); *(f32x4*)o = v0; *(f32x4*)(o + 4) = v1;
                }
            }
        }
    }
    PG8_EPI_WALK()
};

struct EpiQkvB {
    static constexpr bool PERM = false, AFTER_DRAIN = false;
    int cnt;
    struct Ctx { const float* st; const float* c1; const float* c2; const float* rope; bf16_t* Q; bf16_t* Kp; bf16_t* Vtp; bf16_t* Ks; bf16_t* Vts; float* outp; };
    __device__ __forceinline__ Ctx ctx() const {
        unsigned char* wsp = get_args()->ws; Ctx c; c.outp = get_args()->out;
        c.st = (const float*)(wsp + ((cnt & 1) ? WS_STA : WS_STB)); c.c1 = (const float*)(wsp + WS_MISC) + MC_QKVB; c.c2 = c.c1 + 1536; c.rope = (const float*)(wsp + WS_MISC) + MC_ROPE;
        c.Q = (bf16_t*)(wsp + WS_BIG); c.Kp = (bf16_t*)(wsp + WS_BIG + BIG_K); c.Vtp = (bf16_t*)(wsp + WS_BIG + BIG_VT); c.Ks = (bf16_t*)(wsp + WS_KSB); c.Vts = (bf16_t*)(wsp + WS_VTSB); return c; }
    __device__ __forceinline__ void load_cv(const Ctx&, int, int, int, f32x4 (&)[8]) const {}
    __device__ __forceinline__ void row_op(const Ctx& cx, int pm, int pn, int wc, int row, int fq, const f32x4 (&va)[2][2], const f32x4 (&cv)[8]) const {
        const int ns0 = pn * 256 + wc * 32 + 4 * fq;
        const bool sample = (pm == 128);
        float* okp = cx.outp + OUT_BKP; float* ovp = cx.outp + OUT_BVP; float* oks = cx.outp + OUT_BKS; float* ovs = cx.outp + OUT_BVS;
        const int dlo = 16 * (wc & 1) + 4 * fq;
        float mean, rstd; row_mean_rstd(cx.st, row, fq, mean, rstd);
        int b, pos; if (!sample) { b = row >> 11; pos = row & 2047; } else { const int r = row - MP; b = r >> 4; pos = r & 15; }
        if (pn < 5) {
            const int rp = sample ? 2048 + pos : pos;
            const f32x4 cs0 = *(const f32x4*)(cx.rope + ((unsigned)rp * 32 + dlo) * 2), cs1 = *(const f32x4*)(cx.rope + ((unsigned)rp * 32 + dlo) * 2 + 4);
            const f32x4 cc = (f32x4){cs0[0], cs0[2], cs1[0], cs1[2]}, ss = (f32x4){cs0[1], cs0[3], cs1[1], cs1[3]};
#pragma unroll
            for (int bj = 0; bj < 2; ++bj) {
                const f32x4 x1 = (va[bj][0] - mean * *(const f32x4*)(cx.c1 + ns0 + bj * 128)) * rstd + *(const f32x4*)(cx.c2 + ns0 + bj * 128);
                const f32x4 x2 = (va[bj][1] - mean * *(const f32x4*)(cx.c1 + ns0 + bj * 128 + 16)) * rstd + *(const f32x4*)(cx.c2 + ns0 + bj * 128 + 16);
                const f32x4 lo = x1 * cc - x2 * ss, hi = x2 * cc + x1 * ss;
                const int hit = bj * 2 + (wc >> 1);
                if (pn < 4) {
                    const int hc = (pn * 4 + hit) * 64 + dlo;
                    *(u32x2*)(cx.Q + (unsigned)row * QLD + hc) = pk4(lo); *(u32x2*)(cx.Q + (unsigned)row * QLD + hc + 32) = pk4(hi);
                } else {
                    const int kc = hit * 64 + dlo;
                    if (!sample) {
                        *(u32x2*)(cx.Kp + (unsigned)row * KBLD + kc) = pk4(lo); *(u32x2*)(cx.Kp + (unsigned)row * KBLD + kc + 32) = pk4(hi);
                        if (pos >= 1920) { float* o = okp + ((unsigned)(b * 128 + pos - 1920) * 256 + kc); *(f32x4*)o = lo; *(f32x4*)(o + 32) = hi; }
                    } else {
                        bf16_t* kd = cx.Ks + ((unsigned)(b * 160 + 128 + pos) * 256 + kc); *(u32x2*)kd = pk4(lo); *(u32x2*)(kd + 32) = pk4(hi);
                        float* o = oks + ((unsigned)(b * 16 + pos) * 256 + kc); *(f32x4*)o = lo; *(f32x4*)(o + 32) = hi;
                    }
                }
            }
        } else {
#pragma unroll
            for (int bj = 0; bj < 2; ++bj)
#pragma unroll
                for (int n = 0; n < 2; ++n) {
                    const int hc = bj * 128 + wc * 32 + n * 16 + 4 * fq, kvh = hc >> 6, d = hc & 63;
                    const f32x4 v = (va[bj][n] - mean * *(const f32x4*)(cx.c1 + ns0 + bj * 128 + n * 16)) * rstd + *(const f32x4*)(cx.c2 + ns0 + bj * 128 + n * 16);
                    if (!sample) {
                        *(u32x2*)(cx.Vtp + (unsigned)row * KBLD + hc) = pk4(v);
                        if (pos >= 1920) *(f32x4*)(ovp + ((unsigned)(b * 128 + pos - 1920) * 256 + hc)) = v;
                    } else {
                        bf16_t* vt = cx.Vts + ((unsigned)((b * 4 + kvh) * 64 + d) * 160 + 128 + pos);
#pragma unroll
                        for (int j = 0; j < 4; ++j) vt[(unsigned)j * 160] = (bf16_t)f2bf(v[j]);
                        *(f32x4*)(ovs + ((unsigned)(b * 16 + pos) * 256 + hc)) = v;
                    }
                }
        }
    }
    PG8_EPI_WALK()
};

template <class Epi>
__device__ __forceinline__ void small_gemm(PG8_LAS unsigned char* lds, const bf16_t* A, int lda, const bf16_t* Bt, int N, int K, const Epi& E) {
    typedef float f32x16 __attribute__((ext_vector_type(16)));
    int tid_o = threadIdx.x; asm volatile("" : "+v"(tid_o));
    const int tid = tid_o, wid = __builtin_amdgcn_readfirstlane(tid >> 6), lane = tid & 63, r = lane & 31, h = lane >> 5;
    const int ntiles = 8 * (N / 64), ks = K / 8;
    PG8_LAS float* part = (PG8_LAS float*)lds;
    const typename Epi::Ctx cx = E.ctx();
    for (int tile = blockIdx.x; tile < ntiles; tile += gridDim.x) {
        const int tm = tile & 7, tn = tile >> 3, pn = tn >> 2, wc = tn & 3;
        const bf16_t* ap = A + (size_t)(MP + tm * 32 + r) * lda + wid * ks + 8 * h;
        const bf16_t* bp0 = Bt + (size_t)(pn * 256 + wc * 32 + r) * K + wid * ks + 8 * h;
        const bf16_t* bp1 = bp0 + (size_t)128 * K;
        f32x16 acc0, acc1;
#pragma unroll
        for (int i = 0; i < 16; ++i) { acc0[i] = 0.f; acc1[i] = 0.f; }
#define PG8_SG_BATCH(NS, kb) do { bf16x8 fa[NS], fb0[NS], fb1[NS]; \
            _Pragma("unroll") for (int i = 0; i < NS; ++i) { fa[i] = *(const bf16x8*)(ap + (kb) + 16 * i); fb0[i] = *(const bf16x8*)(bp0 + (kb) + 16 * i); fb1[i] = *(const bf16x8*)(bp1 + (kb) + 16 * i); } \
            _Pragma("unroll") for (int i = 0; i < NS; ++i) { acc0 = __builtin_amdgcn_mfma_f32_32x32x16_bf16(fb0[i], fa[i], acc0, 0, 0, 0);     \
                                                             acc1 = __builtin_amdgcn_mfma_f32_32x32x16_bf16(fb1[i], fa[i], acc1, 0, 0, 0); } } while (0)
#pragma unroll 1
        for (int kb = 0; kb + 128 <= ks; kb += 128) PG8_SG_BATCH(8, kb);
        if (ks & 127) PG8_SG_BATCH(6, ks & ~127);
#undef PG8_SG_BATCH
#pragma unroll
        for (int g = 0; g < 4; ++g) {
            *(PG8_LAS f32x4*)(part + ((wid * 2 + 0) * 32 + r) * 36 + 8 * g + 4 * h) = (f32x4){acc0[4 * g], acc0[4 * g + 1], acc0[4 * g + 2], acc0[4 * g + 3]};
            *(PG8_LAS f32x4*)(part + ((wid * 2 + 1) * 32 + r) * 36 + 8 * g + 4 * h) = (f32x4){acc1[4 * g], acc1[4 * g + 1], acc1[4 * g + 2], acc1[4 * g + 3]};
        }
        __syncthreads();
        if (wid < 2) {
            const int fr = lane & 15, fq = lane >> 4, rr = wid * 16 + fr;
            f32x4 v[2][2];
#pragma unroll
            for (int bj = 0; bj < 2; ++bj)
#pragma unroll
                for (int n = 0; n < 2; ++n) {
                    f32x4 s = *(const PG8_LAS f32x4*)(part + ((0 * 2 + bj) * 32 + rr) * 36 + 16 * n + 4 * fq);
#pragma unroll
                    for (int w = 1; w < 8; ++w) s += *(const PG8_LAS f32x4*)(part + ((w * 2 + bj) * 32 + rr) * 36 + 16 * n + 4 * fq);
                    v[bj][n] = s;
                }
            f32x4 cv[8]; E.load_cv(cx, pn, wc, fq, cv);
            E.row_op(cx, 128, pn, wc, MP + tm * 32 + rr, fq, v, cv);
        }
        __syncthreads();
    }
}
}
template <bool MODE_A, bool MASK>
__device__ __forceinline__ void attn_wave(const bf16_t* Qrow0, int ldq, int nq, const bf16_t* Kb, int ldk, const bf16_t* Vt, int ldv,
                                          int kt0, int npairs, int ktl, int nvalid, int qpos0, const float* tabg, LAS float* tab, float sink, bf16_t* Orow0, int ldo, int lane) {
    const int r = lane & 31, h = lane >> 5;
    const int qr = r < nq ? r : nq - 1;
    if (MODE_A) {
#pragma unroll
        for (int i = 0; i < 5; ++i) { const int idx = lane + 64 * i; if (idx < 257) tab[idx] = tabg[idx] * LOG2E; }
        asm volatile("s_waitcnt vmcnt(0) lgkmcnt(0)" ::: "memory");
    }
    bf16x8 qf[4];
#pragma unroll
    for (int s = 0; s < 4; ++s) qf[s] = *(const bf16x8*)(Qrow0 + (size_t)qr * ldq + 16 * s + 8 * h);
    const int pr = (r & ~12) | ((r & 4) << 1) | ((r & 8) >> 1);
    f32x16 O0, O1;
#pragma unroll
    for (int i = 0; i < 16; ++i) { O0[i] = 0.f; O1[i] = 0.f; }
    float mrun = MODE_A ? -1e30f : sink * LOG2E;
    float l = MODE_A ? 0.f : (h == 0 ? 1.f : 0.f);
    const float SC = 0.125f * LOG2E;
    const bf16_t* kbase = Kb + (size_t)pr * ldk + 8 * h;
    const bf16_t* vbase = Vt + (size_t)r * ldv + 8 * h;
    const int relb0 = qpos0 + r - 8 * h;
#define ATT_LOAD(kt_, kf_, vf_) do { const int kc_ = (kt_) < ktl ? (kt_) : ktl; const int k0_ = kc_ * 32; const bf16_t* kp_ = kbase + (size_t)k0_ * ldk; \
        _Pragma("unroll") for (int s = 0; s < 4; ++s) kf_[s] = *(const bf16x8*)(kp_ + 16 * s); \
        _Pragma("unroll") for (int dt = 0; dt < 2; ++dt) _Pragma("unroll") for (int s = 0; s < 2; ++s) vf_[dt][s] = *(const bf16x8*)(vbase + (size_t)(dt * 32) * ldv + k0_ + 16 * s); } while (0)
#define ATT_COMPUTE(kt_, kf_, vf_) do { const int k0 = (kt_) * 32; \
        f32x16 S; _Pragma("unroll") for (int i = 0; i < 16; ++i) S[i] = 0.f; \
        _Pragma("unroll") for (int s = 0; s < 4; ++s) S = __builtin_amdgcn_mfma_f32_32x32x16_bf16(kf_[s], qf[s], S, 0, 0, 0); \
        float t[16]; const int relt = relb0 - k0; const int keyb = k0 + 8 * h; \
        float mx = -1e30f; \
        _Pragma("unroll") for (int i = 0; i < 16; ++i) { \
            float v; \
            if (MODE_A) { int rel = relt - (16 * (i >> 3) + (i & 7)); rel = rel < -128 ? -128 : (rel > 128 ? 128 : rel); v = S[i] * SC + tab[rel + 128]; } \
            else v = S[i] * SC; \
            if (MASK) { if (keyb + 16 * (i >> 3) + (i & 7) >= nvalid) v = -1e30f; } \
            t[i] = v; mx = fmaxf(mx, v); } \
        mx = fmaxf(mx, __shfl_xor(mx, 32)); \
        const float mnew = fmaxf(mrun, mx); const float alpha = __builtin_amdgcn_exp2f(mrun - mnew); mrun = mnew; \
        float ps = 0.f; \
        _Pragma("unroll") for (int i = 0; i < 16; ++i) { t[i] = __builtin_amdgcn_exp2f(t[i] - mnew); ps += t[i]; } \
        l = l * alpha + ps; \
        _Pragma("unroll") for (int i = 0; i < 16; ++i) { O0[i] *= alpha; O1[i] *= alpha; } \
        bf16x8 pf[2]; \
        _Pragma("unroll") for (int s = 0; s < 2; ++s) { u32x4 w; w.x = pg8::cvt_pk_bf16(t[8 * s + 0], t[8 * s + 1]); w.y = pg8::cvt_pk_bf16(t[8 * s + 2], t[8 * s + 3]); \
            w.z = pg8::cvt_pk_bf16(t[8 * s + 4], t[8 * s + 5]); w.w = pg8::cvt_pk_bf16(t[8 * s + 6], t[8 * s + 7]); pf[s] = __builtin_bit_cast(bf16x8, w); } \
        O0 = __builtin_amdgcn_mfma_f32_32x32x16_bf16(vf_[0][0], pf[0], O0, 0, 0, 0); O0 = __builtin_amdgcn_mfma_f32_32x32x16_bf16(vf_[0][1], pf[1], O0, 0, 0, 0); \
        O1 = __builtin_amdgcn_mfma_f32_32x32x16_bf16(vf_[1][0], pf[0], O1, 0, 0, 0); O1 = __builtin_amdgcn_mfma_f32_32x32x16_bf16(vf_[1][1], pf[1], O1, 0, 0, 0); } while (0)
    bf16x8 kfa[4], vfa[2][2], kfb[4], vfb[2][2];
    ATT_LOAD(kt0, kfa, vfa);
#pragma unroll 1
    for (int p = 0; p < npairs; ++p) {
        const int kt = kt0 + 2 * p;
        ATT_LOAD(kt + 1, kfb, vfb);
        ATT_COMPUTE(kt, kfa, vfa);
        ATT_LOAD(kt + 2, kfa, vfa);
        ATT_COMPUTE(kt + 1, kfb, vfb);
    }
#undef ATT_LOAD
#undef ATT_COMPUTE
    l += __shfl_xor(l, 32);
    const float inv = 1.0f / l;
    if (r < nq) {
        bf16_t* op = Orow0 + (size_t)r * ldo + 4 * h;
#pragma unroll
        for (int g = 0; g < 4; ++g) {
            f32x4 a = (f32x4){O0[4 * g], O0[4 * g + 1], O0[4 * g + 2], O0[4 * g + 3]} * inv;
            f32x4 b = (f32x4){O1[4 * g], O1[4 * g + 1], O1[4 * g + 2], O1[4 * g + 3]} * inv;
            *(u32x2*)(op + 8 * g) = pk4(a);
            *(u32x2*)(op + 32 + 8 * g) = pk4(b);
        }
    }
}

struct AttState { f32x16 O0, O1; float mrun, l; };
template <bool MODE_A, bool FAR = false>
__device__ __forceinline__ void att_tile_lds(AttState& st, const bf16x8 (&qf)[4], LAS unsigned char* slot, int tile, int relt, LAS float* tab, int pr, int r, int h) {
    const float SC = 0.125f * LOG2E;
    const int key = tile * 32 + pr;
    LAS unsigned char* krow = slot + key * 128; const int ksw = (key >> 1) & 7;
    bf16x8 kf[4], vf[2][2];
#pragma unroll
    for (int s = 0; s < 4; ++s) kf[s] = *(LAS bf16x8*)(krow + (((2 * s + h) ^ ksw) << 4));
#pragma unroll
    for (int dt = 0; dt < 2; ++dt) { const int d = dt * 32 + r; LAS unsigned char* vrow = slot + 8192 + d * 128; const int vsw = (d >> 1) & 7;
#pragma unroll
        for (int s = 0; s < 2; ++s) vf[dt][s] = *(LAS bf16x8*)(vrow + (((tile * 4 + 2 * s + h) ^ vsw) << 4)); }
    f32x16 S;
#pragma unroll
    for (int i = 0; i < 16; ++i) S[i] = 0.f;
#pragma unroll
    for (int s = 0; s < 4; ++s) S = __builtin_amdgcn_mfma_f32_32x32x16_bf16(kf[s], qf[s], S, 0, 0, 0);
    float t[16]; float mx = -1e30f;
    LAS float* tp = tab + (relt + 41);
#pragma unroll
    for (int i = 0; i < 16; ++i) {
        float v;
        if (MODE_A) v = S[i] * SC + tp[23 - (16 * (i >> 3) + (i & 7))];
        else v = S[i] * SC;
        t[i] = v; mx = fmaxf(mx, v);
    }
    mx = fmaxf(mx, __shfl_xor(mx, 32));
    const float mnew = fmaxf(st.mrun, mx); const float alpha = __builtin_amdgcn_exp2f(st.mrun - mnew); st.mrun = mnew;
    float ps = 0.f;
#pragma unroll
    for (int i = 0; i < 16; ++i) { t[i] = __builtin_amdgcn_exp2f(t[i] - mnew); ps += t[i]; }
    st.l = st.l * alpha + ps;
#pragma unroll
    for (int i = 0; i < 16; ++i) { st.O0[i] *= alpha; st.O1[i] *= alpha; }
    bf16x8 pf[2];
#pragma unroll
    for (int s = 0; s < 2; ++s) { u32x4 w; w.x = pg8::cvt_pk_bf16(t[8 * s + 0], t[8 * s + 1]); w.y = pg8::cvt_pk_bf16(t[8 * s + 2], t[8 * s + 3]);
        w.z = pg8::cvt_pk_bf16(t[8 * s + 4], t[8 * s + 5]); w.w = pg8::cvt_pk_bf16(t[8 * s + 6], t[8 * s + 7]); pf[s] = __builtin_bit_cast(bf16x8, w); }
    st.O0 = __builtin_amdgcn_mfma_f32_32x32x16_bf16(vf[0][0], pf[0], st.O0, 0, 0, 0); st.O0 = __builtin_amdgcn_mfma_f32_32x32x16_bf16(vf[0][1], pf[1], st.O0, 0, 0, 0);
    st.O1 = __builtin_amdgcn_mfma_f32_32x32x16_bf16(vf[1][0], pf[0], st.O1, 0, 0, 0); st.O1 = __builtin_amdgcn_mfma_f32_32x32x16_bf16(vf[1][1], pf[1], st.O1, 0, 0, 0);
}
__device__ __forceinline__ void att_chunk_write(LAS unsigned char* slot, const u32x4& kreg, const u32x4& vreg, int tid) {
    const int key = tid >> 3, c16 = tid & 7;
    *(LAS u32x4*)(slot + key * 128 + ((c16 ^ ((key >> 1) & 7)) << 4)) = kreg;
    const unsigned vw[4] = {vreg.x, vreg.y, vreg.z, vreg.w};
#pragma unroll
    for (int j = 0; j < 8; ++j) { const int d = c16 * 8 + j;
        *(LAS unsigned short*)(slot + 8192 + d * 128 + ((((key >> 3) ^ ((d >> 1) & 7)) << 4)) + (key & 7) * 2) = (unsigned short)((j & 1) ? (vw[j >> 1] >> 16) : (vw[j >> 1] & 0xffffu)); }
}
__device__ __forceinline__ void att_store_o(const AttState& st, bf16_t* Orow0, int ldo, int r, int h) {
    float l = st.l; l += __shfl_xor(l, 32);
    const float inv = 1.0f / l;
    bf16_t* op = Orow0 + (size_t)r * ldo + 4 * h;
#pragma unroll
    for (int g = 0; g < 4; ++g) {
        f32x4 a = (f32x4){st.O0[4 * g], st.O0[4 * g + 1], st.O0[4 * g + 2], st.O0[4 * g + 3]} * inv;
        f32x4 b = (f32x4){st.O1[4 * g], st.O1[4 * g + 1], st.O1[4 * g + 2], st.O1[4 * g + 3]} * inv;
        *(u32x2*)(op + 8 * g) = pk4(a);
        *(u32x2*)(op + 32 + 8 * g) = pk4(b);
    }
}
__device__ __forceinline__ void attn_block_a(LAS unsigned char* lds, const bf16_t* Q, const bf16_t* K, const bf16_t* V, bf16_t* O, const float* tabg, int b, int hd, int c0, int tid, int wave, int lane) {
    const int r = lane & 31, h = lane >> 5, j = wave >> 1, half = wave & 1;
    const int pr = (r & ~12) | ((r & 4) << 1) | ((r & 8) >> 1);
    LAS float* tab = (LAS float*)(lds + 6 * 16384);
    __syncthreads();
#pragma unroll
    for (int i = 0; i < 2; ++i) { const int idx = tid + 512 * i; if (idx < 704) { int rel = idx - 64; rel = rel < -128 ? -128 : (rel > 128 ? 128 : rel); tab[idx] = tabg[rel + 128] * LOG2E; } }
    const size_t rowb = (size_t)b * 2048;
    const bf16_t* kg = K + (rowb + (tid >> 3)) * QLD + hd * 64 + (tid & 7) * 8;
    const bf16_t* vg = V + (rowb + (tid >> 3)) * QLD + hd * 64 + (tid & 7) * 8;
#pragma unroll
    for (int i = 0; i < 4; ++i) { const int kc = c0 - 8 + i;
        if (kc >= 0) { const u32x4 kr = *(const u32x4*)(kg + (size_t)kc * 64 * QLD), vr = *(const u32x4*)(vg + (size_t)kc * 64 * QLD); att_chunk_write(lds + ((kc + 18) % 6) * 16384, kr, vr, tid); } }
    const size_t qrow = rowb + (size_t)(c0 + j) * 64 + half * 32;
    bf16x8 qf[4];
#pragma unroll
    for (int s = 0; s < 4; ++s) qf[s] = *(const bf16x8*)(Q + (qrow + r) * QLD + hd * 64 + 16 * s + 8 * h);
    AttState st;
#pragma unroll
    for (int i = 0; i < 16; ++i) { st.O0[i] = 0.f; st.O1[i] = 0.f; }
    st.mrun = -1e30f; st.l = 0.f;
    asm volatile("s_waitcnt vmcnt(0) lgkmcnt(0)" ::: "memory");
    __syncthreads();
#pragma unroll 1
    for (int p = 0; p < 9; ++p) {
        const int kn = c0 - 4 + p;
        const bool ld = (kn >= 0) && (p < 8);
        u32x4 kr = (u32x4){0u, 0u, 0u, 0u}, vr = (u32x4){0u, 0u, 0u, 0u};
        if (ld) { kr = *(const u32x4*)(kg + (size_t)kn * 64 * QLD); vr = *(const u32x4*)(vg + (size_t)kn * 64 * QLD); }
        const int kc = c0 + j - 8 + p;
        if (kc >= 0) {
            LAS unsigned char* slot = lds + ((kc + 18) % 6) * 16384;
            const int relt0 = (c0 + j - kc) * 64 + half * 32 + r - 8 * h;
            att_tile_lds<true>(st, qf, slot, 0, relt0, tab, pr, r, h);
            att_tile_lds<true>(st, qf, slot, 1, relt0 - 32, tab, pr, r, h);
        }
        if (ld) att_chunk_write(lds + ((kn + 18) % 6) * 16384, kr, vr, tid);
        asm volatile("s_waitcnt lgkmcnt(0)" ::: "memory");
        __syncthreads();
    }
    att_store_o(st, O + qrow * QLD + hd * 64, QLD, r, h);
}
__device__ __forceinline__ void attn_block_b(LAS unsigned char* lds, const bf16_t* Q, const bf16_t* K, const bf16_t* V, bf16_t* O, const float* sinks_, int b, int kvh, int c, int tid, int wave, int lane) {
    const int r = lane & 31, h = lane >> 5, qh = kvh * 4 + (wave >> 1), half = wave & 1;
    const int pr = (r & ~12) | ((r & 4) << 1) | ((r & 8) >> 1);
    const size_t rowb = (size_t)b * 2048;
    const bf16_t* kg = K + (rowb + (tid >> 3)) * KBLD + kvh * 64 + (tid & 7) * 8;
    const bf16_t* vg = V + (rowb + (tid >> 3)) * KBLD + kvh * 64 + (tid & 7) * 8;
    u32x4 kr[3], vr[3];
#pragma unroll
    for (int i = 0; i < 3; ++i) { const int kc = c - 2 + i; kr[i] = (u32x4){0u, 0u, 0u, 0u}; vr[i] = kr[i];
        if (kc >= 0) { kr[i] = *(const u32x4*)(kg + (size_t)kc * 64 * KBLD); vr[i] = *(const u32x4*)(vg + (size_t)kc * 64 * KBLD); } }
    const size_t qrow = rowb + (size_t)c * 64 + half * 32;
    bf16x8 qf[4];
#pragma unroll
    for (int s = 0; s < 4; ++s) qf[s] = *(const bf16x8*)(Q + (qrow + r) * QLD + qh * 64 + 16 * s + 8 * h);
    const float sink = sinks_[qh];
    __syncthreads();
#pragma unroll
    for (int i = 0; i < 3; ++i) if (c - 2 + i >= 0) att_chunk_write(lds + i * 16384, kr[i], vr[i], tid);
    AttState st;
#pragma unroll
    for (int i = 0; i < 16; ++i) { st.O0[i] = 0.f; st.O1[i] = 0.f; }
    st.mrun = sink * LOG2E; st.l = (h == 0) ? 1.f : 0.f;
    asm volatile("s_waitcnt lgkmcnt(0)" ::: "memory");
    __syncthreads();
#pragma unroll 1
    for (int i = 0; i < 3; ++i) {
        if (c - 2 + i >= 0) {
            att_tile_lds<false>(st, qf, lds + i * 16384, 0, 0, nullptr, pr, r, h);
            att_tile_lds<false>(st, qf, lds + i * 16384, 1, 0, nullptr, pr, r, h);
        }
    }
    att_store_o(st, O + qrow * QLD + qh * 64, QLD, r, h);
}

__device__ __forceinline__ void prep_weight_item(const float* W, int K, int N, int cb0, int cb1, const float* g, const float* b, bf16_t* Bt, int row0, float* c1, float* c2,
                                                 LAS float* scr, int lane, int kbeg, int kend) {
    const int c = lane & 31, col = cb1 == -2 ? (c >> 4) * FF + cb0 + 8 * ((c & 15) >> 2) + (c & 3) : cb1 < 0 ? cb0 + 8 * ((c & 15) >> 2) + 4 * (c >> 4) + (c & 3) : (c < 16 ? cb0 + c : cb1 + c - 16), hi = lane >> 5;
    float a1 = 0.f, a2 = 0.f;
    LAS float* gl = scr + 2304; LAS float* bl = scr + 2304 + 256;
    if (g) { const f32x4 gv = *(const f32x4*)(g + kbeg + 4 * lane), bv = *(const f32x4*)(b + kbeg + 4 * lane);
             *(LAS f32x4*)(gl + 4 * lane) = gv; *(LAS f32x4*)(bl + 4 * lane) = bv; }
    asm volatile("s_waitcnt lgkmcnt(0)" ::: "memory");
#pragma unroll 1
    for (int tp = 0; tp < 2; ++tp) {
    float wv[2][32];
#pragma unroll
    for (int t = 0; t < 2; ++t)
#pragma unroll
        for (int i = 0; i < 32; ++i) wv[t][i] = W[(size_t)(kbeg + 64 * (2 * tp + t) + 2 * i + hi) * N + col];
#pragma unroll
    for (int t2 = 0; t2 < 2; ++t2) {
        const int t = 2 * tp + t2;
        const int k0 = kbeg + 64 * t;
#pragma unroll
        for (int i = 0; i < 32; ++i) {
            const int kk = 2 * i + hi;
            const float w = wv[t2][i];
            float v = w;
            if (g) { v = w * gl[64 * t + kk]; a2 += w * bl[64 * t + kk]; }
            v = bfround(v); a1 += v;
            scr[kk * 33 + c] = v;
        }
        asm volatile("s_waitcnt lgkmcnt(0)" ::: "memory");
        const int c8 = lane & 7;
#pragma unroll
        for (int j = 0; j < 4; ++j) {
            const int n = (lane >> 3) + 8 * j; const LAS float* s = scr + (8 * c8) * 33 + n;
            u32x4 o;
            o.x = (__builtin_bit_cast(unsigned, s[0 * 33]) >> 16) | (__builtin_bit_cast(unsigned, s[1 * 33]) & 0xffff0000u);
            o.y = (__builtin_bit_cast(unsigned, s[2 * 33]) >> 16) | (__builtin_bit_cast(unsigned, s[3 * 33]) & 0xffff0000u);
            o.z = (__builtin_bit_cast(unsigned, s[4 * 33]) >> 16) | (__builtin_bit_cast(unsigned, s[5 * 33]) & 0xffff0000u);
            o.w = (__builtin_bit_cast(unsigned, s[6 * 33]) >> 16) | (__builtin_bit_cast(unsigned, s[7 * 33]) & 0xffff0000u);
            *(u32x4*)(Bt + (size_t)(row0 + n) * K + k0 + 8 * c8) = o;
        }
        asm volatile("s_waitcnt lgkmcnt(0)" ::: "memory");
    }
    }
    a1 += __shfl_xor(a1, 32); a2 += __shfl_xor(a2, 32);
    if (c1 && lane < 32) { atomicAdd(c1 + row0 + c, a1); atomicAdd(c2 + row0 + c, a2); }
}
constexpr int N_PHASES = 16;
#include <cstdint>
#include <cstdlib>
#include <vector>

#include <cstdint>
#include <cstdlib>
#include <vector>

#define XB_TMO      128
#define XB_XCNT(j)  (256  + 64 * (j))
#define XB_XSUB(j)  (1280 + 64 * (j))
#define XB_XGEN(j)  (2304 + 64 * (j))
#define XB_TOP      3328
#define XB_TOPGEN   3392
#define XCD_BAR_WORDS 3456
#define XB_SPIN_CAP (1u << 18)

__device__ __forceinline__ unsigned xb_ld(unsigned* p)              { return __hip_atomic_load(p, __ATOMIC_RELAXED, __HIP_MEMORY_SCOPE_AGENT); }
__device__ __forceinline__ unsigned xb_add(unsigned* p, unsigned v) { return __hip_atomic_fetch_add(p, v, __ATOMIC_RELAXED, __HIP_MEMORY_SCOPE_AGENT); }
__device__ __forceinline__ unsigned xb_xcc_id() { return (unsigned)__builtin_amdgcn_s_getreg((3 << 11) | 20) & 0xFu; }
#define XB_SPIN(cond, bar) do { unsigned _sp = 0; while (cond) { __builtin_amdgcn_s_sleep(1); \
    if ((++_sp & 255u) == 0u) { if (xb_ld(&(bar)[XB_TMO])) break; if (_sp > XB_SPIN_CAP) { atomicAdd(&(bar)[XB_TMO], 1u); break; } } } } while (0)

struct XcdBarrier {
    unsigned* bar; unsigned x;
    volatile LAS unsigned* st;
};

__device__ __forceinline__ XcdBarrier xcd_barrier_post(unsigned* bar, volatile LAS unsigned* st) {
    XcdBarrier b; b.bar = bar; b.x = xb_xcc_id(); b.st = st;
    if (threadIdx.x == 0) (void)xb_add(&bar[XB_XCNT(b.x)], 1u);
    return b;
}
__device__ __forceinline__ void xcd_barrier_complete(unsigned* bar, unsigned x, unsigned& nloc, unsigned& nx) {
    const unsigned G = gridDim.x * gridDim.y * gridDim.z;
    unsigned sum, cnt, mine, sp = 0u;
    for (;;) {
        sum = 0u; cnt = 0u; mine = 0u;
#pragma unroll
        for (unsigned j = 0; j < 16; ++j) { const unsigned c = xb_ld(&bar[XB_XCNT(j)]); sum += c; cnt += (c > 0u) ? 1u : 0u; mine = (j == x) ? c : mine; }
        if (sum == G) break;
        __builtin_amdgcn_s_sleep(1);
        if ((++sp & 255u) == 0u) { if (xb_ld(&bar[XB_TMO])) break; if (sp > XB_SPIN_CAP) { atomicAdd(&bar[XB_TMO], 1u); break; } }
    }
    nloc = mine > 0u ? mine : 1u; nx = cnt > 0u ? cnt : 1u;
}

__device__ __forceinline__ void xcd_barrier(const XcdBarrier& b) {
    asm volatile("s_waitcnt vmcnt(0)" ::: "memory");
    __syncthreads();
    if (threadIdx.x == 0) {
        unsigned* bar = b.bar;
        __builtin_amdgcn_s_waitcnt(0);
        unsigned nloc = b.st[0], nx = b.st[1];
        if (nloc == 0u) { xcd_barrier_complete(bar, b.x, nloc, nx); b.st[0] = nloc; b.st[1] = nx; }
        const unsigned old = xb_add(&bar[XB_XSUB(b.x)], 1u);
        const unsigned gen = old / nloc;
        if (old + 1u == (gen + 1u) * nloc) {
            __builtin_amdgcn_fence(__ATOMIC_RELEASE, "agent");
            asm volatile("s_waitcnt vmcnt(0)" ::: "memory");
            const unsigned og = xb_add(&bar[XB_TOP], 1u);
            const unsigned tg = og / nx;
            if (og + 1u == (tg + 1u) * nx) xb_add(&bar[XB_TOPGEN], 1u);
            else XB_SPIN(xb_ld(&bar[XB_TOPGEN]) == tg, bar);
            __builtin_amdgcn_fence(__ATOMIC_ACQUIRE, "agent");
            xb_add(&bar[XB_XGEN(b.x)], 1u);
            asm volatile("s_waitcnt vmcnt(0)" ::: "memory");
        } else {
            XB_SPIN(xb_ld(&bar[XB_XGEN(b.x)]) == gen, bar);
            __builtin_amdgcn_fence(__ATOMIC_ACQUIRE, "agent");
            asm volatile("s_waitcnt vmcnt(0)" ::: "memory");
        }
    }
    __syncthreads();
}


__device__ const double ROPE_INV[32] = {1.0, 0.7498942093324559, 0.5623413251903491, 0.4216965034285822, 0.31622776601683794, 0.23713737056616552, 0.1778279410038923, 0.1333521432163324, 0.1,
    0.07498942093324558, 0.05623413251903491, 0.042169650342858224, 0.03162277660168379, 0.023713737056616554, 0.01778279410038923, 0.01333521432163324, 0.01, 0.007498942093324558,
    0.005623413251903491, 0.004216965034285823, 0.0031622776601683794, 0.0023713737056616554, 0.0017782794100389228, 0.001333521432163324, 0.001, 0.0007498942093324559, 0.0005623413251903491,
    0.00042169650342858224, 0.00031622776601683794, 0.00023713737056616554, 0.00017782794100389227, 0.0001333521432163324};


#define AIN(i) ((const float*)get_args()->in[i])
#define x_p AIN(0)
#define x_s AIN(1)
#define cak AIN(2)
#define cav AIN(3)
#define cbk AIN(4)
#define cbv AIN(5)
#define ln_g AIN(6)
#define ln_b AIN(7)
#define w_in AIN(8)
#define w_dn AIN(9)
#define w_qkva AIN(10)
#define w_oa AIN(11)
#define relb AIN(12)
#define w_qkvb AIN(13)
#define w_ob AIN(14)
#define sinks AIN(15)
#define out ((float*)get_args()->out)
#define WSP ((unsigned char*)get_args()->ws)
#define Win ((bf16_t*)(WSP + WS_WIN))
#define Wdn ((bf16_t*)(WSP + WS_WDN))
#define Wqkva ((bf16_t*)(WSP + WS_WQKVA))
#define Woa ((bf16_t*)(WSP + WS_WOA))
#define Wqkvb ((bf16_t*)(WSP + WS_WQKVB))
#define Wob ((bf16_t*)(WSP + WS_WOB))
#define misc ((float*)(WSP + WS_MISC))
#define stA ((float*)(WSP + WS_STA))
#define stB ((float*)(WSP + WS_STB))
#define Zb ((bf16_t*)(WSP + WS_ZB))
#define Ksa ((bf16_t*)(WSP + WS_KSA))
#define Vtsa ((bf16_t*)(WSP + WS_VTSA))
#define Ksb ((bf16_t*)(WSP + WS_KSB))
#define Vtsb ((bf16_t*)(WSP + WS_VTSB))
#define Hb ((bf16_t*)(WSP + WS_BIG))
#define Qb ((bf16_t*)(WSP + WS_BIG))
#define Kpb ((bf16_t*)(WSP + WS_BIG + BIG_K))
#define Vtpb ((bf16_t*)(WSP + WS_BIG + BIG_VT))
#define rope (misc + MC_ROPE)
__global__ void __launch_bounds__(512, 2) fwd_kernel(Args args) {
    extern __shared__ __attribute__((aligned(16))) unsigned char lds_raw[];
    LAS unsigned char* lds = (LAS unsigned char*)lds_raw;
    cg::grid_group grid = cg::this_grid();
    const int tid = threadIdx.x, lane = tid & 63, wave = __builtin_amdgcn_readfirstlane(tid >> 6);
    const int G = gridDim.x, bid = blockIdx.x;
    if (tid < 4) ((LAS unsigned*)(lds + 131072))[tid] = 0u;
    __syncthreads();
    const XcdBarrier xbar = xcd_barrier_post((unsigned*)WSP, (volatile LAS unsigned*)(lds + 131072));
    const int lo = args.ph_lo, hi = args.ph_hi;
#define IN(k) (lo <= (k) && (k) < hi)
#ifndef PROBE_DUP
#define PROBE_DUP 0
#endif
#ifndef PROBE_SPIN_MASK
#define PROBE_SPIN_MASK 0u
#endif
#ifndef PROBE_SPIN_MULT
#define PROBE_SPIN_MULT 8
#endif
    unsigned long long pr_acc = 0ull, pr_t0 = (PROBE_SPIN_MASK != 0u) ? __builtin_amdgcn_s_memrealtime() : 0ull;
#define PROBE_MARK(k) do { if (PROBE_SPIN_MASK != 0u) { const unsigned long long t_ = __builtin_amdgcn_s_memrealtime(); if ((PROBE_SPIN_MASK >> (k)) & 1u) pr_acc += t_ - pr_t0; pr_t0 = t_; } } while (0)
#define SEAM(k) do { if (IN(k) && IN((k) + 1)) { if ((k) == 0) grid.sync(); else { xcd_barrier(xbar); if (PROBE_DUP & 1) xcd_barrier(xbar); } } } while (0)

    if (IN(0))
#pragma unroll 1
    for (int rep = 0; rep < ((PROBE_DUP & 8) ? 2 : 1); ++rep) {
        const int gw = bid * 8 + wave, NGW = G * 8;
        const long gt = (long)bid * 512 + tid, NGT = (long)G * 512;
        LAS float* scr = (LAS float*)(lds + wave * 16384);
        for (int it = gw; it < 5056; it += NGW) {
            int r = it;
            if (r < 2816) { const int w = r / 704, grp = (r % 704) >> 2, kc = r & 3;
                const int lnidx = (w == 1) ? 1 : (w == 2) ? 2 : 4;
                const float* g = (w == 0) ? nullptr : ln_g + lnidx * DM; const float* b = (w == 0) ? nullptr : ln_b + lnidx * DM;
                float* c1 = (w == 0) ? nullptr : misc + MC_WIN + w * 2 * 5632;
                prep_weight_item(w_in + (size_t)w * DM * 2 * FF, DM, 2 * FF, (grp >> 3) * 128 + (grp & 3) * 32 + ((grp >> 2) & 1) * 4, -2, g, b, Win + (size_t)w * 2 * FF * DM, grp * 32, c1, c1 + 5632, scr, lane, kc * 256, kc * 256 + 256);
                continue; }
            r -= 2816;
            if (r < 1408) { const int w = r / 352, grp = (r % 352) / 11, kc = r % 11;
                prep_weight_item(w_dn + (size_t)w * FF * DM, FF, DM, grp * 32, -1, nullptr, nullptr, Wdn + (size_t)w * DM * FF, grp * 32, nullptr, nullptr, scr, lane, kc * 256, kc * 256 + 256);
                continue; }
            r -= 1408;
            const int kc = r & 3; r >>= 2;
            if (r < 96) { prep_weight_item(w_qkva, DM, 3072, r * 32, -1, ln_g + 0 * DM, ln_b + 0 * DM, Wqkva, r * 32, misc + MC_QKVA, misc + MC_QKVA + 3072, scr, lane, kc * 256, kc * 256 + 256); continue; }
            r -= 96;
            if (r < 32) { prep_weight_item(w_oa, DM, DM, r * 32, -1, nullptr, nullptr, Woa, r * 32, nullptr, nullptr, scr, lane, kc * 256, kc * 256 + 256); continue; }
            r -= 32;
            if (r < 48) { int cb0, cb1; if (r < 40) { cb0 = (r >> 1) * 64 + 16 * (r & 1); cb1 = cb0 + 32; } else { cb0 = r * 32; cb1 = cb0 + 16; }
                prep_weight_item(w_qkvb, DM, 1536, cb0, cb1, ln_g + 3 * DM, ln_b + 3 * DM, Wqkvb, r * 32, misc + MC_QKVB, misc + MC_QKVB + 1536, scr, lane, kc * 256, kc * 256 + 256); continue; }
            r -= 48;
            prep_weight_item(w_ob, DM, DM, r * 32, -1, nullptr, nullptr, Wob, r * 32, nullptr, nullptr, scr, lane, kc * 256, kc * 256 + 256);
        }
        for (long i0 = gt; i0 < (long)MT * 128; i0 += 8 * NGT) {
            f32x4 a[8], b[8];
#pragma unroll
            for (int u = 0; u < 8; ++u) { const long i = i0 + (long)u * NGT; if (i < (long)MT * 128) { const int row = (int)(i >> 7), c8 = (int)(i & 127);
                const float* src = (row < MP ? x_p + (size_t)row * DM : x_s + (size_t)(row - MP) * DM) + c8 * 8; a[u] = *(const f32x4*)src; b[u] = *(const f32x4*)(src + 4); } }
#pragma unroll
            for (int u = 0; u < 8; ++u) { const long i = i0 + (long)u * NGT; if (i < (long)MT * 128) { const int row = (int)(i >> 7), c8 = (int)(i & 127);
                u32x4 o; o.x = pk2(a[u][0], a[u][1]); o.y = pk2(a[u][2], a[u][3]); o.z = pk2(b[u][0], b[u][1]); o.w = pk2(b[u][2], b[u][3]);
                *(u32x4*)(Zb + (size_t)row * ZLD + c8 * 8) = o; } }
        }
        for (long i = gt; i < 2064 * 32; i += NGT) {
            const int pos = (int)(i >> 5), fi = (int)(i & 31);
            const double a = (double)pos * ROPE_INV[fi];
            const double n = __builtin_floor(a * 0.15915494309189535);
            const float rr = (float)__builtin_fma(-n, 6.283185307179586, a);
            rope[2 * i] = cosf(rr); rope[2 * i + 1] = sinf(rr);
        }
        for (long i0 = gt; i0 < 16L * 544 * 128; i0 += 4 * NGT) {
            f32x4 ka[4], kc[4];
#pragma unroll
            for (int u = 0; u < 4; ++u) { const long i = i0 + (long)u * NGT; ka[u] = (f32x4){0.f, 0.f, 0.f, 0.f}; kc[u] = ka[u];
                if (i < 16L * 544 * 128) { const int c8 = (int)(i & 127); const int bp = (int)(i >> 7); const int b = bp / 544, pos = bp % 544;
                    if (pos < 512) { const float* src = cak + ((size_t)(b * 512 + pos) * DM + c8 * 8); ka[u] = *(const f32x4*)src; kc[u] = *(const f32x4*)(src + 4); } } }
#pragma unroll
            for (int u = 0; u < 4; ++u) { const long i = i0 + (long)u * NGT;
                if (i < 16L * 544 * 128) { const int c8 = (int)(i & 127); const int bp = (int)(i >> 7); const int pos = bp % 544;
                    u32x4 o; o.x = pk2(ka[u][0], ka[u][1]); o.y = pk2(ka[u][2], ka[u][3]); o.z = pk2(kc[u][0], kc[u][1]); o.w = pk2(kc[u][2], kc[u][3]);
                    if (pos < 512 || pos >= 528) *(u32x4*)(Ksa + (size_t)bp * DM + c8 * 8) = o; } }
        }
        for (long i0 = gt; i0 < 16L * 16 * 68 * 64; i0 += 2 * NGT) {
            float v[2][8];
#pragma unroll
            for (int u = 0; u < 2; ++u) { const long i = i0 + (long)u * NGT;
#pragma unroll
                for (int e = 0; e < 8; ++e) v[u][e] = 0.f;
                if (i < 16L * 16 * 68 * 64) { const int d = (int)(i & 63); long t = i >> 6; const int p8 = (int)(t % 68); t /= 68; const int h = (int)(t & 15), b = (int)(t >> 4);
                    if (p8 < 64) {
#pragma unroll
                        for (int e = 0; e < 8; ++e) v[u][e] = cav[((size_t)(b * 512 + p8 * 8 + e) * 16 + h) * 64 + d]; } } }
#pragma unroll
            for (int u = 0; u < 2; ++u) { const long i = i0 + (long)u * NGT;
                if (i < 16L * 16 * 68 * 64) { const int d = (int)(i & 63); long t = i >> 6; const int p8 = (int)(t % 68); t /= 68; const int h = (int)(t & 15), b = (int)(t >> 4);
                    u32x4 o; o.x = pk2(v[u][0], v[u][1]); o.y = pk2(v[u][2], v[u][3]); o.z = pk2(v[u][4], v[u][5]); o.w = pk2(v[u][6], v[u][7]);
                    if (p8 < 64 || p8 >= 66) *(u32x4*)(Vtsa + ((size_t)((b * 16 + h) * 64 + d) * 544 + p8 * 8)) = o; } }
        }
        for (long i = gt; i < 16L * 160 * 32; i += NGT) {
            const int c8 = (int)(i & 31); const int bp = (int)(i >> 5); const int b = bp / 160, pos = bp % 160;
            u32x4 o = (u32x4){0u, 0u, 0u, 0u};
            if (pos < 128) { const float* src = cbk + ((size_t)(b * 128 + pos) * 256 + c8 * 8); const f32x4 a = *(const f32x4*)src, c = *(const f32x4*)(src + 4);
                o.x = pk2(a[0], a[1]); o.y = pk2(a[2], a[3]); o.z = pk2(c[0], c[1]); o.w = pk2(c[2], c[3]); }
            if (pos < 128 || pos >= 144) *(u32x4*)(Ksb + (size_t)bp * 256 + c8 * 8) = o;
        }
        for (long i = gt; i < 16L * 4 * 20 * 64; i += NGT) {
            const int d = (int)(i & 63); long t = i >> 6; const int p8 = (int)(t % 20); t /= 20; const int h = (int)(t & 3), b = (int)(t >> 2);
            u32x4 o = (u32x4){0u, 0u, 0u, 0u};
            if (p8 < 16) { float v[8];
#pragma unroll
                for (int e = 0; e < 8; ++e) v[e] = cbv[((size_t)(b * 128 + p8 * 8 + e) * 4 + h) * 64 + d];
                o.x = pk2(v[0], v[1]); o.y = pk2(v[2], v[3]); o.z = pk2(v[4], v[5]); o.w = pk2(v[6], v[7]); }
            if (p8 < 16 || p8 >= 18) *(u32x4*)(Vtsb + ((size_t)((b * 4 + h) * 64 + d) * 160 + p8 * 8)) = o;
        }
    }
    SEAM(0); PROBE_MARK(0);

#pragma unroll 1
    for (int s = 0; s < 14; ++s) {
        if (IN(s + 1)) {
            const int L = s / 7, k = s % 7;
            const int c = 3 * L + (k > 1) + (k > 4);
            if (false) {}
#ifndef NO_SW
            else if (k == 0 || k == 5)
#pragma unroll 1
            for (int rep = 0; rep < ((PROBE_DUP & 2) ? 2 : 1); ++rep) {
                const int w = 2 * L + (k == 5);
                pg8::Gemm g{Zb, Win + (size_t)w * 2 * FF * DM, MP, 2 * FF, DM, ZLD}; pg8::StaticOrder S; S.init(MP, 2 * FF, G, bid);
                pg8::EpiSwiglu E{w, c};
                pg8::small_gemm<pg8::EpiSwiglu>(lds, g.A, g.lda, g.Bt, g.N, g.K, E);
                pg8::gemm_phase<pg8::EpiSwiglu, pg8::StaticOrder, true, true>(lds, g, S, E);
            }
#endif
#ifndef NO_RES
            else if (k == 1 || k == 6 || k == 4) {
                const bool wo = (k == 4);
                const bf16_t* Bt = wo ? (L == 0 ? Woa : Wob) : Wdn + (size_t)(2 * L + (k == 6)) * DM * FF;
                pg8::Gemm g{wo ? Qb : Hb, Bt, MP, DM, wo ? DM : FF, wo ? QLD : FF}; pg8::StaticOrder S; S.init(MP, DM, G, bid);
                pg8::EpiResid E{c, wo ? 1.0f : 0.5f};
                pg8::small_gemm<pg8::EpiResid>(lds, g.A, g.lda, g.Bt, g.N, g.K, E);
                pg8::gemm_phase<pg8::EpiResid, pg8::StaticOrder, true, true>(lds, g, S, E);
            }
#endif
#ifndef NO_QKV
            else if (k == 2)
#pragma unroll 1
            for (int rep = 0; rep < ((PROBE_DUP & 16) ? 2 : 1); ++rep) {
                if (L == 0) {
                    pg8::Gemm g{Zb, Wqkva, MP, 3072, DM, ZLD}; pg8::StaticOrder S; S.init(MP, 3072, G, bid);
                    pg8::EpiQkvA E{c};
                    pg8::small_gemm<pg8::EpiQkvA>(lds, g.A, g.lda, g.Bt, g.N, g.K, E);
                    pg8::gemm_phase<pg8::EpiQkvA, pg8::StaticOrder, true, true>(lds, g, S, E);
                } else {
                    pg8::Gemm g{Zb, Wqkvb, MP, 1536, DM, ZLD}; pg8::StaticOrder S; S.init(MP, 1536, G, bid);
                    pg8::EpiQkvB E{c};
                    pg8::small_gemm<pg8::EpiQkvB>(lds, g.A, g.lda, g.Bt, g.N, g.K, E);
                    pg8::gemm_phase<pg8::EpiQkvB, pg8::StaticOrder, true, true>(lds, g, S, E);
                }
            }
#endif
#ifndef NO_ATT
            else
#pragma unroll 1
            for (int rep = 0; rep < ((PROBE_DUP & 4) ? 2 : 1); ++rep) {
                bf16_t* Ob = ((PROBE_DUP & 4) && rep == 0) ? (bf16_t*)(WSP + WS_DUMMY_O) : Qb;
                int tid_o2 = threadIdx.x; asm volatile("" : "+v"(tid_o2)); const int tid2 = tid_o2, lane = tid2 & 63;
                unsigned* qctr = (unsigned*)WSP + 4000 + 64 * L + 16 * rep;
                volatile LAS unsigned* qslot = (volatile LAS unsigned*)(lds + 131072 + 16);
                for (;;) {
                    __syncthreads();
                    if (tid2 == 0) *qslot = __hip_atomic_fetch_add(qctr, 1u, __ATOMIC_RELAXED, __HIP_MEMORY_SCOPE_AGENT);
                    __syncthreads();
                    const int qi = (int)*qslot;
                    if (qi >= 2048 + 32) break;
                    const int bu = qi < 32 ? 2048 + qi : qi - 32;
                    if (bu < 2048) {
                        if (L == 0) attn_block_a(lds, Qb, Kpb, Vtpb, Ob, relb + ((bu >> 3) & 15) * 257, bu >> 7, (bu >> 3) & 15, (bu & 7) * 4, tid2, wave, lane);
                        else attn_block_b(lds, Qb, Kpb, Vtpb, Ob, sinks, bu >> 7, (bu >> 5) & 3, bu & 31, tid2, wave, lane);
                    } else {
                        __syncthreads();
                        const int wu = (bu - 2048) * 8 + wave, b = wu >> 4, h = wu & 15; const size_t row0 = (size_t)MP + b * 16;
                        if (L == 0) attn_wave<true, true>(Qb + row0 * QLD + h * 64, QLD, 16, Ksa + (size_t)b * 544 * DM + h * 64, DM, Vtsa + (size_t)((b * 16 + h) * 64) * 544, 544,
                                                          0, 9, 16, 528, 512, relb + h * 257, (LAS float*)(lds + 6 * 16384 + wave * 2048), 0.f, Ob + row0 * QLD + h * 64, QLD, lane);
                        else { const int kvh = h >> 2;
                               attn_wave<false, true>(Qb + row0 * QLD + h * 64, QLD, 16, Ksb + (size_t)b * 160 * 256 + kvh * 64, 256, Vtsb + (size_t)((b * 4 + kvh) * 64) * 160, 160,
                                                      0, 3, 4, 144, 0, nullptr, nullptr, sinks[h], Ob + row0 * QLD + h * 64, QLD, lane); }
                    }
                }
            }
#endif
        }
        SEAM(s + 1); PROBE_MARK(s + 1);
    }
    if (IN(15)) {
        const int gw = bid * 8 + wave, NGW = G * 8;
        const float* g = ln_g + 5 * DM; const float* b = ln_b + 5 * DM;
        f32x4 gv[4], bv[4];
#pragma unroll
        for (int j = 0; j < 4; ++j) { gv[j] = *(const f32x4*)(g + 4 * lane + 256 * j); bv[j] = *(const f32x4*)(b + 4 * lane + 256 * j); }
        for (int row0 = gw; row0 < MT; row0 += 4 * NGW) {
            f32x4 v[4][4];
#pragma unroll
            for (int u = 0; u < 4; ++u) { const int row = row0 + u * NGW;
                if (row < MT) { const bf16_t* zb = Zb + (size_t)row * ZLD + 4 * lane;
#pragma unroll
                    for (int j = 0; j < 4; ++j) { const u32x2 zz = *(const u32x2*)(zb + 256 * j);
                        v[u][j] = (f32x4){__builtin_bit_cast(float, zz.x << 16), __builtin_bit_cast(float, zz.x & 0xffff0000u), __builtin_bit_cast(float, zz.y << 16), __builtin_bit_cast(float, zz.y & 0xffff0000u)}; } }
                else {
#pragma unroll
                    for (int j = 0; j < 4; ++j) v[u][j] = (f32x4){0.f, 0.f, 0.f, 0.f}; } }
#pragma unroll
            for (int u = 0; u < 4; ++u) { const int row = row0 + u * NGW;
                float s = 0.f;
#pragma unroll
                for (int j = 0; j < 4; ++j) s += (v[u][j][0] + v[u][j][1]) + (v[u][j][2] + v[u][j][3]);
                const float mean = wave_sum(s) * (1.0f / DM); float s2 = 0.f;
#pragma unroll
                for (int j = 0; j < 4; ++j) { v[u][j] = v[u][j] - mean; s2 += (v[u][j][0] * v[u][j][0] + v[u][j][1] * v[u][j][1]) + (v[u][j][2] * v[u][j][2] + v[u][j][3] * v[u][j][3]); }
                const float rstd = 1.0f / sqrtf(wave_sum(s2) * (1.0f / DM) + 1e-5f);
                if (row < MT) { float* zr = out + (size_t)row * DM + 4 * lane;
#pragma unroll
                    for (int j = 0; j < 4; ++j) *(f32x4*)(zr + 256 * j) = v[u][j] * rstd * gv[j] + bv[j]; } }
        }
    }
    if (PROBE_SPIN_MASK != 0u) { PROBE_MARK(15);
        if (bid == 0) { const unsigned long long tend = __builtin_amdgcn_s_memrealtime() + (unsigned long long)PROBE_SPIN_MULT * pr_acc; while (__builtin_amdgcn_s_memrealtime() < tend) __builtin_amdgcn_s_sleep(16); } }
#undef IN
#undef SEAM
}

#undef AIN
#undef x_p
#undef x_s
#undef cak
#undef cav
#undef cbk
#undef cbv
#undef ln_g
#undef ln_b
#undef w_in
#undef w_dn
#undef w_qkva
#undef w_oa
#undef relb
#undef w_qkvb
#undef w_ob
#undef sinks
#undef out
#undef WSP
#undef Win
#undef Wdn
#undef Wqkva
#undef Woa
#undef Wqkvb
#undef Wob
#undef misc
#undef stA
#undef stB
#undef Zb
#undef Ksa
#undef Vtsa
#undef Ksb
#undef Vtsb
#undef Hb
#undef Qb
#undef Kpb
#undef Vtpb
#undef rope
#ifndef N_LAUNCH_MODE
#define N_LAUNCH_MODE 1
#endif
extern "C" void kernel_launch(void* const* d_in, const int* in_sizes, int n_in, void* d_out, int out_size, void* d_ws, size_t ws_size, hipStream_t stream) {
    static int grid = 0;
    if (grid == 0) {
        if (n_in != 16 || ws_size < WS_END || (size_t)out_size != OUT_END) { fprintf(stderr, "kernel_launch: unexpected problem (n_in %d, out %d, ws %zu)\n", n_in, out_size, ws_size); grid = -1; return; }
        int dev = 0, cus = 0, per_cu = 0;
        (void)hipGetDevice(&dev); (void)hipDeviceGetAttribute(&cus, hipDeviceAttributeMultiprocessorCount, dev);
        if (hipFuncSetAttribute((const void*)fwd_kernel, hipFuncAttributeMaxDynamicSharedMemorySize, LDS_BYTES) != hipSuccess) { fprintf(stderr, "kernel_launch: hipFuncSetAttribute failed\n"); grid = -1; return; }
        if (hipOccupancyMaxActiveBlocksPerMultiprocessor(&per_cu, (const void*)fwd_kernel, 512, LDS_BYTES) != hipSuccess || per_cu < 1) { fprintf(stderr, "kernel_launch: occupancy query gave %d\n", per_cu); per_cu = 1; }
        (void)hipGetLastError();
        grid = cus * per_cu;
        fprintf(stderr, "kernel_launch: grid %d (cus %d x %d)\n", grid, cus, per_cu);
    }
    if (grid < 0) return;
    if (hipMemsetAsync(d_ws, 0, 16384, stream) != hipSuccess) { fprintf(stderr, "kernel_launch: memset failed\n"); return; }
    if (hipMemsetAsync((char*)d_ws + WS_MISC, 0, (size_t)MC_ROPE * 4, stream) != hipSuccess) { fprintf(stderr, "kernel_launch: memset failed\n"); return; }
    Args a{};
    for (int i = 0; i < 16; ++i) a.in[i] = (const float*)d_in[i];
    a.out = (float*)d_out; a.ws = (unsigned char*)d_ws;
    if (N_LAUNCH_MODE == 1) {
        a.ph_lo = 0; a.ph_hi = N_PHASES;
        void* kargs[] = {&a};
        hipError_t e = hipLaunchCooperativeKernel((const void*)fwd_kernel, dim3(grid), dim3(512), kargs, LDS_BYTES, stream);
        if (e != hipSuccess) fprintf(stderr, "cooperative launch failed: %s (grid %d)\n", hipGetErrorString(e), grid);
    } else {
        for (int p = 0; p < N_PHASES; ++p) { a.ph_lo = p; a.ph_hi = p + 1; hipLaunchKernelGGL(fwd_kernel, dim3(grid), dim3(512), LDS_BYTES, stream, a); }
    }
}
```
